# Optimizing an MI355X kernel written in HIP

```python
import math
import jax, jax.numpy as jnp
from jax import lax
import numpy as np

D_MODEL = 2048
BATCH = 4
SEQ = 2048
DEPTH = 1
DEC_BATCH = 128
DEC_SEQ = 1
PAST_LEN = 16384
PAGE_SIZE = 128

A_CHUNK = 128
A_GROUP_DIM = 128
A_GROUPS = D_MODEL // A_GROUP_DIM
D_A = A_GROUPS * A_GROUP_DIM
B_HEADS = 16
B_HEAD_DIM = 128
D_B = B_HEADS * B_HEAD_DIM
CONV_W = 4
DELTA_CHUNK = 64
D_FF = 4 * D_MODEL
D_IN = 2 * D_A + 4 * D_B + 2 * B_HEADS + 2 * D_MODEL
ALPHA = (2.0 * DEPTH) ** 0.25
BETA_INIT = (8.0 * DEPTH) ** -0.25
LN_EPS = 1e-5
RMS_EPS = 1e-6

kernel_name = "hybrid_gmlp_gated_deltanet_deepnorm_step"


def layer_norm(x, g, b):
    xf = x.astype(jnp.float32)
    mu = jnp.mean(xf, axis=-1, keepdims=True)
    var = jnp.mean(jnp.square(xf - mu), axis=-1, keepdims=True)
    return ((xf - mu) * lax.rsqrt(var + LN_EPS) * g + b).astype(x.dtype)


def l2norm(x):
    xf = x.astype(jnp.float32)
    return (xf * lax.rsqrt(jnp.sum(jnp.square(xf), axis=-1, keepdims=True) + RMS_EPS)).astype(x.dtype)


def gated_rms_norm(o, z, w):
    of = o.astype(jnp.float32)
    of = of * lax.rsqrt(jnp.mean(jnp.square(of), axis=-1, keepdims=True) + RMS_EPS)
    return (of * w * jax.nn.silu(z.astype(jnp.float32))).astype(o.dtype)


def chunk_spatial_gate(u, v, w_s, b_s):
    b, t, _ = v.shape
    pad = (-t) % A_CHUNK
    nc = (t + pad) // A_CHUNK
    vp = jnp.pad(v, ((0, 0), (0, pad), (0, 0))).reshape(b, nc, A_CHUNK, A_GROUPS, A_GROUP_DIM)
    idx = jnp.arange(A_CHUNK)
    causal = idx[:, None] >= idx[None, :]
    w = jnp.where(causal[None], w_s, 0.0)
    mixed = jnp.einsum('gts,bcsgd->bctgd', w, vp) + jnp.transpose(b_s)[None, None, :, :, None]
    mixed = mixed.reshape(b, nc * A_CHUNK, D_A)[:, :t]
    return u * mixed.astype(u.dtype)


def gated_delta_rule(q, k, v, beta, g, s0):
    b, t, h, dk = q.shape
    dv = v.shape[-1]
    out_dtype = v.dtype
    pad = (-t) % DELTA_CHUNK
    nc = (t + pad) // DELTA_CHUNK

    def blocks(a):
        a = a.astype(jnp.float32)
        a = jnp.pad(a, [(0, 0), (0, pad)] + [(0, 0)] * (a.ndim - 2))
        a = a.reshape((b, nc, DELTA_CHUNK) + a.shape[2:])
        return jnp.moveaxis(a, 3, 1)

    q, k, v, beta, g = blocks(q), blocks(k), blocks(v), blocks(beta), blocks(g)
    gc = jnp.cumsum(g, axis=-1)
    idx = jnp.arange(DELTA_CHUNK)
    incl = idx[:, None] >= idx[None, :]
    strict = idx[:, None] > idx[None, :]
    decay = jnp.exp(jnp.where(incl, gc[..., :, None] - gc[..., None, :], -jnp.inf))
    kb = k * beta[..., None]
    vb = v * beta[..., None]
    n = jnp.where(strict, jnp.einsum('bhnid,bhnjd->bhnij', kb, k) * decay, 0.0)
    eye = jnp.eye(DELTA_CHUNK, dtype=jnp.float32)
    tmat = lax.linalg.triangular_solve(eye + n, jnp.broadcast_to(eye, n.shape),
                                       left_side=True, lower=True, unit_diagonal=True)
    w_val = jnp.einsum('bhnij,bhnje->bhnie', tmat, vb)
    k_cd = jnp.einsum('bhnij,bhnjd->bhnid', tmat, kb * jnp.exp(gc)[..., None])
    attn = jnp.einsum('bhnid,bhnjd->bhnij', q, k) * decay
    q_dec = q * jnp.exp(gc)[..., None]
    k_dec = k * jnp.exp(gc[..., -1:] - gc)[..., None]
    g_last = jnp.exp(gc[..., -1])
    xs = (jnp.moveaxis(w_val, 2, 0), jnp.moveaxis(k_cd, 2, 0), jnp.moveaxis(attn, 2, 0),
          jnp.moveaxis(q_dec, 2, 0), jnp.moveaxis(k_dec, 2, 0), jnp.moveaxis(g_last, 2, 0))

    def step(s, xc):
        w_c, kcd_c, attn_c, qd_c, kd_c, gl_c = xc
        v_new = w_c - jnp.einsum('bhid,bhde->bhie', kcd_c, s)
        o_c = jnp.einsum('bhid,bhde->bhie', qd_c, s) + jnp.einsum('bhij,bhje->bhie', attn_c, v_new)
        s = s * gl_c[..., None, None] + jnp.einsum('bhid,bhie->bhde', kd_c, v_new)
        return s, o_c

    s_fin, o = lax.scan(step, s0.astype(jnp.float32), xs)
    o = jnp.transpose(o, (1, 0, 3, 2, 4)).reshape(b, nc * DELTA_CHUNK, h, dv)[:, :t]
    return o.astype(out_dtype), s_fin.astype(s0.dtype)


def hybrid_layer(x, conv_buf, s0, w_in, w_s, b_s, ln_v_g, ln_v_b, w_conv, a_log, dt_bias, w_onorm,
                 w_proj_a, w_proj_b, w_o, ln1_g, ln1_b, w_up, w_down, ln2_g, ln2_b):
    b, t, _ = x.shape
    p = jnp.einsum('btd,de->bte', x, w_in)
    sizes = [D_A, D_A, 3 * D_B, D_B, B_HEADS, B_HEADS, D_MODEL, D_MODEL]
    points = [int(s) for s in np.cumsum(sizes)[:-1]]
    u, va, qkv, z, beta_logit, a_logit, gate_a, gate_b = jnp.split(p, points, axis=-1)
    u = jax.nn.gelu(u, approximate=False)
    va = layer_norm(jax.nn.gelu(va, approximate=False), ln_v_g, ln_v_b)
    y_a = chunk_spatial_gate(u, va, w_s, b_s)
    xp = jnp.concatenate([conv_buf.astype(qkv.dtype), qkv], axis=1)
    new_conv = xp[:, t:]
    acc = xp[:, 0:t] * w_conv[0]
    for j in range(1, CONV_W):
        acc = acc + xp[:, j:j + t] * w_conv[j]
    qkv_c = jax.nn.silu(acc)
    q, k, vb = jnp.split(qkv_c, 3, axis=-1)
    q = l2norm(q.reshape(b, t, B_HEADS, B_HEAD_DIM)) * (B_HEAD_DIM ** -0.5)
    k = l2norm(k.reshape(b, t, B_HEADS, B_HEAD_DIM))
    vb = vb.reshape(b, t, B_HEADS, B_HEAD_DIM)
    beta = jax.nn.sigmoid(beta_logit.astype(jnp.float32))
    g = -jnp.exp(a_log.astype(jnp.float32)) * jax.nn.softplus(a_logit.astype(jnp.float32) + dt_bias.astype(jnp.float32))
    o, s_new = gated_delta_rule(q, k, vb, beta, g, s0)
    y_b = gated_rms_norm(o, z.reshape(b, t, B_HEADS, B_HEAD_DIM), w_onorm).reshape(b, t, D_B)
    m = jax.nn.sigmoid(gate_a) * (y_a @ w_proj_a) + jax.nn.sigmoid(gate_b) * (y_b @ w_proj_b)
    x1 = layer_norm(ALPHA * x + m @ w_o, ln1_g, ln1_b)
    h = jnp.square(jax.nn.relu(x1 @ w_up)) @ w_down
    y = layer_norm(ALPHA * x1 + h, ln2_g, ln2_b)
    return y, va, new_conv, s_new


def setup_inputs(seed: int = 0) -> dict:
    key = jax.random.key(seed)
    ks = jax.random.split(key, 24)

    def nrm(k, shape, scale):
        return jax.random.normal(k, shape, jnp.float32) * scale

    x_prompt = nrm(ks[0], (BATCH, SEQ, D_MODEL), 1.0)
    x_sample = nrm(ks[1], (DEC_BATCH, DEC_SEQ, D_MODEL), 1.0)
    state_conv = nrm(ks[2], (DEPTH, DEC_BATCH, CONV_W - 1, 3 * D_B), 1.0)
    state_ssm = nrm(ks[3], (DEPTH, DEC_BATCH, B_HEADS, B_HEAD_DIM, B_HEAD_DIM), 0.1)
    w_in = nrm(ks[4], (DEPTH, D_MODEL, D_IN), D_MODEL ** -0.5)
    w_s = nrm(ks[5], (DEPTH, A_GROUPS, A_CHUNK, A_CHUNK), A_CHUNK ** -0.5)
    b_s = 1.0 + nrm(ks[6], (DEPTH, A_GROUPS, A_CHUNK), 0.01)
    ln_v_g = 1.0 + nrm(ks[7], (DEPTH, D_A), 0.02)
    ln_v_b = nrm(ks[8], (DEPTH, D_A), 0.02)
    w_conv = nrm(ks[9], (DEPTH, CONV_W, 3 * D_B), CONV_W ** -0.5)
    a_log = jnp.log(jax.random.uniform(ks[10], (DEPTH, B_HEADS), jnp.float32, minval=1.0, maxval=16.0))
    dt = jnp.exp(jax.random.uniform(ks[11], (DEPTH, B_HEADS), jnp.float32,
                                    minval=math.log(1e-3), maxval=math.log(1e-1)))
    dt_bias = dt + jnp.log(-jnp.expm1(-dt))
    w_onorm = 1.0 + nrm(ks[12], (DEPTH, B_HEAD_DIM), 0.02)
    w_proj_a = nrm(ks[13], (DEPTH, D_A, D_MODEL), D_A ** -0.5)
    w_proj_b = nrm(ks[14], (DEPTH, D_B, D_MODEL), D_B ** -0.5)
    w_o = nrm(ks[15], (DEPTH, D_MODEL, D_MODEL), BETA_INIT * D_MODEL ** -0.5)
    ln1_g = 1.0 + nrm(ks[16], (DEPTH, D_MODEL), 0.02)
    ln1_b = nrm(ks[17], (DEPTH, D_MODEL), 0.02)
    w_up = nrm(ks[18], (DEPTH, D_MODEL, D_FF), D_MODEL ** -0.5)
    w_down = nrm(ks[19], (DEPTH, D_FF, D_MODEL), BETA_INIT * D_FF ** -0.5)
    ln2_g = 1.0 + nrm(ks[20], (DEPTH, D_MODEL), 0.02)
    ln2_b = nrm(ks[21], (DEPTH, D_MODEL), 0.02)
    return {"x_prompt": x_prompt, "x_sample": x_sample, "state_conv": state_conv, "state_ssm": state_ssm,
            "w_in": w_in, "w_s": w_s, "b_s": b_s, "ln_v_g": ln_v_g, "ln_v_b": ln_v_b, "w_conv": w_conv,
            "a_log": a_log, "dt_bias": dt_bias, "w_onorm": w_onorm, "w_proj_a": w_proj_a,
            "w_proj_b": w_proj_b, "w_o": w_o, "ln1_g": ln1_g, "ln1_b": ln1_b, "w_up": w_up,
            "w_down": w_down, "ln2_g": ln2_g, "ln2_b": ln2_b}


def reference(x_prompt, x_sample, state_conv, state_ssm, w_in, w_s, b_s, ln_v_g, ln_v_b, w_conv, a_log,
              dt_bias, w_onorm, w_proj_a, w_proj_b, w_o, ln1_g, ln1_b, w_up, w_down, ln2_g, ln2_b):
    yp = x_prompt
    ys = x_sample
    bp = x_prompt.shape[0]
    conv_p, ssm_p, vrows_s, conv_s, ssm_s = [], [], [], [], []
    for l in range(DEPTH):
        lw = (w_in[l], w_s[l], b_s[l], ln_v_g[l], ln_v_b[l], w_conv[l], a_log[l], dt_bias[l], w_onorm[l],
              w_proj_a[l], w_proj_b[l], w_o[l], ln1_g[l], ln1_b[l], w_up[l], w_down[l], ln2_g[l], ln2_b[l])
        conv0 = jnp.zeros((bp, CONV_W - 1, 3 * D_B), x_prompt.dtype)
        ssm0 = jnp.zeros((bp, B_HEADS, B_HEAD_DIM, B_HEAD_DIM), x_prompt.dtype)
        yp, _, cp, sp = hybrid_layer(yp, conv0, ssm0, *lw)
        ys, vs, cs, ss = hybrid_layer(ys, state_conv[l], state_ssm[l], *lw)
        conv_p.append(cp)
        ssm_p.append(sp)
        vrows_s.append(vs)
        conv_s.append(cs)
        ssm_s.append(ss)
    new_conv_prompt = jnp.stack(conv_p)
    new_ssm_prompt = jnp.stack(ssm_p)
    new_gmlp_v_sample = jnp.stack(vrows_s)
    new_conv_sample = jnp.stack(conv_s)
    new_ssm_sample = jnp.stack(ssm_s)
    return (yp, ys, new_conv_prompt, new_ssm_prompt, new_gmlp_v_sample, new_conv_sample, new_ssm_sample)
```

```cpp
#include <hip/hip_runtime.h>
#include <hip/hip_cooperative_groups.h>
#include <cstdio>
#include <cstdint>
namespace cg = cooperative_groups;

#define LAS __attribute__((address_space(3)))
typedef unsigned short bf16_t;
typedef short bf16x8 __attribute__((ext_vector_type(8)));
typedef short s16x4 __attribute__((ext_vector_type(4)));
typedef float f32x2 __attribute__((ext_vector_type(2)));
typedef float f32x4 __attribute__((ext_vector_type(4)));
typedef float f32x16 __attribute__((ext_vector_type(16)));
typedef unsigned u32x2 __attribute__((ext_vector_type(2)));
typedef unsigned u32x4 __attribute__((ext_vector_type(4)));

constexpr int DM = 2048, SEQ = 2048, NBP = 4, MP = 8192, MS = 128, MT = 8320, MPAD = 8448;
constexpr int N1 = 16640, DFF = 8192, DQKV = 6144;
constexpr float ALPHA = 1.189207115002721f, LN_EPS = 1e-5f, RMS_EPS = 1e-6f;
constexpr int LDS_BYTES = 160768;
constexpr size_t MiB = 1u << 20;
constexpr size_t WS_BG = 1 * MiB, WS_VSTAT = 3 * MiB, WS_GL = 6 * MiB;
constexpr size_t WS_WPT = 8 * MiB, WS_WOT = 24 * MiB, WS_U = 32 * MiB, WS_Z = 65 * MiB, WS_VA = 98 * MiB, WS_QKV = 131 * MiB;
constexpr size_t WS_GA = 230 * MiB, WS_GB = 263 * MiB, WS_W1T = 296 * MiB, WS_XB = 361 * MiB, WS_PS = 296 * MiB;
constexpr size_t WS_MTMP = 296 * MiB, WS_MB = 362 * MiB, WS_R1 = 395 * MiB, WS_H = 296 * MiB;
constexpr size_t WS_WUPT = 32 * MiB, WS_WDNT = 64 * MiB, WS_X1 = 131 * MiB, WS_X1B = 197 * MiB, WS_R2 = 230 * MiB;
constexpr size_t WS_PART = 472 * MiB;
constexpr size_t WS_END = 504 * MiB;
constexpr int PS_ITEM = 90112;
constexpr int PS_W = 0, PS_KCD = 32768, PS_QD = 49152, PS_KDT = 65536, PS_AT = 81920;
constexpr size_t O_YP = 0, O_YS = 16777216, O_CP = 17039360, O_SP = 17113088, O_GV = 18161664, O_CS = 18423808, O_SS = 20783104;

__device__ __forceinline__ unsigned pk2(float lo, float hi) { typedef __bf16 b2 __attribute__((ext_vector_type(2))); f32x2 v = {lo, hi}; b2 b = __builtin_convertvector(v, b2); return __builtin_bit_cast(unsigned, b); }
__device__ __forceinline__ float bf2f(unsigned short b) { return __uint_as_float((unsigned)b << 16); }
__device__ __forceinline__ float bflo(unsigned w) { return __uint_as_float(w << 16); }
__device__ __forceinline__ float bfhi(unsigned w) { return __uint_as_float(w & 0xffff0000u); }
__device__ __forceinline__ float sigmoidf_(float x) { return 1.0f / (1.0f + __expf(-x)); }
__device__ __forceinline__ float siluf_(float x) { return x / (1.0f + __expf(-x)); }
__device__ __forceinline__ float wave_sum(float v) {
#pragma unroll
    for (int o = 1; o < 64; o <<= 1) v += __shfl_xor(v, o);
    return v;
}
__device__ __forceinline__ void lds_barrier() { asm volatile("s_waitcnt lgkmcnt(0)\n\ts_barrier" ::: "memory"); }
__device__ __forceinline__ f32x2 gelu_pk(f32x2 v) {
    const f32x2 av = __builtin_elementwise_abs(v), d = av * 0.2316418882f + 1.0f;
    f32x2 t; t.x = __builtin_amdgcn_rcpf(d.x); t.y = __builtin_amdgcn_rcpf(d.y);
    f32x2 q = t * 0.5307027145f + (-0.7265760135f); q = q * t + 0.7107068705f; q = q * t + (-0.142248368f); q = q * t + 0.127414796f; q = q * t;
    const f32x2 s = (v * v) * (-0.72134752044f);
    f32x2 e; e.x = __builtin_amdgcn_exp2f(s.x); e.y = __builtin_amdgcn_exp2f(s.y);
    const f32x2 m = v * (q * e), r = v - m;
    f32x2 o; o.x = v.x < 0.f ? m.x : r.x; o.y = v.y < 0.f ? m.y : r.y; return o;
}
__device__ __forceinline__ f32x4 gelu4(f32x4 v) { f32x2 a = gelu_pk((f32x2){v[0], v[1]}), b = gelu_pk((f32x2){v[2], v[3]}); return (f32x4){a.x, a.y, b.x, b.y}; }

namespace pg8 {
constexpr int BM = 256, BK = 64, HALF = 128, HTB = HALF * BK * 2, STAGE_BYTES = 8 * HTB, NXCD = 8, WGM = 8;
__host__ __device__ __forceinline__ int lds_byte(int r, int c) { const int st = (r >> 4) * 2 + (c >> 5), rr = r & 15, cc = c & 31, ob = rr * 64 + cc * 2; return st * 1024 + (ob ^ (((ob >> 9) & 1) << 5)); }
__host__ __device__ __forceinline__ void stage_rc(int b, int& R, int& C) { const int st = b / 1024, sb = b % 1024, swz = sb ^ (((sb >> 9) & 1) << 5); R = (st >> 1) * 16 + swz / 64; C = (st & 1) * 32 + (swz % 64) / 2; }
__host__ __device__ __forceinline__ int perm32(int rho) { const int n = rho >> 4, i = rho & 15; return 8 * (i >> 2) + 4 * n + (i & 3); }
struct Unit { int pm, pn, k0, nt; };
struct Gemm { const bf16_t* A; const bf16_t* Bt; int M, N, K; };
struct Sched {
    int nM, nN, nwg, G, c, pairs, offM, offN, ntK;
    int split, sM, sNt, sSl, sNtK;
    __device__ void init(int nM_, int nN_, int G_, int c_, int pairs_, int offM_, int offN_, int ntK_) { nM = nM_; nN = nN_; nwg = nM * nN; G = G_; c = c_; pairs = pairs_; offM = offM_; offN = offN_; ntK = ntK_; split = 0; sM = 0; sNt = 0; sSl = 0; sNtK = 0; }
    __device__ void init_split(int sM_, int nN_, int slices, int ntk_slice, int G_, int c_, int pairs_, int offM_, int offN_) { init(1, nN_, G_, c_, pairs_, offM_, offN_, ntk_slice); split = 1; sM = sM_; sNt = nN_; sSl = slices; sNtK = ntk_slice; nwg = nN_ * slices * (pairs_ ? 2 : 1); }
    __device__ bool next(int i, Unit& u) const {
        if (split) {
            const int L = i * G + c; if (L >= nwg) return false;
            const int sl = L % sSl, r = L / sSl, pn = r % sNt, which = r / sNt;
            u.pm = sM + which * offM; u.pn = pn + which * offN; u.k0 = sl * sNtK; u.nt = sNtK; return true;
        }
        const int j = pairs ? (i >> 1) : i, which = pairs ? (i & 1) : 0;
        const long L = (long)j * G + c; if (L >= nwg) return false;
        int wgid = (int)L; { const int q = nwg / NXCD, r = nwg % NXCD, xcd = wgid % NXCD, off = wgid / NXCD; wgid = (xcd < r ? xcd * (q + 1) : r * (q + 1) + (xcd - r) * q) + off; }
        const int nig = WGM * nN, gid = wgid / nig, fm = gid * WGM, gsz = (nM - fm) < WGM ? (nM - fm) : WGM;
        u.pm = fm + ((wgid % nig) % gsz) + which * offM; u.pn = (wgid % nig) / gsz + which * offN; u.k0 = 0; u.nt = ntK; return true;
    }
};

template <class Epi>
__device__ __forceinline__ void gemm_phase(LAS unsigned char* lds, const Gemm g, const Sched& S, const Epi& E) {
    const int tid = threadIdx.x, wid = __builtin_amdgcn_readfirstlane(tid >> 6), lane = tid & 63, wr = wid >> 2, wc = wid & 3, fr = lane & 15, fq = lane >> 4;
    const int K = g.K;
    unsigned voffA[2], voffB[2];
#pragma unroll
    for (int i = 0; i < 2; ++i) { int R, C; stage_rc(tid * 16 + i * 8192, R, C); const int Rb = (R & ~31) + perm32(R & 31);
        voffA[i] = (unsigned)(R * K + C) * 2u; voffB[i] = (unsigned)(Rb * K + C) * 2u; }
    const size_t kstep = (size_t)(BK * 2);
    const size_t hstep = (size_t)HALF * K * 2;
    const size_t tstep = 2 * hstep;
    const unsigned ldsw = (unsigned)wid * 1024u;
    const int aoff = lds_byte(wr * 64 + fr, fq * 8), boff = lds_byte(wc * 32 + fr, fq * 8);
#define PG8_SA(b, h) (((b) * 2 + (h)) * HTB)
#define PG8_SB(b, h) ((4 + (b) * 2 + (h)) * HTB)
#define PG8_STAGE(bufoff, gbase, voff) do { _Pragma("unroll") for (int _i = 0; _i < 2; ++_i) \
        __builtin_amdgcn_global_load_lds((const unsigned*)((const char*)(gbase) + (voff)[_i]), (LAS unsigned*)(lds + (bufoff) + ldsw + _i * 8192), 16, 0, 0); } while (0)
#define PG8_LDA(dst, b, h) do { _Pragma("unroll") for (int m = 0; m < 4; ++m) _Pragma("unroll") for (int k = 0; k < 2; ++k) dst[m][k] = *(const LAS bf16x8*)(lds + PG8_SA(b, h) + aoff + m * 2048 + k * 1024); } while (0)
#define PG8_LDB(dst, b, h) do { _Pragma("unroll") for (int n = 0; n < 2; ++n) _Pragma("unroll") for (int k = 0; k < 2; ++k) dst[n][k] = *(const LAS bf16x8*)(lds + PG8_SB(b, h) + boff + n * 2048 + k * 1024); } while (0)
#define PG8_MMA(ai, bj, At, Bt) do { __builtin_amdgcn_s_setprio(1); _Pragma("unroll") for (int m = 0; m < 4; ++m) _Pragma("unroll") for (int n = 0; n < 2; ++n) _Pragma("unroll") for (int k = 0; k < 2; ++k) \
        acc[ai][bj][m][n] = __builtin_amdgcn_mfma_f32_16x16x32_bf16(Bt[n][k], At[m][k], acc[ai][bj][m][n], 0, 0, 0); __builtin_amdgcn_s_setprio(0); } while (0)
#define PG8_WAIT_V(n) asm volatile("s_waitcnt vmcnt(" #n ")" ::: "memory")
#define PG8_WAIT_L(n) asm volatile("s_waitcnt lgkmcnt(" #n ")" ::: "memory")
#define PG8_BAR __builtin_amdgcn_s_barrier()
#define PG8_SCHED __builtin_amdgcn_sched_barrier(0)
    Unit cur, nxt; int ui = 0;
    if (!S.next(0, cur)) return;
    f32x4 acc[2][2][4][2];
#pragma unroll
    for (int a = 0; a < 2; ++a)
#pragma unroll
        for (int b = 0; b < 2; ++b)
#pragma unroll
            for (int m = 0; m < 4; ++m)
#pragma unroll
                for (int n = 0; n < 2; ++n) acc[a][b][m][n] = (f32x4){0.f, 0.f, 0.f, 0.f};
    bf16x8 At[4][2], B0[2][2], B1[2][2];
    const char* cA = (const char*)g.A + (size_t)cur.pm * tstep + (size_t)cur.k0 * kstep; const char* cB = (const char*)g.Bt + (size_t)cur.pn * tstep + (size_t)cur.k0 * kstep;
    PG8_STAGE(PG8_SB(0, 0), cB, voffB); PG8_STAGE(PG8_SB(0, 1), cB + hstep, voffB); PG8_STAGE(PG8_SA(0, 0), cA, voffA); PG8_STAGE(PG8_SA(0, 1), cA + hstep, voffA);
    if (wr == 1) PG8_BAR;
    PG8_WAIT_V(2); PG8_BAR;
    PG8_STAGE(PG8_SB(1, 0), cB + kstep, voffB); PG8_STAGE(PG8_SA(1, 0), cA + kstep, voffA); PG8_STAGE(PG8_SB(1, 1), cB + hstep + kstep, voffB);
    PG8_WAIT_V(6); PG8_BAR;
    for (;;) {
        const bool has_next = S.next(ui + 1, nxt);
        const char* nA = has_next ? (const char*)g.A + (size_t)nxt.pm * tstep + (size_t)nxt.k0 * kstep : cA; const char* nB = has_next ? (const char*)g.Bt + (size_t)nxt.pn * tstep + (size_t)nxt.k0 * kstep : cB;
        const int nt = cur.nt;
        for (int t = 0; t < nt; t += 2) {
            const bool last = (t == nt - 2);
            const char* a1 = cA + (size_t)(t + 1) * kstep;
            const char* a2 = last ? nA : cA + (size_t)(t + 2) * kstep; const char* b2 = last ? nB : cB + (size_t)(t + 2) * kstep;
            const char* a3 = a2 + kstep; const char* b3 = b2 + kstep;
            PG8_LDB(B0, 0, 0); PG8_LDB(B1, 0, 1); PG8_SCHED; PG8_LDA(At, 0, 0); PG8_STAGE(PG8_SA(1, 1), a1 + hstep, voffA);
            PG8_WAIT_V(8); PG8_WAIT_L(0); PG8_BAR; PG8_MMA(0, 0, At, B0); PG8_MMA(0, 1, At, B1); PG8_BAR; PG8_SCHED;
            PG8_LDA(At, 0, 1); PG8_STAGE(PG8_SB(0, 0), b2, voffB); PG8_STAGE(PG8_SB(0, 1), b2 + hstep, voffB); PG8_STAGE(PG8_SA(0, 0), a2, voffA);
            PG8_WAIT_V(8); PG8_WAIT_L(0); PG8_BAR; PG8_MMA(1, 0, At, B0); PG8_MMA(1, 1, At, B1); PG8_BAR; PG8_SCHED;
            PG8_LDB(B0, 1, 0); PG8_LDB(B1, 1, 1); PG8_SCHED; PG8_LDA(At, 1, 0); PG8_STAGE(PG8_SA(0, 1), a2 + hstep, voffA);
            PG8_WAIT_V(8); PG8_WAIT_L(0); PG8_BAR; PG8_MMA(0, 0, At, B0); PG8_MMA(0, 1, At, B1); PG8_BAR; PG8_SCHED;
            PG8_LDA(At, 1, 1); PG8_STAGE(PG8_SB(1, 0), b3, voffB); PG8_STAGE(PG8_SB(1, 1), b3 + hstep, voffB); PG8_STAGE(PG8_SA(1, 0), a3, voffA);
            PG8_WAIT_V(8); PG8_WAIT_L(0); PG8_BAR; PG8_MMA(1, 0, At, B0); PG8_MMA(1, 1, At, B1); PG8_BAR; PG8_SCHED;
        }
        if (wr == 0) PG8_BAR;
        E(acc, cur, wr, wc, fr, fq);
        if (!has_next) break;
#pragma unroll
        for (int a = 0; a < 2; ++a)
#pragma unroll
            for (int b = 0; b < 2; ++b)
#pragma unroll
                for (int m = 0; m < 4; ++m)
#pragma unroll
                    for (int n = 0; n < 2; ++n) acc[a][b][m][n] = (f32x4){0.f, 0.f, 0.f, 0.f};
        cur = nxt; cA = nA; cB = nB; ++ui;
        if (wr == 1) PG8_BAR;
    }
    PG8_WAIT_V(0);
    PG8_BAR;
#undef PG8_SA
#undef PG8_SB
#undef PG8_STAGE
#undef PG8_LDA
#undef PG8_LDB
#undef PG8_MMA
#undef PG8_WAIT_V
#undef PG8_WAIT_L
#undef PG8_BAR
#undef PG8_SCHED
}
}
using pg8::Unit;
typedef f32x4 Acc[2][2][4][2];

struct Params {
    const float *x_prompt, *x_sample, *state_conv, *state_ssm, *w_in, *w_s, *b_s, *ln_v_g, *ln_v_b, *w_conv, *a_log, *dt_bias, *w_onorm,
                *w_proj_a, *w_proj_b, *w_o, *ln1_g, *ln1_b, *w_up, *w_down, *ln2_g, *ln2_b;
    float* out; unsigned char* ws; int ph_lo, ph_hi, coop, pad;
};

__device__ __forceinline__ void store8bf(bf16_t* p, f32x4 v0, f32x4 v1) { u32x4 w; w.x = pk2(v0[0], v0[1]); w.y = pk2(v0[2], v0[3]); w.z = pk2(v1[0], v1[1]); w.w = pk2(v1[2], v1[3]); *(u32x4*)p = w; }

struct Epi1 {
    unsigned char* ws; const float* a_log; const float* dt_bias;
    __device__ __forceinline__ void operator()(const Acc& acc, const Unit& u, int wr, int wc, int fr, int fq) const {
        const int pn = u.pn; const int row0 = u.pm * 256 + wr * 64 + fr; const int cl = wc * 32 + 8 * fq;
        if (pn < 64) {
            int act, ld, cb; size_t boff;
            if (pn < 8) { boff = WS_U; act = 1; ld = DM; cb = pn * 256; }
            else if (pn < 16) { boff = WS_VA; act = 1; ld = DM; cb = (pn - 8) * 256; }
            else if (pn < 40) { boff = WS_QKV; act = 0; ld = DQKV; cb = (pn - 16) * 256; }
            else if (pn < 48) { boff = WS_Z; act = 2; ld = DM; cb = (pn - 40) * 256; }
            else if (pn < 56) { boff = WS_GA; act = 3; ld = DM; cb = (pn - 48) * 256; }
            else { boff = WS_GB; act = 3; ld = DM; cb = (pn - 56) * 256; }
            const bool stats = (pn >= 8 && pn < 16);
            bf16_t* base = (bf16_t*)(ws + boff);
            float* vstat = (float*)(ws + WS_VSTAT) + ((pn - 8) * 4 + wc) * 2;
            const unsigned off0 = (unsigned)(row0 * ld + cb + cl);
#pragma unroll
            for (int ai = 0; ai < 2; ++ai)
#pragma unroll
                for (int m = 0; m < 4; ++m) {
                    const unsigned off = off0 + (unsigned)((ai * 128 + m * 16) * ld); float s = 0.f, s2 = 0.f;
#pragma unroll
                    for (int bj = 0; bj < 2; ++bj) { f32x4 v0 = acc[ai][bj][m][0], v1 = acc[ai][bj][m][1];
                        if (act == 1) { v0 = gelu4(v0); v1 = gelu4(v1); }
                        else if (act >= 2) {
#pragma unroll
                            for (int e = 0; e < 4; ++e) { const float t0 = sigmoidf_(v0[e]), t1 = sigmoidf_(v1[e]); v0[e] = act == 2 ? v0[e] * t0 : t0; v1[e] = act == 2 ? v1[e] * t1 : t1; } }
                        if (stats) {
#pragma unroll
                            for (int e = 0; e < 4; ++e) { s += v0[e] + v1[e]; s2 += v0[e] * v0[e] + v1[e] * v1[e]; } }
                        store8bf(base + off + bj * 128, v0, v1); }
                    if (stats) { s += __shfl_xor(s, 16); s += __shfl_xor(s, 32); s2 += __shfl_xor(s2, 16); s2 += __shfl_xor(s2, 32);
                        if (fq == 0) { float* sp = vstat + (unsigned)((row0 + ai * 128 + m * 16) * 64); sp[0] = s; sp[1] = s2; } }
                    __builtin_amdgcn_sched_barrier(0);
                }
        } else if (wc == 0) {
            float* bg = (float*)(ws + WS_BG);
            const unsigned boff0 = (unsigned)(row0 * 32 + 8 * fq);
            if (fq < 2) {
#pragma unroll
                for (int ai = 0; ai < 2; ++ai)
#pragma unroll
                    for (int m = 0; m < 4; ++m) {
#pragma unroll
                        for (int n = 0; n < 2; ++n) { const f32x4 v = acc[ai][0][m][n]; f32x4 o;
#pragma unroll
                            for (int e = 0; e < 4; ++e) o[e] = sigmoidf_(v[e]);
                            *(f32x4*)(bg + boff0 + (unsigned)((ai * 128 + m * 16) * 32 + 4 * n)) = o; }
                        __builtin_amdgcn_sched_barrier(0); }
            } else {
                const int h0 = 8 * (fq - 2);
#pragma unroll
                for (int n = 0; n < 2; ++n) {
                    f32x4 na = *(const f32x4*)(a_log + h0 + 4 * n); const f32x4 db = *(const f32x4*)(dt_bias + h0 + 4 * n);
#pragma unroll
                    for (int e = 0; e < 4; ++e) na[e] = -__expf(na[e]);
#pragma unroll
                    for (int ai = 0; ai < 2; ++ai)
#pragma unroll
                        for (int m = 0; m < 4; ++m) { const f32x4 v = acc[ai][0][m][n]; f32x4 o;
#pragma unroll
                            for (int e = 0; e < 4; ++e) { const float xx = v[e] + db[e]; const float sp = xx > 20.f ? xx : __logf(1.0f + __expf(xx)); o[e] = na[e] * sp; }
                            *(f32x4*)(bg + boff0 + (unsigned)((ai * 128 + m * 16) * 32 + 4 * n)) = o;
                            __builtin_amdgcn_sched_barrier(0); }
                }
            }
        }
    }
};
struct Epi4 {
    unsigned char* ws;
    __device__ __forceinline__ void operator()(const Acc& acc, const Unit& u, int wr, int wc, int fr, int fq) const {
        const int which = u.pm >= 33 ? 1 : 0; const int pm = u.pm - 33 * which, pn = u.pn - 8 * which;
        const bf16_t* gate = (const bf16_t*)(ws + (which ? WS_GB : WS_GA)); bf16_t* mt = (bf16_t*)(ws + WS_MTMP); bf16_t* mb = (bf16_t*)(ws + WS_MB);
        const int row0 = pm * 256 + wr * 64 + fr, col0 = pn * 256 + wc * 32 + 8 * fq;
#pragma unroll
        for (int ai = 0; ai < 2; ++ai)
#pragma unroll
            for (int m = 0; m < 4; ++m) { const size_t off = (size_t)(row0 + ai * 128 + m * 16) * DM + col0;
#pragma unroll
                for (int bj = 0; bj < 2; ++bj) { const u32x4 gw = *(const u32x4*)(gate + off + bj * 128);
                    f32x4 g0 = {bflo(gw.x), bfhi(gw.x), bflo(gw.y), bfhi(gw.y)}, g1 = {bflo(gw.z), bfhi(gw.z), bflo(gw.w), bfhi(gw.w)};
                    f32x4 v0 = acc[ai][bj][m][0] * g0, v1 = acc[ai][bj][m][1] * g1;
                    if (which == 0) store8bf(mt + off + bj * 128, v0, v1);
                    else { const u32x4 tw = *(const u32x4*)(mt + off + bj * 128); v0 += (f32x4){bflo(tw.x), bfhi(tw.x), bflo(tw.y), bfhi(tw.y)}; v1 += (f32x4){bflo(tw.z), bfhi(tw.z), bflo(tw.w), bfhi(tw.w)}; store8bf(mb + off + bj * 128, v0, v1); } } }
    }
};
struct EpiRes {
    __device__ __forceinline__ void done(const Unit&) const {}
    const float* resf; const bf16_t* resb; bf16_t* out;
    __device__ __forceinline__ void operator()(const Acc& acc, const Unit& u, int wr, int wc, int fr, int fq) const {
        const int row0 = u.pm * 256 + wr * 64 + fr, col0 = u.pn * 256 + wc * 32 + 8 * fq;
#pragma unroll
        for (int ai = 0; ai < 2; ++ai)
#pragma unroll
            for (int m = 0; m < 4; ++m) { const size_t off = (size_t)(row0 + ai * 128 + m * 16) * DM + col0;
#pragma unroll
                for (int bj = 0; bj < 2; ++bj) { f32x4 r0, r1;
                    if (resf) { r0 = *(const f32x4*)(resf + off + bj * 128); r1 = *(const f32x4*)(resf + off + bj * 128 + 4); }
                    else { const u32x4 w = *(const u32x4*)(resb + off + bj * 128); r0 = (f32x4){bflo(w.x), bfhi(w.x), bflo(w.y), bfhi(w.y)}; r1 = (f32x4){bflo(w.z), bfhi(w.z), bflo(w.w), bfhi(w.w)}; }
                    store8bf(out + off + bj * 128, r0 * ALPHA + acc[ai][bj][m][0], r1 * ALPHA + acc[ai][bj][m][1]); } }
    }
};
struct Epi7 {
    bf16_t* H;
    __device__ __forceinline__ void operator()(const Acc& acc, const Unit& u, int wr, int wc, int fr, int fq) const {
        const int row0 = u.pm * 256 + wr * 64 + fr, col0 = u.pn * 256 + wc * 32 + 8 * fq;
#pragma unroll
        for (int ai = 0; ai < 2; ++ai)
#pragma unroll
            for (int m = 0; m < 4; ++m) { const size_t off = (size_t)(row0 + ai * 128 + m * 16) * DFF + col0;
#pragma unroll
                for (int bj = 0; bj < 2; ++bj) { f32x4 v0 = acc[ai][bj][m][0], v1 = acc[ai][bj][m][1];
#pragma unroll
                    for (int e = 0; e < 4; ++e) { const float a = fmaxf(v0[e], 0.f), b = fmaxf(v1[e], 0.f); v0[e] = a * a; v1[e] = b * b; }
                    store8bf(H + off + bj * 128, v0, v1); } }
    }
};

struct EpiSPart {
    float* part; int ld;
    __device__ __forceinline__ void operator()(const Acc& acc, const Unit& u, int wr, int wc, int fr, int fq) const {
        const int r0 = wr * 64 + fr, col0 = u.pn * 256 + wc * 32 + 8 * fq; float* base = part + (size_t)(u.k0 / u.nt) * 128 * ld;
#pragma unroll
        for (int m = 0; m < 4; ++m) { float* op = base + (size_t)(r0 + m * 16) * ld + col0;
#pragma unroll
            for (int bj = 0; bj < 2; ++bj) { *(f32x4*)(op + bj * 128) = acc[0][bj][m][0]; *(f32x4*)(op + bj * 128 + 4) = acc[0][bj][m][1]; } }
    }
};
struct EpiS4 {
    unsigned char* ws;
    __device__ __forceinline__ void operator()(const Acc& acc, const Unit& u, int wr, int wc, int fr, int fq) const {
        const int which = u.pm >= 33 ? 1 : 0; const int pn = u.pn - 8 * which;
        const bf16_t* gate = (const bf16_t*)(ws + (which ? WS_GB : WS_GA)); float* base = (float*)(ws + WS_PART) + (size_t)(which * 16 + u.k0 / u.nt) * 128 * DM;
        const int r0 = wr * 64 + fr, col0 = pn * 256 + wc * 32 + 8 * fq;
#pragma unroll
        for (int m = 0; m < 4; ++m) { const int r = r0 + m * 16;
#pragma unroll
            for (int bj = 0; bj < 2; ++bj) { const u32x4 gw = *(const u32x4*)(gate + (size_t)(MP + r) * DM + col0 + bj * 128);
                const f32x4 g0 = {bflo(gw.x), bfhi(gw.x), bflo(gw.y), bfhi(gw.y)}, g1 = {bflo(gw.z), bfhi(gw.z), bflo(gw.w), bfhi(gw.w)};
                float* op = base + (size_t)r * DM + col0 + bj * 128; *(f32x4*)op = acc[0][bj][m][0] * g0; *(f32x4*)(op + 4) = acc[0][bj][m][1] * g1; } }
    }
};

__device__ __forceinline__ void transpose_item(const float* W, int K, int N, bf16_t* WT, int dst_row0, LAS float* scr, int kb, int nb, int lane) {
    const int k0 = 64 * kb, n0 = 32 * nb;
#pragma unroll 8
    for (int i = 0; i < 32; ++i) { const int kk = 2 * i + (lane >> 5); scr[kk * 33 + (lane & 31)] = W[(size_t)(k0 + kk) * N + n0 + (lane & 31)]; }
    asm volatile("s_waitcnt lgkmcnt(0)" ::: "memory");
    const int c = lane & 7;
#pragma unroll
    for (int j = 0; j < 4; ++j) { const int n = (lane >> 3) + 8 * j; const LAS float* s = scr + (8 * c) * 33 + n;
        u32x4 o; o.x = pk2(s[0 * 33], s[1 * 33]); o.y = pk2(s[2 * 33], s[3 * 33]); o.z = pk2(s[4 * 33], s[5 * 33]); o.w = pk2(s[6 * 33], s[7 * 33]);
        *(u32x4*)(WT + (size_t)(dst_row0 + n) * K + k0 + 8 * c) = o; }
    asm volatile("s_waitcnt lgkmcnt(0)" ::: "memory");
}
__device__ __forceinline__ void transpose64(const float* W, int N, bf16_t* WT, int K, int k0, int n0, int dst_row0, LAS float* scr, int lane) {
    f32x4 v[16];
    const float* src = W + (size_t)(k0 + (lane >> 4)) * N + n0 + (lane & 15) * 4;
#pragma unroll
    for (int t = 0; t < 16; ++t) v[t] = *(const f32x4*)(src + (size_t)(4 * t) * N);
#pragma unroll
    for (int t = 0; t < 16; ++t) { LAS float* d = scr + (4 * t + (lane >> 4)) * 65 + (lane & 15) * 4; d[0] = v[t][0]; d[1] = v[t][1]; d[2] = v[t][2]; d[3] = v[t][3]; }
    asm volatile("s_waitcnt lgkmcnt(0)" ::: "memory");
    const int c = lane & 7;
#pragma unroll
    for (int j = 0; j < 8; ++j) { const int n = (lane >> 3) + 8 * j; const LAS float* s = scr + (8 * c) * 65 + n;
        u32x4 o; o.x = pk2(s[0 * 65], s[1 * 65]); o.y = pk2(s[2 * 65], s[3 * 65]); o.z = pk2(s[4 * 65], s[5 * 65]); o.w = pk2(s[6 * 65], s[7 * 65]);
        *(u32x4*)(WT + (size_t)(dst_row0 + n) * K + k0 + 8 * c) = o; }
    asm volatile("s_waitcnt lgkmcnt(0)" ::: "memory");
}
__device__ __forceinline__ void ln_row(const float* src, const float* g, const float* b, float* dstf, bf16_t* dstb, int lane, int nparts = 0, size_t pstride = 0, const float* res = nullptr) {
    f32x4 v[8]; float s = 0.f;
    if (nparts == 0) {
#pragma unroll
        for (int j = 0; j < 8; ++j) v[j] = *(const f32x4*)(src + (lane + 64 * j) * 4);
    } else {
#pragma unroll
        for (int j = 0; j < 8; ++j) v[j] = *(const f32x4*)(res + (lane + 64 * j) * 4) * ALPHA;
        for (int sl = 0; sl < nparts; ++sl) {
#pragma unroll
            for (int j = 0; j < 8; ++j) v[j] += *(const f32x4*)(src + (size_t)sl * pstride + (lane + 64 * j) * 4);
        }
    }
#pragma unroll
    for (int j = 0; j < 8; ++j) s += (v[j][0] + v[j][1]) + (v[j][2] + v[j][3]);
    const float mean = wave_sum(s) * (1.f / DM); float s2 = 0.f;
#pragma unroll
    for (int j = 0; j < 8; ++j) { v[j] = v[j] - mean; s2 += (v[j][0] * v[j][0] + v[j][1] * v[j][1]) + (v[j][2] * v[j][2] + v[j][3] * v[j][3]); }
    const float rstd = 1.0f / sqrtf(wave_sum(s2) * (1.f / DM) + LN_EPS);
#pragma unroll
    for (int j = 0; j < 8; ++j) { const int c = (lane + 64 * j) * 4; const f32x4 gg = *(const f32x4*)(g + c), bb = *(const f32x4*)(b + c); const f32x4 y = v[j] * rstd * gg + bb;
        if (dstf) *(f32x4*)(dstf + c) = y;
        if (dstb) { u32x2 w; w.x = pk2(y[0], y[1]); w.y = pk2(y[2], y[3]); *(u32x2*)(dstb + c) = w; } }
}

__device__ __forceinline__ void ln_row_b(const bf16_t* src, const float* g, const float* b, float* dstf, bf16_t* dstb, int lane) {
    float v[4][8]; float s = 0.f;
#pragma unroll
    for (int j = 0; j < 4; ++j) { const u32x4 w = *(const u32x4*)(src + (lane + 64 * j) * 8);
        v[j][0] = bflo(w.x); v[j][1] = bfhi(w.x); v[j][2] = bflo(w.y); v[j][3] = bfhi(w.y); v[j][4] = bflo(w.z); v[j][5] = bfhi(w.z); v[j][6] = bflo(w.w); v[j][7] = bfhi(w.w);
#pragma unroll
        for (int e = 0; e < 8; ++e) s += v[j][e]; }
    const float mean = wave_sum(s) * (1.f / DM); float s2 = 0.f;
#pragma unroll
    for (int j = 0; j < 4; ++j)
#pragma unroll
        for (int e = 0; e < 8; ++e) { v[j][e] -= mean; s2 += v[j][e] * v[j][e]; }
    const float rstd = 1.0f / sqrtf(wave_sum(s2) * (1.f / DM) + LN_EPS);
#pragma unroll
    for (int j = 0; j < 4; ++j) { const int c = (lane + 64 * j) * 8; const f32x4 g0 = *(const f32x4*)(g + c), g1 = *(const f32x4*)(g + c + 4), b0 = *(const f32x4*)(b + c), b1 = *(const f32x4*)(b + c + 4);
        const f32x4 y0 = (f32x4){v[j][0], v[j][1], v[j][2], v[j][3]} * rstd * g0 + b0, y1 = (f32x4){v[j][4], v[j][5], v[j][6], v[j][7]} * rstd * g1 + b1;
        if (dstf) { *(f32x4*)(dstf + c) = y0; *(f32x4*)(dstf + c + 4) = y1; }
        if (dstb) store8bf(dstb + c, y0, y1); }
}

__device__ __forceinline__ void prescan_item(const Params& p, LAS unsigned char* lds, int it) {
    const int tid = threadIdx.x, wid = tid >> 6, lane = tid & 63;
    const int bh = it >> 5, n = it & 31, b = bh >> 4, h = bh & 15, t0 = n * 64, mrow0 = b * SEQ + t0;
    LAS bf16_t* Kb = (LAS bf16_t*)(lds);
    LAS bf16_t* Qb = (LAS bf16_t*)(lds + 17408);
    LAS float* NfT = (LAS float*)(lds + 34816);
    LAS bf16_t* KdT = (LAS bf16_t*)(lds + 52224);
    LAS bf16_t* VbT = (LAS bf16_t*)(lds + 70656);
    LAS bf16_t* KbgT = (LAS bf16_t*)(lds + 89088);
    LAS bf16_t* Tb = (LAS bf16_t*)(lds + 107520);
    LAS float* sm_beta = (LAS float*)(lds + 116736);
    LAS float* sm_gc = sm_beta + 64;
    LAS float* Wc = (LAS float*)(lds + 117248);
    LAS float* OH = (LAS float*)(lds + 123392);
    unsigned char* ps = p.ws + WS_PS + (size_t)it * PS_ITEM;
    const float* bg = (const float*)(p.ws + WS_BG);
    const bf16_t* qkv = (const bf16_t*)(p.ws + WS_QKV);
    const int ri = tid >> 3, c0 = (tid & 7) * 16;
    u32x4 raw[3][4][2];
    {
        const unsigned char* qb = (const unsigned char*)qkv;
#pragma unroll
        for (int j = 0; j < 4; ++j) {
            const int tt = t0 + ri - 3 + j, ttc = tt < 0 ? 0 : tt;
            const unsigned off = (unsigned)(((b * SEQ + ttc) * DQKV + h * 128 + c0) * 2);
#pragma unroll
            for (int sec = 0; sec < 2; ++sec) {
                u32x4 a0 = *(const u32x4*)(qb + (size_t)(off + sec * 4096u)), a1 = *(const u32x4*)(qb + (size_t)(off + sec * 4096u + 16u));
                if (tt < 0) { a0 = (u32x4){0u, 0u, 0u, 0u}; a1 = (u32x4){0u, 0u, 0u, 0u}; }
                raw[sec][j][0] = a0; raw[sec][j][1] = a1;
            }
        }
    }
#pragma unroll
    for (int k = 0; k < 3; ++k) { const int idx = tid + 512 * k, j = idx / 384, rem = idx % 384; Wc[idx] = p.w_conv[(size_t)j * DQKV + (rem >> 7) * DM + h * 128 + (rem & 127)]; }
    if (tid >= 384) OH[tid - 384] = (tid == 384 + 64) ? 1.f : 0.f;
    if (wid == 0) {
        const float be = bg[(size_t)(mrow0 + lane) * 32 + h]; float g = bg[(size_t)(mrow0 + lane) * 32 + 16 + h];
#pragma unroll
        for (int o = 1; o < 64; o <<= 1) { const float t = __shfl_up(g, o); if (lane >= o) g += t; }
        sm_beta[lane] = be; sm_gc[lane] = g;
        if (lane == 63) ((float*)(p.ws + WS_GL))[it] = __expf(g);
    }
    lds_barrier();
    {
        const int i = ri;
        const int isw = i ^ ((tid & 7) << 3);
        const float gci = sm_gc[i], bei = sm_beta[i], gcl = sm_gc[63];
        const float eg = __expf(gci), ekd = __expf(gcl - gci);
#pragma unroll
        for (int sec = 0; sec < 3; ++sec) {
            float vals[16];
            asm volatile("" ::: "memory"); __builtin_amdgcn_sched_barrier(0);
            if (sec == 1) {
                const unsigned char* qb = (const unsigned char*)qkv;
#pragma unroll
                for (int j = 0; j < 4; ++j) { const int tt = t0 + ri - 3 + j, ttc = tt < 0 ? 0 : tt; const unsigned off = (unsigned)(((b * SEQ + ttc) * DQKV + h * 128 + c0) * 2) + 8192u;
                    u32x4 a0 = *(const u32x4*)(qb + (size_t)off), a1 = *(const u32x4*)(qb + (size_t)(off + 16u));
                    if (tt < 0) { a0 = (u32x4){0u, 0u, 0u, 0u}; a1 = (u32x4){0u, 0u, 0u, 0u}; }
                    raw[2][j][0] = a0; raw[2][j][1] = a1; }
                asm volatile("" ::: "memory"); __builtin_amdgcn_sched_barrier(0);
            }
#pragma unroll
            for (int e = 0; e < 16; ++e) vals[e] = 0.f;
#pragma unroll
            for (int j = 0; j < 4; ++j) {
                const LAS float* wp = Wc + (j * 3 + sec) * 128 + c0;
                const f32x4 w0 = *(const LAS f32x4*)wp, w1 = *(const LAS f32x4*)(wp + 4), w2 = *(const LAS f32x4*)(wp + 8), w3 = *(const LAS f32x4*)(wp + 12);
                const u32x4 r0 = raw[sec][j][0], r1 = raw[sec][j][1];
                vals[0] += bflo(r0.x) * w0[0]; vals[1] += bfhi(r0.x) * w0[1]; vals[2] += bflo(r0.y) * w0[2]; vals[3] += bfhi(r0.y) * w0[3];
                vals[4] += bflo(r0.z) * w1[0]; vals[5] += bfhi(r0.z) * w1[1]; vals[6] += bflo(r0.w) * w1[2]; vals[7] += bfhi(r0.w) * w1[3];
                vals[8] += bflo(r1.x) * w2[0]; vals[9] += bfhi(r1.x) * w2[1]; vals[10] += bflo(r1.y) * w2[2]; vals[11] += bfhi(r1.y) * w2[3];
                vals[12] += bflo(r1.z) * w3[0]; vals[13] += bfhi(r1.z) * w3[1]; vals[14] += bflo(r1.w) * w3[2]; vals[15] += bfhi(r1.w) * w3[3];
            }
#pragma unroll
            for (int e = 0; e < 16; ++e) vals[e] = siluf_(vals[e]);
            if (sec < 2) {
                float sq = 0.f;
#pragma unroll
                for (int e = 0; e < 16; ++e) sq += vals[e] * vals[e];
                sq += __shfl_xor(sq, 1); sq += __shfl_xor(sq, 2); sq += __shfl_xor(sq, 4);
                const float rn = (1.0f / sqrtf(sq + RMS_EPS)) * (sec == 0 ? 0.08838834764831845f : 1.0f);
#pragma unroll
                for (int e = 0; e < 16; ++e) vals[e] *= rn;
                unsigned w8[8];
#pragma unroll
                for (int e = 0; e < 8; ++e) w8[e] = pk2(vals[2 * e], vals[2 * e + 1]);
                LAS bf16_t* dst = (sec == 0 ? Qb : Kb) + i * 136 + c0;
                *(LAS u32x4*)dst = (u32x4){w8[0], w8[1], w8[2], w8[3]}; *(LAS u32x4*)(dst + 8) = (u32x4){w8[4], w8[5], w8[6], w8[7]};
                asm volatile("" ::: "memory"); __builtin_amdgcn_sched_barrier(0);
                if (sec == 0) {
#pragma unroll
                    for (int e = 0; e < 8; ++e) w8[e] = pk2(vals[2 * e] * eg, vals[2 * e + 1] * eg);
                    bf16_t* qdp = (bf16_t*)(ps + PS_QD) + i * 128 + c0;
                    *(u32x4*)qdp = (u32x4){w8[0], w8[1], w8[2], w8[3]}; *(u32x4*)(qdp + 8) = (u32x4){w8[4], w8[5], w8[6], w8[7]};
                } else {
#pragma unroll
                    for (int e = 0; e < 16; ++e) KdT[(c0 + e) * 72 + isw] = (bf16_t)(pk2(vals[e] * ekd, 0.f) & 0xffffu);
                    asm volatile("" ::: "memory"); __builtin_amdgcn_sched_barrier(0);
                    const float bk = bei * eg;
#pragma unroll
                    for (int e = 0; e < 16; ++e) KbgT[(c0 + e) * 72 + isw] = (bf16_t)(pk2(bk * vals[e], 0.f) & 0xffffu);
                }
            } else {
#pragma unroll
                for (int e = 0; e < 16; ++e) VbT[(c0 + e) * 72 + isw] = (bf16_t)(pk2(bei * vals[e], 0.f) & 0xffffu);
            }
        }
    }
    lds_barrier();
    {
        const int mat = wid >> 2, mi = wid & 3, fr = lane & 15, fq = lane >> 4;
        LAS bf16_t* Asrc = mat ? Qb : Kb;
        bf16x8 af[4];
#pragma unroll
        for (int s = 0; s < 4; ++s) af[s] = *(const LAS bf16x8*)(Asrc + (16 * mi + fr) * 136 + 32 * s + 8 * fq);
#pragma unroll
        for (int nj = 0; nj < 4; ++nj) {
            f32x4 acc = {0.f, 0.f, 0.f, 0.f};
            if (nj <= mi) {
#pragma unroll
                for (int s = 0; s < 4; ++s) { const bf16x8 bfr = *(const LAS bf16x8*)(Kb + (16 * nj + fr) * 136 + 32 * s + 8 * fq); acc = __builtin_amdgcn_mfma_f32_16x16x32_bf16(af[s], bfr, acc, 0, 0, 0); }
            }
            const int jj = 16 * nj + fr; const float gcj = sm_gc[jj];
            if (mat == 0) { f32x4 o;
#pragma unroll
                for (int j = 0; j < 4; ++j) { const int i = 16 * mi + 4 * fq + j; const float dec = __expf(fminf(sm_gc[i] - gcj, 0.f)); o[j] = (i > jj) ? sm_beta[i] * acc[j] * dec : 0.f; }
                *(LAS f32x4*)(NfT + jj * 68 + 16 * mi + 4 * fq) = o;
            } else {
#pragma unroll
                for (int j = 0; j < 4; ++j) { const int i = 16 * mi + 4 * fq + j; const float dec = __expf(fminf(sm_gc[i] - gcj, 0.f));
                    ((bf16_t*)(ps + PS_AT))[i * 64 + jj] = (bf16_t)(pk2((i >= jj) ? acc[j] * dec : 0.f, 0.f) & 0xffffu); }
            }
        }
    }
    lds_barrier();
    if (tid < 128) {
        const int c = tid >> 1, half = tid & 1; f32x2 r2[16];
        const LAS float* ohp = OH + 64 - c + 4 * half;
#pragma unroll
        for (int li = 0; li < 8; ++li) { r2[2 * li] = (f32x2){ohp[8 * li], ohp[8 * li + 1]}; r2[2 * li + 1] = (f32x2){ohp[8 * li + 2], ohp[8 * li + 3]}; }
        const LAS float* nb = NfT + half * 4;
#pragma unroll
        for (int j = 0; j < 63; ++j) {
            const int jc = j >> 2, lj = jc >> 1, ej = j & 3;
            const float xm = (ej & 2) ? ((ej & 1) ? r2[2 * lj + 1].y : r2[2 * lj + 1].x) : ((ej & 1) ? r2[2 * lj].y : r2[2 * lj].x);
            const float xo = __shfl_xor(xm, 1);
            const float xj = ((jc & 1) == half) ? xm : xo;
            const f32x2 xj2 = {xj, xj};
#pragma unroll
            for (int li = lj; li < 8; ++li) {
                f32x4 nv = *(const LAS f32x4*)(nb + j * 68 + 8 * li);
                if (li == lj) {
                    const int rowb = 4 * (2 * li + half);
#pragma unroll
                    for (int e = 0; e < 4; ++e) nv[e] = (rowb + e > j) ? nv[e] : 0.f;
                }
                r2[2 * li] = r2[2 * li] - (f32x2){nv[0], nv[1]} * xj2; r2[2 * li + 1] = r2[2 * li + 1] - (f32x2){nv[2], nv[3]} * xj2;
            }
            asm volatile("" ::: "memory"); __builtin_amdgcn_sched_barrier(0);
        }
#pragma unroll
        for (int li = 0; li < 8; ++li) { const int rb = 4 * (2 * li + half);
            Tb[(rb) * 72 + c] = (bf16_t)(pk2(r2[2 * li].x, 0.f) & 0xffffu); Tb[(rb + 1) * 72 + c] = (bf16_t)(pk2(r2[2 * li].y, 0.f) & 0xffffu);
            Tb[(rb + 2) * 72 + c] = (bf16_t)(pk2(r2[2 * li + 1].x, 0.f) & 0xffffu); Tb[(rb + 3) * 72 + c] = (bf16_t)(pk2(r2[2 * li + 1].y, 0.f) & 0xffffu); }
    } else if (tid >= 256) {
        const int t2 = tid - 256; bf16_t* kd = (bf16_t*)(ps + PS_KDT);
#pragma unroll
        for (int k = 0; k < 4; ++k) { const int q = t2 + 256 * k, row = q >> 3, cc = q & 7; *(u32x4*)(kd + row * 64 + cc * 8) = *(const LAS u32x4*)(KdT + row * 72 + (cc ^ ((row >> 4) & 7)) * 8); }
    }
    lds_barrier();
    {
        const int fr = lane & 15, fq = lane >> 4;
        float* wout = (float*)(ps + PS_W); bf16_t* kout = (bf16_t*)(ps + PS_KCD);
        bf16x8 tf[4][2];
#pragma unroll
        for (int mi = 0; mi < 4; ++mi)
#pragma unroll
            for (int s = 0; s < 2; ++s) tf[mi][s] = *(const LAS bf16x8*)(Tb + (16 * mi + fr) * 72 + 32 * s + 8 * fq);
#pragma unroll
        for (int t = 0; t < 2; ++t) {
            const int ni = wid * 2 + t;
            const bf16x8 b0 = *(const LAS bf16x8*)(VbT + (16 * ni + fr) * 72 + 8 * (fq ^ (ni & 7))), b1 = *(const LAS bf16x8*)(VbT + (16 * ni + fr) * 72 + 8 * ((4 + fq) ^ (ni & 7)));
#pragma unroll
            for (int mi = 0; mi < 4; ++mi) {
                f32x4 acc = {0.f, 0.f, 0.f, 0.f};
                acc = __builtin_amdgcn_mfma_f32_16x16x32_bf16(tf[mi][0], b0, acc, 0, 0, 0);
                acc = __builtin_amdgcn_mfma_f32_16x16x32_bf16(tf[mi][1], b1, acc, 0, 0, 0);
                if (ni < 8) {
                    const int e = 16 * ni + fr; const unsigned wb = (unsigned)((e >> 5) * 1024 + (fq >> 1) * 128 + (fq & 1) * 32 + (e & 31));
                    unsigned* w32 = (unsigned*)wout + wb + (unsigned)((mi >> 1) * 512 + (mi & 1) * 256);
                    w32[0] = pk2(acc[0], acc[1]); w32[64] = pk2(acc[2], acc[3]);
                } else {
                    const unsigned kb_ = (unsigned)(4 * fq * 128 + 16 * (ni - 8) + fr);
#pragma unroll
                    for (int j = 0; j < 4; ++j) kout[kb_ + (unsigned)((16 * mi + j) * 128)] = (bf16_t)(pk2(-acc[j], 0.f) & 0xffffu);
                }
                asm volatile("" ::: "memory"); __builtin_amdgcn_sched_barrier(0);
            }
        }
    }
    lds_barrier();
}

__device__ __forceinline__ bf16x8 packs(const f32x16& x, int s) {
    u32x4 w; w.x = pk2(x[8 * s], x[8 * s + 1]); w.y = pk2(x[8 * s + 2], x[8 * s + 3]); w.z = pk2(x[8 * s + 4], x[8 * s + 5]); w.w = pk2(x[8 * s + 6], x[8 * s + 7]); return __builtin_bit_cast(bf16x8, w);
}
__device__ __forceinline__ bf16x8 ldA2(const LAS bf16_t* p) { const u32x2 a = *(const LAS u32x2*)p, b = *(const LAS u32x2*)(p + 8); u32x4 w = {a.x, a.y, b.x, b.y}; return __builtin_bit_cast(bf16x8, w); }
#define MFMA32(a, b, c) __builtin_amdgcn_mfma_f32_32x32x16_bf16((a), (b), (c), 0, 0, 0)
__device__ __forceinline__ int crow(int reg, int hh) { return (reg & 3) + 8 * (reg >> 2) + 4 * hh; }

__device__ __forceinline__ void scan_stage(const unsigned char* src, LAS unsigned char* bb, int t2) {
    constexpr int O_KCD = 0, O_QD = 16896, O_KDT = 33792, O_AT = 51200;
#pragma unroll
    for (int half = 0; half < 2; ++half) {
        u32x4 stg[7];
#pragma unroll
        for (int k = 0; k < 7; ++k) stg[k] = *(const u32x4*)(src + (size_t)(t2 + 256 * (7 * half + k)) * 16);
#pragma unroll
        for (int k = 0; k < 7; ++k) { const int kk = 7 * half + k, q = t2 + 256 * kk; LAS unsigned char* d_;
            if (kk < 4) d_ = bb + O_KCD + (q >> 4) * 264 + (q & 15) * 16; else if (kk < 8) d_ = bb + O_QD + ((q - 1024) >> 4) * 264 + (q & 15) * 16;
            else if (kk < 12) d_ = bb + O_KDT + ((q - 2048) >> 3) * 136 + (q & 7) * 16; else d_ = bb + O_AT + ((q - 3072) >> 3) * 136 + (q & 7) * 16;
            *(LAS u32x2*)d_ = (u32x2){stg[k].x, stg[k].y}; *(LAS u32x2*)(d_ + 8) = (u32x2){stg[k].z, stg[k].w}; }
    }
}
__device__ __forceinline__ void scan_onorm(const Params& p, const LAS bf16_t* Ob, bf16_t* zrow0, int h, int t2) {
    const int oi = t2 >> 2, oq = t2 & 3; u32x4 ov[4];
#pragma unroll
    for (int k = 0; k < 4; ++k) ov[k] = *(const LAS u32x4*)(Ob + oi * 136 + oq * 32 + 8 * k);
    float ov_f[32];
#pragma unroll
    for (int k = 0; k < 4; ++k) { ov_f[8 * k] = bflo(ov[k].x); ov_f[8 * k + 1] = bfhi(ov[k].x); ov_f[8 * k + 2] = bflo(ov[k].y); ov_f[8 * k + 3] = bfhi(ov[k].y);
        ov_f[8 * k + 4] = bflo(ov[k].z); ov_f[8 * k + 5] = bfhi(ov[k].z); ov_f[8 * k + 6] = bflo(ov[k].w); ov_f[8 * k + 7] = bfhi(ov[k].w); }
    float ss = 0.f;
#pragma unroll
    for (int e = 0; e < 32; ++e) ss += ov_f[e] * ov_f[e];
    ss += __shfl_xor(ss, 1); ss += __shfl_xor(ss, 2);
    const float rstd = 1.0f / sqrtf(ss * (1.f / 128.f) + RMS_EPS);
    bf16_t* zp = zrow0 + (size_t)oi * DM + h * 128 + oq * 32; const float* wn = p.w_onorm + oq * 32;
#pragma unroll
    for (int k = 0; k < 4; ++k) { const u32x4 zw = *(const u32x4*)(zp + 8 * k); const f32x4 w0 = *(const f32x4*)(wn + 8 * k), w1 = *(const f32x4*)(wn + 8 * k + 4);
        u32x4 o; o.x = pk2(ov_f[8 * k] * rstd * w0[0] * bflo(zw.x), ov_f[8 * k + 1] * rstd * w0[1] * bfhi(zw.x));
        o.y = pk2(ov_f[8 * k + 2] * rstd * w0[2] * bflo(zw.y), ov_f[8 * k + 3] * rstd * w0[3] * bfhi(zw.y));
        o.z = pk2(ov_f[8 * k + 4] * rstd * w1[0] * bflo(zw.z), ov_f[8 * k + 5] * rstd * w1[1] * bfhi(zw.z));
        o.w = pk2(ov_f[8 * k + 6] * rstd * w1[2] * bflo(zw.w), ov_f[8 * k + 7] * rstd * w1[3] * bfhi(zw.w));
        *(u32x4*)(zp + 8 * k) = o; }
}
__device__ __forceinline__ void scan_bh(const Params& p, LAS unsigned char* lds, int bh) {
    const int tid = threadIdx.x, wid = __builtin_amdgcn_readfirstlane(tid >> 6), lane = tid & 63, r = lane & 31, hh = lane >> 5;
    const int b = bh >> 4, h = bh & 15;
    constexpr int BUFB = 59904, O_KCD = 0, O_QD = 16896, O_KDT = 33792, O_AT = 51200, OBUFB = 17408;
    LAS unsigned char* Obase = lds + 2 * BUFB;
    const unsigned char* psb = p.ws + WS_PS + (size_t)(bh * 32) * PS_ITEM;
    const float* gl = (const float*)(p.ws + WS_GL) + bh * 32;
    bf16_t* Zb = (bf16_t*)(p.ws + WS_Z) + (size_t)(b * SEQ) * DM;
    if (wid >= 4) scan_stage(psb + PS_KCD, lds, tid - 256);
    lds_barrier();
    if (wid < 4) {
        f32x16 S[4], Vn[2], O[2];
#pragma unroll
        for (int d = 0; d < 4; ++d)
#pragma unroll
            for (int i = 0; i < 16; ++i) S[d][i] = 0.f;
        const int e0 = 32 * wid + r;
        { const unsigned* wsrc = (const unsigned*)(psb + PS_W) + wid * 1024 + lane;
#pragma unroll
            for (int mi = 0; mi < 2; ++mi)
#pragma unroll
                for (int k = 0; k < 8; ++k) { const unsigned u = wsrc[(mi * 8 + k) * 64]; Vn[mi][2 * k] = bflo(u); Vn[mi][2 * k + 1] = bfhi(u); } }
        const float glv = gl[lane & 31];
        for (int n = 0; n < 32; ++n) {
            LAS unsigned char* bb = lds + (n & 1) * BUFB;
            unsigned Wp[16];
            if (n + 1 < 32) { const unsigned* wsrc = (const unsigned*)(psb + (size_t)(n + 1) * PS_ITEM + PS_W) + wid * 1024 + lane;
#pragma unroll
                for (int k = 0; k < 16; ++k) Wp[k] = wsrc[k * 64]; }
            const LAS bf16_t* kcd = (const LAS bf16_t*)(bb + O_KCD); const LAS bf16_t* qdl = (const LAS bf16_t*)(bb + O_QD);
            const LAS bf16_t* kdt = (const LAS bf16_t*)(bb + O_KDT); const LAS bf16_t* att = (const LAS bf16_t*)(bb + O_AT);
            LAS bf16_t* Obuf = (LAS bf16_t*)(Obase + (n & 1) * OBUFB);
#pragma unroll
            for (int mi = 0; mi < 2; ++mi)
#pragma unroll
                for (int i = 0; i < 16; ++i) O[mi][i] = 0.f;
#pragma unroll
            for (int s = 0; s < 8; ++s) {
                bf16x8 ac[4];
#pragma unroll
                for (int mi = 0; mi < 2; ++mi) { ac[mi] = ldA2(kcd + (32 * mi + r) * 132 + 16 * s + 4 * hh); ac[2 + mi] = ldA2(qdl + (32 * mi + r) * 132 + 16 * s + 4 * hh); }
                const bf16x8 sf = packs(S[s >> 1], s & 1);
#pragma unroll
                for (int mi = 0; mi < 2; ++mi) { Vn[mi] = MFMA32(ac[mi], sf, Vn[mi]); O[mi] = MFMA32(ac[2 + mi], sf, O[mi]); }
                __builtin_amdgcn_sched_barrier(0);
            }
            bf16x8 vf[4];
#pragma unroll
            for (int s = 0; s < 4; ++s) vf[s] = packs(Vn[s >> 1], s & 1);
            if (n + 1 < 32) {
#pragma unroll
                for (int mi = 0; mi < 2; ++mi)
#pragma unroll
                    for (int k = 0; k < 8; ++k) { Vn[mi][2 * k] = bflo(Wp[mi * 8 + k]); Vn[mi][2 * k + 1] = bfhi(Wp[mi * 8 + k]); } }
#pragma unroll
            for (int s = 0; s < 2; ++s) O[0] = MFMA32(ldA2(att + (r) * 68 + 16 * s + 4 * hh), vf[s], O[0]);
#pragma unroll
            for (int s = 0; s < 4; ++s) O[1] = MFMA32(ldA2(att + (32 + r) * 68 + 16 * s + 4 * hh), vf[s], O[1]);
            const float g_l = __builtin_bit_cast(float, __builtin_amdgcn_readlane(__builtin_bit_cast(int, glv), n));
#pragma unroll
            for (int d = 0; d < 4; ++d) { S[d] = S[d] * g_l;
#pragma unroll
                for (int s = 0; s < 4; ++s) S[d] = MFMA32(ldA2(kdt + (32 * d + r) * 68 + 16 * s + 4 * hh), vf[s], S[d]); }
#pragma unroll
            for (int mi = 0; mi < 2; ++mi)
#pragma unroll
                for (int i = 0; i < 16; ++i) Obuf[(32 * mi + crow(i, hh)) * 136 + e0] = (bf16_t)(pk2(O[mi][i], 0.f) & 0xffffu);
            lds_barrier();
        }
        float* so = p.out + O_SP + (size_t)bh * 16384;
#pragma unroll
        for (int d = 0; d < 4; ++d)
#pragma unroll
            for (int i = 0; i < 16; ++i) so[(32 * d + crow(i, hh)) * 128 + e0] = S[d][i];
    } else {
        const int t2 = tid - 256, oi = t2 >> 2, oq = t2 & 3;
        u32x4 stg[8], stgb[6], zr[4];
#define SCAN_LD_A(item) do { const unsigned char* s_ = psb + (size_t)(item) * PS_ITEM + PS_KCD; _Pragma("unroll") for (int k = 0; k < 8; ++k) stg[k] = *(const u32x4*)(s_ + (size_t)(t2 + 256 * k) * 16); } while (0)
#define SCAN_LD_B(item) do { const unsigned char* s_ = psb + (size_t)(item) * PS_ITEM + PS_KCD; _Pragma("unroll") for (int k = 0; k < 6; ++k) stgb[k] = *(const u32x4*)(s_ + (size_t)(t2 + 256 * (8 + k)) * 16); } while (0)
#define SCAN_ST_A(bufi) do { LAS unsigned char* bb_ = lds + (bufi) * BUFB; _Pragma("unroll") for (int k = 0; k < 8; ++k) { const int q = t2 + 256 * k; LAS unsigned char* d_; \
            if (k < 4) d_ = bb_ + O_KCD + (q >> 4) * 264 + (q & 15) * 16; else d_ = bb_ + O_QD + ((q - 1024) >> 4) * 264 + (q & 15) * 16; \
            *(LAS u32x2*)d_ = (u32x2){stg[k].x, stg[k].y}; *(LAS u32x2*)(d_ + 8) = (u32x2){stg[k].z, stg[k].w}; } } while (0)
#define SCAN_ST_B(bufi) do { LAS unsigned char* bb_ = lds + (bufi) * BUFB; _Pragma("unroll") for (int k = 0; k < 6; ++k) { const int q = t2 + 256 * (8 + k); LAS unsigned char* d_; \
            if (k < 4) d_ = bb_ + O_KDT + ((q - 2048) >> 3) * 136 + (q & 7) * 16; else d_ = bb_ + O_AT + ((q - 3072) >> 3) * 136 + (q & 7) * 16; \
            *(LAS u32x2*)d_ = (u32x2){stgb[k].x, stgb[k].y}; *(LAS u32x2*)(d_ + 8) = (u32x2){stgb[k].z, stgb[k].w}; } } while (0)
#define SCAN_ZLD(chunk) do { const bf16_t* zp_ = Zb + (size_t)((chunk) * 64 + oi) * DM + h * 128 + oq * 32; _Pragma("unroll") for (int k = 0; k < 4; ++k) zr[k] = *(const u32x4*)(zp_ + 8 * k); } while (0)
#define SCAN_NORM(obuf, chunk) do { const LAS bf16_t* Ob_ = (const LAS bf16_t*)(obuf); u32x4 ov[4]; SCAN_ZLD(chunk); \
            _Pragma("unroll") for (int k = 0; k < 4; ++k) ov[k] = *(const LAS u32x4*)(Ob_ + oi * 136 + oq * 32 + 8 * k); \
            float ss = 0.f; \
            _Pragma("unroll") for (int k = 0; k < 4; ++k) { const float a0 = bflo(ov[k].x), a1 = bfhi(ov[k].x), a2 = bflo(ov[k].y), a3 = bfhi(ov[k].y), a4 = bflo(ov[k].z), a5 = bfhi(ov[k].z), a6 = bflo(ov[k].w), a7 = bfhi(ov[k].w); \
                ss += (a0 * a0 + a1 * a1) + (a2 * a2 + a3 * a3) + (a4 * a4 + a5 * a5) + (a6 * a6 + a7 * a7); } \
            ss += __shfl_xor(ss, 1); ss += __shfl_xor(ss, 2); \
            const float rstd = 1.0f / sqrtf(ss * (1.f / 128.f) + RMS_EPS); \
            bf16_t* zp_ = Zb + (size_t)((chunk) * 64 + oi) * DM + h * 128 + oq * 32; const float* wn = p.w_onorm + oq * 32; \
            _Pragma("unroll") for (int k = 0; k < 4; ++k) { const u32x4 zw = zr[k]; const f32x4 w0 = *(const f32x4*)(wn + 8 * k) * rstd, w1 = *(const f32x4*)(wn + 8 * k + 4) * rstd; \
                u32x4 o; o.x = pk2(bflo(ov[k].x) * w0[0] * bflo(zw.x), bfhi(ov[k].x) * w0[1] * bfhi(zw.x)); \
                o.y = pk2(bflo(ov[k].y) * w0[2] * bflo(zw.y), bfhi(ov[k].y) * w0[3] * bfhi(zw.y)); \
                o.z = pk2(bflo(ov[k].z) * w1[0] * bflo(zw.z), bfhi(ov[k].z) * w1[1] * bfhi(zw.z)); \
                o.w = pk2(bflo(ov[k].w) * w1[2] * bflo(zw.w), bfhi(ov[k].w) * w1[3] * bfhi(zw.w)); \
                *(u32x4*)(zp_ + 8 * k) = o; asm volatile("" ::: "memory"); } } while (0)
        SCAN_LD_A(1); SCAN_LD_B(1);
        for (int n = 0; n < 32; ++n) {
            if (n + 1 < 32) { SCAN_ST_A((n + 1) & 1); SCAN_ST_B((n + 1) & 1); }
            if (n + 2 < 32) { SCAN_LD_A(n + 2); SCAN_LD_B(n + 2); }
            if (n >= 1) SCAN_NORM(Obase + ((n - 1) & 1) * OBUFB, n - 1);
            lds_barrier();
        }
        SCAN_NORM(Obase + OBUFB, 31);
#undef SCAN_LD_A
#undef SCAN_LD_B
#undef SCAN_ST_A
#undef SCAN_ST_B
#undef SCAN_ZLD
#undef SCAN_NORM
    }
    lds_barrier();
}

__device__ __forceinline__ void sample_prefetch(const Params& p, int it, f32x4 (&Sn)[8]) {
    const int tid = threadIdx.x; const float* S0 = p.state_ssm + (size_t)it * 16384 + (tid >> 5) * 1024 + (tid & 31) * 4;
#pragma unroll
    for (int i = 0; i < 8; ++i) Sn[i] = *(const f32x4*)(S0 + i * 128);
}
__device__ __forceinline__ void sample_item(const Params& p, LAS unsigned char* lds, int it, const f32x4 (&Sr)[8]) {
    const int tid = threadIdx.x, wid = tid >> 6, lane = tid & 63;
    const int b = it >> 4, h = it & 15, m = MP + b;
    const int e4 = (tid & 31) * 4, dg = tid >> 5;
    LAS float* vq = (LAS float*)lds;
    LAS float* red = vq + 384;
    LAS float* vnew = vq + 400;
    LAS float* part = vq + 1024;
    const bf16_t* qkv = (const bf16_t*)(p.ws + WS_QKV); const float* bg = (const float*)(p.ws + WS_BG); bf16_t* Zb = (bf16_t*)(p.ws + WS_Z);
    if (tid < 384) { const int sec = tid >> 7, c = tid & 127, col = sec * DM + h * 128 + c;
        float a = bf2f(qkv[(size_t)m * DQKV + col]) * p.w_conv[3 * DQKV + col];
#pragma unroll
        for (int j = 0; j < 3; ++j) a += p.state_conv[(size_t)(b * 3 + j) * DQKV + col] * p.w_conv[j * DQKV + col];
        vq[sec * 128 + c] = siluf_(a); }
    lds_barrier();
    if (wid < 2) { const float a = vq[wid * 128 + lane], c2 = vq[wid * 128 + 64 + lane]; const float s = wave_sum(a * a + c2 * c2); if (lane == 0) red[wid] = s; }
    lds_barrier();
    if (tid < 256) { const int sec = tid >> 7; const float rs = 1.0f / sqrtf(red[sec] + RMS_EPS) * (sec == 0 ? 0.08838834764831845f : 1.0f); vq[tid] *= rs; }
    lds_barrier();
    if (wid == 0) { const float s = wave_sum(vq[lane] * vq[128 + lane] + vq[64 + lane] * vq[192 + lane]); if (lane == 0) red[2] = s; }
    {
        f32x4 ks = {0.f, 0.f, 0.f, 0.f}, qs = {0.f, 0.f, 0.f, 0.f};
#pragma unroll
        for (int i = 0; i < 8; ++i) { const float kk = vq[128 + dg * 8 + i], qq = vq[dg * 8 + i]; ks += Sr[i] * kk; qs += Sr[i] * qq; }
        *(LAS f32x4*)(part + dg * 128 + e4) = ks; *(LAS f32x4*)(part + 2048 + dg * 128 + e4) = qs;
    }
    lds_barrier();
    const float beta = bg[(size_t)m * 32 + h], eg = __expf(bg[(size_t)m * 32 + 16 + h]);
    float o = 0.f;
    if (tid < 128) { float kS = 0.f, qS = 0.f;
#pragma unroll
        for (int d = 0; d < 16; ++d) { kS += part[d * 128 + tid]; qS += part[2048 + d * 128 + tid]; }
        const float vn = beta * (vq[256 + tid] - eg * kS); o = eg * qS + red[2] * vn; vnew[tid] = vn;
        const float s = wave_sum(o * o); if (lane == 0) red[4 + wid] = s; }
    lds_barrier();
    if (tid < 128) { const float rstd = 1.0f / sqrtf((red[4] + red[5]) * (1.f / 128.f) + RMS_EPS); bf16_t* zp = Zb + (size_t)m * DM + h * 128 + tid;
        *zp = (bf16_t)(pk2(o * rstd * p.w_onorm[tid] * bf2f(*zp), 0.f) & 0xffffu); }
    {
        float* So = p.out + O_SS + (size_t)it * 16384; const f32x4 vn4 = *(const LAS f32x4*)(vnew + e4);
#pragma unroll
        for (int i = 0; i < 8; ++i) { const float kk = vq[128 + dg * 8 + i]; *(f32x4*)(So + (dg * 8 + i) * 128 + e4) = Sr[i] * eg + vn4 * kk; }
    }
    lds_barrier();
}

__device__ __forceinline__ void mixerA_item(const Params& p, LAS unsigned char* lds, int it) {
    const int tid = threadIdx.x, wid = tid >> 6, lane = tid & 63, fr = lane & 15, fq = lane >> 4;
    const int b = it >> 8, c = (it >> 4) & 15, g = it & 15, m0 = b * SEQ + c * 128;
    LAS bf16_t* Wt = (LAS bf16_t*)lds;
    LAS bf16_t* VnT = (LAS bf16_t*)(lds + 34816);
    LAS float* st = (LAS float*)(lds + 68608);
    const float* vstat = (const float*)(p.ws + WS_VSTAT); const bf16_t* VA = (const bf16_t*)(p.ws + WS_VA); bf16_t* U = (bf16_t*)(p.ws + WS_U);
    if (tid < 128) { const float* sp = vstat + (size_t)(m0 + tid) * 64; float s = 0.f, s2 = 0.f;
#pragma unroll
        for (int k = 0; k < 16; ++k) { const f32x4 v = *(const f32x4*)(sp + 4 * k); s += v[0] + v[2]; s2 += v[1] + v[3]; }
        const float mu = s * (1.f / DM), var = fmaxf(s2 * (1.f / DM) - mu * mu, 0.f); st[2 * tid] = mu; st[2 * tid + 1] = 1.0f / sqrtf(var + LN_EPS); }
    {
        const float* ws_ = p.w_s + (size_t)g * 16384;
#pragma unroll
        for (int k = 0; k < 8; ++k) { const int idx = tid + 512 * k, t = idx >> 5, s4 = (idx & 31) * 4; f32x4 w = *(const f32x4*)(ws_ + t * 128 + s4);
#pragma unroll
            for (int e = 0; e < 4; ++e) if (s4 + e > t) w[e] = 0.f;
            *(LAS u32x2*)(Wt + t * 136 + s4) = (u32x2){pk2(w[0], w[1]), pk2(w[2], w[3])}; }
    }
    lds_barrier();
#pragma unroll
    for (int k = 0; k < 4; ++k) {
        const int q = tid + 512 * k, l = q & 63, grp = q >> 6, s = (grp >> 2) * 16 + (l >> 2), dc = (grp & 3) * 4 + (l & 3);
        const u32x4 raw = *(const u32x4*)(VA + (size_t)(m0 + s) * DM + g * 128 + dc * 8);
        const float mu = st[2 * s], rs = st[2 * s + 1];
        const float* gp = p.ln_v_g + g * 128 + dc * 8; const float* bp = p.ln_v_b + g * 128 + dc * 8;
        const f32x4 g0 = *(const f32x4*)gp, g1 = *(const f32x4*)(gp + 4), b0 = *(const f32x4*)bp, b1 = *(const f32x4*)(bp + 4);
        float v[8] = {bflo(raw.x), bfhi(raw.x), bflo(raw.y), bfhi(raw.y), bflo(raw.z), bfhi(raw.z), bflo(raw.w), bfhi(raw.w)};
#pragma unroll
        for (int e = 0; e < 8; ++e) { const float gg = e < 4 ? g0[e & 3] : g1[e & 3], bb = e < 4 ? b0[e & 3] : b1[e & 3]; const float y = (v[e] - mu) * rs * gg + bb;
            VnT[(dc * 8 + e) * 132 + s] = (bf16_t)(pk2(y, 0.f) & 0xffffu); }
    }
    lds_barrier();
    {
        bf16x8 wf[4];
        const int nks = ((16 * wid + 15) >> 5) + 1;
#pragma unroll
        for (int s = 0; s < 4; ++s) wf[s] = *(const LAS bf16x8*)(Wt + (16 * wid + fr) * 136 + 32 * s + 8 * fq);
        const int t = 16 * wid + fr; const float bs = p.b_s[g * 128 + t];
#pragma unroll
        for (int mb = 0; mb < 8; ++mb) {
            f32x4 acc = {0.f, 0.f, 0.f, 0.f};
#pragma unroll
            for (int s = 0; s < 4; ++s) if (s < nks) {
                const LAS bf16_t* vp = VnT + (16 * mb + fr) * 132 + 32 * s + 8 * fq; const u32x2 a0 = *(const LAS u32x2*)vp, a1 = *(const LAS u32x2*)(vp + 4);
                u32x4 aw = {a0.x, a0.y, a1.x, a1.y};
                acc = __builtin_amdgcn_mfma_f32_16x16x32_bf16(__builtin_bit_cast(bf16x8, aw), wf[s], acc, 0, 0, 0); }
            bf16_t* up = U + (size_t)(m0 + t) * DM + g * 128 + 16 * mb + 4 * fq; const u32x2 uw = *(const u32x2*)up;
            u32x2 o; o.x = pk2(bflo(uw.x) * (acc[0] + bs), bfhi(uw.x) * (acc[1] + bs)); o.y = pk2(bflo(uw.y) * (acc[2] + bs), bfhi(uw.y) * (acc[3] + bs));
            *(u32x2*)up = o;
        }
    }
    lds_barrier();
}

#define XB_TMO      128
#define XB_XCNT(j)  (256  + 64 * (j))
#define XB_XSUB(j)  (1280 + 64 * (j))
#define XB_XGEN(j)  (2304 + 64 * (j))
#define XB_TOP      3328
#define XB_TOPGEN   3392
#define XCD_BAR_WORDS 3456
#define XB_SPIN_CAP (1u << 18)
__device__ __forceinline__ unsigned xb_ld(unsigned* p)              { return __hip_atomic_load(p, __ATOMIC_RELAXED, __HIP_MEMORY_SCOPE_AGENT); }
__device__ __forceinline__ unsigned xb_add(unsigned* p, unsigned v) { return __hip_atomic_fetch_add(p, v, __ATOMIC_RELAXED, __HIP_MEMORY_SCOPE_AGENT); }
__device__ __forceinline__ unsigned xb_xcc_id() { return (unsigned)__builtin_amdgcn_s_getreg((3 << 11) | 20) & 0xFu; }
#define XB_SPIN(cond, bar) do { unsigned _sp = 0; while (cond) { __builtin_amdgcn_s_sleep(1); \
    if ((++_sp & 255u) == 0u) { if (xb_ld(&(bar)[XB_TMO])) break; if (_sp > XB_SPIN_CAP) { atomicAdd(&(bar)[XB_TMO], 1u); break; } } } } while (0)
struct XcdBarrier { unsigned* bar; unsigned x; volatile LAS unsigned* st; };
__device__ __forceinline__ XcdBarrier xcd_barrier_post(unsigned* bar, volatile LAS unsigned* st) {
    XcdBarrier b; b.bar = bar; b.x = xb_xcc_id(); b.st = st;
    if (threadIdx.x == 0) (void)xb_add(&bar[XB_XCNT(b.x)], 1u);
    return b;
}
__device__ __forceinline__ void xcd_barrier_complete(unsigned* bar, unsigned x, unsigned& nloc, unsigned& nx) {
    const unsigned G = gridDim.x * gridDim.y * gridDim.z;
    unsigned sum, cnt, mine, sp = 0u;
    for (;;) {
        sum = 0u; cnt = 0u; mine = 0u;
#pragma unroll
        for (unsigned j = 0; j < 16; ++j) { const unsigned c = xb_ld(&bar[XB_XCNT(j)]); sum += c; cnt += (c > 0u) ? 1u : 0u; mine = (j == x) ? c : mine; }
        if (sum == G) break;
        __builtin_amdgcn_s_sleep(1);
        if ((++sp & 255u) == 0u) { if (xb_ld(&bar[XB_TMO])) break; if (sp > XB_SPIN_CAP) { atomicAdd(&bar[XB_TMO], 1u); break; } }
    }
    nloc = mine > 0u ? mine : 1u; nx = cnt > 0u ? cnt : 1u;
}
__device__ __forceinline__ void xcd_barrier(const XcdBarrier& b) {
    asm volatile("s_waitcnt vmcnt(0)" ::: "memory");
    __syncthreads();
    if (threadIdx.x == 0) {
        unsigned* bar = b.bar;
        __builtin_amdgcn_s_waitcnt(0);
        unsigned nloc = b.st[0], nx = b.st[1];
        if (nloc == 0u) { xcd_barrier_complete(bar, b.x, nloc, nx); b.st[0] = nloc; b.st[1] = nx; }
        const unsigned old = xb_add(&bar[XB_XSUB(b.x)], 1u);
        const unsigned gen = old / nloc;
        if (old + 1u == (gen + 1u) * nloc) {
            __builtin_amdgcn_fence(__ATOMIC_RELEASE, "agent");
            asm volatile("s_waitcnt vmcnt(0)" ::: "memory");
            const unsigned og = xb_add(&bar[XB_TOP], 1u);
            const unsigned tg = og / nx;
            if (og + 1u == (tg + 1u) * nx) xb_add(&bar[XB_TOPGEN], 1u);
            else XB_SPIN(xb_ld(&bar[XB_TOPGEN]) == tg, bar);
            __builtin_amdgcn_fence(__ATOMIC_ACQUIRE, "agent");
            xb_add(&bar[XB_XGEN(b.x)], 1u);
            asm volatile("s_waitcnt vmcnt(0)" ::: "memory");
        } else {
            XB_SPIN(xb_ld(&bar[XB_XGEN(b.x)]) == gen, bar);
            __builtin_amdgcn_fence(__ATOMIC_ACQUIRE, "agent");
            asm volatile("s_waitcnt vmcnt(0)" ::: "memory");
        }
    }
    __syncthreads();
}

__device__ __forceinline__ unsigned char* opq(unsigned char* q) { asm volatile("" : "+s"(q)); return q; }
__global__ void __launch_bounds__(512, 2) mega_fwd(Params p) {
    extern __shared__ __attribute__((aligned(16))) unsigned char smem[];
    LAS unsigned char* lds = (LAS unsigned char*)smem;
    cg::grid_group grid = cg::this_grid();
    const int tid = threadIdx.x, wid = tid >> 6, lane = tid & 63, G = gridDim.x, blk = blockIdx.x;
    unsigned char* ws = p.ws;
#ifndef PHMASK
#define PHMASK 0x3ff
#endif
#define IN(k) (((PHMASK >> (k)) & 1) && p.ph_lo <= (k) && (k) < p.ph_hi)
#define SEAM(k) do { if (IN(k) && IN((k) + 1)) { if (p.coop == 2) grid.sync(); else xcd_barrier(xbar); } } while (0)
    volatile LAS unsigned* xst = (volatile LAS unsigned*)(lds + 160000);
    if (tid < 2) xst[tid] = 0u;
    __syncthreads();
    const XcdBarrier xbar = xcd_barrier_post((unsigned*)ws, xst);

    if (IN(0)) { unsigned char* ws = opq(p.ws);
        LAS float* scr = (LAS float*)(lds + wid * 16640);
        const int gw = blk * 8 + wid, NGW = G * 8;
        constexpr int I_IN = 32 * 256, I_BG = 32, I_P = 32 * 32, NIT = I_IN + I_BG + 3 * I_P;
        for (int it = gw; it < NIT; it += NGW) {
            int r = it;
            if (r < I_IN) { const int kb = r >> 8, nb = r & 255; const int n0 = nb < 192 ? 64 * nb : 12320 + 64 * (nb - 192); const int drow = nb < 192 ? n0 : n0 - 32;
                transpose64(p.w_in, 16416, (bf16_t*)(ws + WS_W1T), DM, 64 * kb, n0, drow, scr, lane); continue; }
            r -= I_IN;
            if (r < I_BG) { transpose_item(p.w_in, DM, 16416, (bf16_t*)(ws + WS_W1T), 16384, scr, r, 384, lane); continue; }
            r -= I_BG;
            if (r < I_P) { transpose64(p.w_proj_a, DM, (bf16_t*)(ws + WS_WPT), DM, 64 * (r >> 5), 64 * (r & 31), 64 * (r & 31), scr, lane); continue; } r -= I_P;
            if (r < I_P) { transpose64(p.w_proj_b, DM, (bf16_t*)(ws + WS_WPT), DM, 64 * (r >> 5), 64 * (r & 31), DM + 64 * (r & 31), scr, lane); continue; } r -= I_P;
            transpose64(p.w_o, DM, (bf16_t*)(ws + WS_WOT), DM, 64 * (r >> 5), 64 * (r & 31), 64 * (r & 31), scr, lane);
        }
        bf16_t* xb = (bf16_t*)(ws + WS_XB);
#pragma unroll 4
        for (size_t q = (size_t)blk * 512 + tid; q < (size_t)MPAD * DM / 8; q += (size_t)G * 512) {
            const size_t e = q * 8; const int row = (int)(e / DM);
            u32x4 o = {0u, 0u, 0u, 0u};
            if (row < MT) { const float* src = row < MP ? p.x_prompt + e : p.x_sample + (e - (size_t)MP * DM); const f32x4 a = *(const f32x4*)src, c2 = *(const f32x4*)(src + 4);
                o.x = pk2(a[0], a[1]); o.y = pk2(a[2], a[3]); o.z = pk2(c2[0], c2[1]); o.w = pk2(c2[2], c2[3]); }
            *(u32x4*)(xb + e) = o;
        }
        bf16_t* w1 = (bf16_t*)(ws + WS_W1T);
        for (size_t q = (size_t)blk * 512 + tid; q < (size_t)224 * DM / 8; q += (size_t)G * 512) *(u32x4*)(w1 + (size_t)16416 * DM + q * 8) = (u32x4){0u, 0u, 0u, 0u};
    }
    SEAM(0);
    if (IN(1)) { unsigned char* ws = opq(p.ws);
        pg8::Gemm g{(const bf16_t*)(ws + WS_XB), (const bf16_t*)(ws + WS_W1T), MPAD, N1, DM};
        pg8::Sched S; S.init(33, 65, G, blk, 0, 0, 0, 32);
        Epi1 E{ws, p.a_log, p.dt_bias};
        pg8::gemm_phase<Epi1>(lds, g, S, E);
    }
    SEAM(1);
    if (IN(2)) { unsigned char* ws = opq(p.ws);
        for (int it = blk; it < 2048; it += G) prescan_item(p, lds, it);
    }
    SEAM(2);
    if (IN(3)) { unsigned char* ws = opq(p.ws);
        const bool split = G > 64;
        if (blk < 64) { for (int bh = blk; bh < 64; bh += (split ? 64 : G)) scan_bh(p, lds, bh); }
        if (!split || blk >= 64) {
            const int oi = split ? blk - 64 : blk, on = split ? G - 64 : G;
            const bf16_t* qkv = (const bf16_t*)(ws + WS_QKV);
            for (int q = oi * 512 + tid; q < NBP * 3 * DQKV / 4; q += on * 512) { const int e = q * 4, col = e % DQKV, j = (e / DQKV) % 3, bb = e / (3 * DQKV);
                const u32x2 r = *(const u32x2*)(qkv + (size_t)(bb * SEQ + SEQ - 3 + j) * DQKV + col); *(f32x4*)(p.out + O_CP + e) = (f32x4){bflo(r.x), bfhi(r.x), bflo(r.y), bfhi(r.y)}; }
#pragma unroll 2
            for (int q = oi * 512 + tid; q < MS * 3 * DQKV / 4; q += on * 512) { const int e = q * 4, col = e % DQKV, j = (e / DQKV) % 3, bb = e / (3 * DQKV); f32x4 v;
                if (j < 2) v = *(const f32x4*)(p.state_conv + (size_t)(bb * 3 + j + 1) * DQKV + col);
                else { const u32x2 r = *(const u32x2*)(qkv + (size_t)(MP + bb) * DQKV + col); v = (f32x4){bflo(r.x), bfhi(r.x), bflo(r.y), bfhi(r.y)}; }
                *(f32x4*)(p.out + O_CS + e) = v; }
            const float* vstat = (const float*)(ws + WS_VSTAT); const bf16_t* VA = (const bf16_t*)(ws + WS_VA); bf16_t* U = (bf16_t*)(ws + WS_U);
            for (int row = oi * 8 + wid; row < MS; row += on * 8) { const int m = MP + row;
                const f32x2 st = lane < 32 ? *(const f32x2*)(vstat + (size_t)m * 64 + 2 * lane) : (f32x2){0.f, 0.f};
                const float s = wave_sum(st.x), s2 = wave_sum(st.y);
                const float mu = s * (1.f / DM), var = fmaxf(s2 * (1.f / DM) - mu * mu, 0.f), rs = 1.0f / sqrtf(var + LN_EPS);
#pragma unroll
                for (int k = 0; k < 8; ++k) { const int cc = (lane + 64 * k) * 4, gg = cc >> 7;
                    const u32x2 va = *(const u32x2*)(VA + (size_t)m * DM + cc); const f32x4 lg = *(const f32x4*)(p.ln_v_g + cc), lb = *(const f32x4*)(p.ln_v_b + cc);
                    f32x4 vn = {bflo(va.x), bfhi(va.x), bflo(va.y), bfhi(va.y)}; vn = (vn - mu) * rs * lg + lb;
                    *(f32x4*)(p.out + O_GV + (size_t)row * DM + cc) = vn;
                    const float w00 = p.w_s[(size_t)gg * 16384], bs0 = p.b_s[gg * 128];
                    bf16_t* up = U + (size_t)m * DM + cc; const u32x2 uw = *(const u32x2*)up;
                    *(u32x2*)up = (u32x2){pk2(bflo(uw.x) * (w00 * vn[0] + bs0), bfhi(uw.x) * (w00 * vn[1] + bs0)), pk2(bflo(uw.y) * (w00 * vn[2] + bs0), bfhi(uw.y) * (w00 * vn[3] + bs0))}; }
            }
        }
        {
            unsigned* qctr = (unsigned*)ws + 3584;
            volatile LAS int* slot = (volatile LAS int*)(lds + 160016);
            if (tid == 0) { slot[0] = (int)__hip_atomic_fetch_add(qctr, 1u, __ATOMIC_RELAXED, __HIP_MEMORY_SCOPE_AGENT); slot[1] = (int)__hip_atomic_fetch_add(qctr, 1u, __ATOMIC_RELAXED, __HIP_MEMORY_SCOPE_AGENT); }
            lds_barrier();
            int cur = slot[0], nxt = slot[1], par = 0;
            f32x4 Sr[8], Sn[8];
            if (cur < 2048) sample_prefetch(p, cur, Sr);
            lds_barrier();
            while (cur < 3072) {
                unsigned tick = 0u;
                if (tid == 0) tick = __hip_atomic_fetch_add(qctr, 1u, __ATOMIC_RELAXED, __HIP_MEMORY_SCOPE_AGENT);
                if (nxt < 2048) sample_prefetch(p, nxt, Sn);
                if (cur < 2048) sample_item(p, lds, cur, Sr); else mixerA_item(p, lds, cur - 2048);
                if (tid == 0) slot[par] = (int)tick;
                lds_barrier();
                const int nn = slot[par]; par ^= 1;
#pragma unroll
                for (int i = 0; i < 8; ++i) Sr[i] = Sn[i];
                cur = nxt; nxt = nn;
            }
        }
    }
    SEAM(3);
    if (IN(4)) { unsigned char* ws = opq(p.ws);
        pg8::Gemm g{(const bf16_t*)(ws + WS_U), (const bf16_t*)(ws + WS_WPT), 2 * MPAD, 2 * DM, DM};
        { pg8::Sched S; S.init(32, 8, G, blk, 1, 33, 8, 32); Epi4 E{ws}; pg8::gemm_phase<Epi4>(lds, g, S, E); }
        { pg8::Sched S; S.init_split(32, 8, 16, 2, G, blk, 1, 33, 8); EpiS4 E{ws}; pg8::gemm_phase<EpiS4>(lds, g, S, E); }
    }
    SEAM(4);
    if (IN(5)) { unsigned char* ws = opq(p.ws);
        {
            const float* part = (const float*)(ws + WS_PART); bf16_t* MB = (bf16_t*)(ws + WS_MB);
            for (int q = blk * 512 + tid; q < MS * DM / 4; q += G * 512) { f32x4 v = *(const f32x4*)(part + 4 * q);
#pragma unroll 8
                for (int sl = 1; sl < 32; ++sl) v += *(const f32x4*)(part + (size_t)sl * MS * DM + 4 * q);
                *(u32x2*)(MB + (size_t)MP * DM + 4 * q) = (u32x2){pk2(v[0], v[1]), pk2(v[2], v[3])}; }
        }
        pg8::Gemm g{(const bf16_t*)(ws + WS_MB), (const bf16_t*)(ws + WS_WOT), MPAD, DM, DM};
        { pg8::Sched S; S.init(32, 8, G, blk, 0, 0, 0, 32); EpiRes E{p.x_prompt, nullptr, (bf16_t*)(ws + WS_R1)}; pg8::gemm_phase<EpiRes>(lds, g, S, E); }
        xcd_barrier(xbar);
        { pg8::Sched S; S.init_split(32, 8, 16, 2, G, blk, 0, 0, 0); EpiSPart E{(float*)(ws + WS_PART), DM}; pg8::gemm_phase<EpiSPart>(lds, g, S, E); }
    }
    SEAM(5);
    if (IN(6)) { unsigned char* ws = opq(p.ws);
        const int gw = blk * 8 + wid, NGW = G * 8;
        for (int m = gw; m < MT; m += NGW) {
            if (m < MP) ln_row_b((const bf16_t*)(ws + WS_R1) + (size_t)m * DM, p.ln1_g, p.ln1_b, nullptr, (bf16_t*)(ws + WS_X1B) + (size_t)m * DM, lane);
            else ln_row((const float*)(ws + WS_PART) + (size_t)(m - MP) * DM, p.ln1_g, p.ln1_b, (float*)(ws + WS_X1) + (size_t)m * DM, (bf16_t*)(ws + WS_X1B) + (size_t)m * DM, lane, 16, (size_t)MS * DM, p.x_sample + (size_t)(m - MP) * DM);
        }
        LAS float* scr = (LAS float*)(lds + wid * 16640);
        for (int it = gw; it < 8192; it += NGW) {
            if (it < 4096) transpose64(p.w_up, DFF, (bf16_t*)(ws + WS_WUPT), DM, 64 * (it >> 7), 64 * (it & 127), 64 * (it & 127), scr, lane);
            else { const int r = it - 4096; transpose64(p.w_down, DM, (bf16_t*)(ws + WS_WDNT), DFF, 64 * (r >> 5), 64 * (r & 31), 64 * (r & 31), scr, lane); }
        }
    }
    SEAM(6);
    if (IN(7)) { unsigned char* ws = opq(p.ws);
        pg8::Gemm g{(const bf16_t*)(ws + WS_X1B), (const bf16_t*)(ws + WS_WUPT), MPAD, DFF, DM};
        { pg8::Sched S; S.init(32, 32, G, blk, 0, 0, 0, 32); Epi7 E{(bf16_t*)(ws + WS_H)}; pg8::gemm_phase<Epi7>(lds, g, S, E); }
        { pg8::Sched S; S.init_split(32, 32, 8, 4, G, blk, 0, 0, 0); EpiSPart E{(float*)(ws + WS_PART), DFF}; pg8::gemm_phase<EpiSPart>(lds, g, S, E); }
    }
    SEAM(7);
    if (IN(8)) { unsigned char* ws = opq(p.ws);
        {
            const float* part = (const float*)(ws + WS_PART); bf16_t* H = (bf16_t*)(ws + WS_H);
            for (int q = blk * 512 + tid; q < MS * DFF / 4; q += G * 512) { f32x4 v = *(const f32x4*)(part + 4 * q);
#pragma unroll
                for (int sl = 1; sl < 8; ++sl) v += *(const f32x4*)(part + (size_t)sl * MS * DFF + 4 * q);
#pragma unroll
                for (int e = 0; e < 4; ++e) { const float a = fmaxf(v[e], 0.f); v[e] = a * a; }
                *(u32x2*)(H + (size_t)MP * DFF + 4 * q) = (u32x2){pk2(v[0], v[1]), pk2(v[2], v[3])}; }
        }
        pg8::Gemm g{(const bf16_t*)(ws + WS_H), (const bf16_t*)(ws + WS_WDNT), MPAD, DM, DFF};
        { pg8::Sched S; S.init(32, 8, G, blk, 0, 0, 0, 128); EpiRes E{nullptr, (const bf16_t*)(ws + WS_X1B), (bf16_t*)(ws + WS_R2)}; pg8::gemm_phase<EpiRes>(lds, g, S, E); }
        xcd_barrier(xbar);
        { pg8::Sched S; S.init_split(32, 8, 32, 4, G, blk, 0, 0, 0); EpiSPart E{(float*)(ws + WS_PART), DM}; pg8::gemm_phase<EpiSPart>(lds, g, S, E); }
    }
    SEAM(8);
    if (IN(9)) { unsigned char* ws = opq(p.ws);
        const int gw = blk * 8 + wid, NGW = G * 8;
        for (int m = gw; m < MT; m += NGW) {
            if (m < MP) ln_row_b((const bf16_t*)(ws + WS_R2) + (size_t)m * DM, p.ln2_g, p.ln2_b, p.out + (size_t)m * DM, nullptr, lane);
            else ln_row((const float*)(ws + WS_PART) + (size_t)(m - MP) * DM, p.ln2_g, p.ln2_b, p.out + (size_t)m * DM, nullptr, lane, 32, (size_t)MS * DM, (const float*)(ws + WS_X1) + (size_t)m * DM);
        }
    }
#undef IN
#undef SEAM
}

extern "C" void kernel_launch(void* const* d_in, const int* in_sizes, int n_in, void* d_out, int out_size, void* d_ws, size_t ws_size, hipStream_t stream) {
    static int grid = 0;
    if (grid == 0) {
        int dev = 0, cus = 0, per_cu = 0;
        if (n_in != 22 || ws_size < WS_END) { fprintf(stderr, "kernel_launch: unexpected inputs (n_in %d, ws %zu)\n", n_in, ws_size); grid = -1; return; }
        hipGetDevice(&dev);
        hipDeviceGetAttribute(&cus, hipDeviceAttributeMultiprocessorCount, dev);
        if (hipFuncSetAttribute((const void*)mega_fwd, hipFuncAttributeMaxDynamicSharedMemorySize, LDS_BYTES) != hipSuccess) { fprintf(stderr, "kernel_launch: hipFuncSetAttribute failed\n"); grid = -1; return; }
        if (hipOccupancyMaxActiveBlocksPerMultiprocessor(&per_cu, (const void*)mega_fwd, 512, LDS_BYTES) != hipSuccess || per_cu < 1) { fprintf(stderr, "kernel_launch: occupancy query says %d\n", per_cu); per_cu = 1; }
        (void)hipGetLastError();
        grid = cus;
    }
    if (grid < 0) return;
    Params p{};
    const float** pp = (const float**)&p;
    for (int i = 0; i < 22; ++i) pp[i] = (const float*)d_in[i];
    p.out = (float*)d_out; p.ws = (unsigned char*)d_ws; p.ph_lo = 0; p.ph_hi = 10; p.coop = 1; p.pad = 0;
    if (hipMemsetAsync(d_ws, 0, 16384, stream) != hipSuccess) { fprintf(stderr, "kernel_launch: memset failed\n"); return; }
    void* args[] = {&p};
    hipError_t e = hipLaunchCooperativeKernel((const void*)mega_fwd, dim3(grid), dim3(512), args, LDS_BYTES, stream);
    if (e != hipSuccess) fprintf(stderr, "cooperative launch failed: %s (grid %d)\n", hipGetErrorString(e), grid);
}
```

```cpp
#include <hip/hip_runtime.h>
#include <hip/hip_cooperative_groups.h>
#include <cstdio>
#include <cstdint>
namespace cg = cooperative_groups;

#define LAS __attribute__((address_space(3)))
typedef unsigned short bf16_t;
typedef short bf16x8 __attribute__((ext_vector_type(8)));
typedef short s16x4 __attribute__((ext_vector_type(4)));
typedef float f32x2 __attribute__((ext_vector_type(2)));
typedef float f32x4 __attribute__((ext_vector_type(4)));
typedef float f32x16 __attribute__((ext_vector_type(16)));
typedef unsigned u32x2 __attribute__((ext_vector_type(2)));
typedef unsigned u32x4 __attribute__((ext_vector_type(4)));

constexpr int DM = 2048, SEQ = 2048, NBP = 4, MP = 8192, MS = 128, MT = 8320, MPAD = 8448;
constexpr int N1 = 16640, DFF = 8192, DQKV = 6144;
constexpr float ALPHA = 1.189207115002721f, LN_EPS = 1e-5f, RMS_EPS = 1e-6f;
constexpr int LDS_BYTES = 160768;
constexpr size_t MiB = 1u << 20;
constexpr size_t WS_BG = 1 * MiB, WS_VSTAT = 3 * MiB, WS_GL = 6 * MiB;
constexpr size_t WS_WPT = 8 * MiB, WS_WOT = 24 * MiB, WS_U = 32 * MiB, WS_Z = 65 * MiB, WS_VA = 98 * MiB, WS_QKV = 131 * MiB;
constexpr size_t WS_GA = 230 * MiB, WS_GB = 263 * MiB, WS_W1T = 296 * MiB, WS_XB = 361 * MiB, WS_PS = 296 * MiB;
constexpr size_t WS_MTMP = 296 * MiB, WS_MB = 362 * MiB, WS_R1 = 395 * MiB, WS_H = 296 * MiB;
constexpr size_t WS_WUPT = 440 * MiB, WS_WDNT = 472 * MiB,
     WS_X1 = 131 * MiB, WS_X1B = 197 * MiB, WS_R2 = 230 * MiB;
constexpr size_t WS_PART = 98 * MiB;
constexpr size_t WS_END = 504 * MiB;
constexpr int PS_ITEM = 73728;
constexpr int PS_W = 0, PS_KCD = 16384, PS_QD = 32768, PS_KDT = 49152, PS_AT = 65536;
constexpr size_t O_YP = 0, O_YS = 16777216, O_CP = 17039360, O_SP = 17113088, O_GV = 18161664, O_CS = 18423808, O_SS = 20783104;

__device__ __forceinline__ unsigned pk2(float lo, float hi) { typedef __bf16 b2 __attribute__((ext_vector_type(2))); f32x2 v = {lo, hi}; b2 b = __builtin_convertvector(v, b2); return __builtin_bit_cast(unsigned, b); }
__device__ __forceinline__ float bf2f(unsigned short b) { return __uint_as_float((unsigned)b << 16); }
__device__ __forceinline__ float bflo(unsigned w) { return __uint_as_float(w << 16); }
__device__ __forceinline__ float bfhi(unsigned w) { return __uint_as_float(w & 0xffff0000u); }
__device__ __forceinline__ float sigmoidf_(float x) { return 1.0f / (1.0f + __expf(-x)); }
__device__ __forceinline__ float siluf_(float x) { return x / (1.0f + __expf(-x)); }
__device__ __forceinline__ float wave_sum(float v) {
#pragma unroll
    for (int o = 1; o < 64; o <<= 1) v += __shfl_xor(v, o);
    return v;
}
__device__ __forceinline__ void lds_barrier() { asm volatile("s_waitcnt lgkmcnt(0)\n\ts_barrier" ::: "memory"); }
__device__ __forceinline__ f32x2 gelu_pk(f32x2 v) {
    const f32x2 av = __builtin_elementwise_abs(v), d = av * 0.2316418882f + 1.0f;
    f32x2 t; t.x = __builtin_amdgcn_rcpf(d.x); t.y = __builtin_amdgcn_rcpf(d.y);
    f32x2 q = t * 0.5307027145f + (-0.7265760135f); q = q * t + 0.7107068705f; q = q * t + (-0.142248368f); q = q * t + 0.127414796f; q = q * t;
    const f32x2 s = (v * v) * (-0.72134752044f);
    f32x2 e; e.x = __builtin_amdgcn_exp2f(s.x); e.y = __builtin_amdgcn_exp2f(s.y);
    const f32x2 m = v * (q * e), r = v - m;
    f32x2 o; o.x = v.x < 0.f ? m.x : r.x; o.y = v.y < 0.f ? m.y : r.y; return o;
}
__device__ __forceinline__ f32x4 gelu4(f32x4 v) { f32x2 a = gelu_pk((f32x2){v[0], v[1]}), b = gelu_pk((f32x2){v[2], v[3]}); return (f32x4){a.x, a.y, b.x, b.y}; }

namespace pg8 {
constexpr int BM = 256, BK = 64, HALF = 128, HTB = HALF * BK * 2, STAGE_BYTES = 8 * HTB, NXCD = 8, WGM = 8;
__host__ __device__ __forceinline__ int lds_byte(int r, int c) { const int st = (r >> 4) * 2 + (c >> 5), rr = r & 15, cc = c & 31, ob = rr * 64 + cc * 2; return st * 1024 + (ob ^ (((ob >> 9) & 1) << 5)); }
__host__ __device__ __forceinline__ void stage_rc(int b, int& R, int& C) { const int st = b / 1024, sb = b % 1024, swz = sb ^ (((sb >> 9) & 1) << 5); R = (st >> 1) * 16 + swz / 64; C = (st & 1) * 32 + (swz % 64) / 2; }
__host__ __device__ __forceinline__ int perm32(int rho) { const int n = rho >> 4, i = rho & 15; return 8 * (i >> 2) + 4 * n + (i & 3); }
struct Unit { int pm, pn, k0, nt; };
struct Gemm { const bf16_t* A; const bf16_t* Bt; int M, N, K; };
struct Sched {
    int nM, nN, nwg, G, c, pairs, offM, offN, ntK;
    int split, sM, sNt, sSl, sNtK;
    __device__ void init(int nM_, int nN_, int G_, int c_, int pairs_, int offM_, int offN_, int ntK_) { nM = nM_; nN = nN_; nwg = nM * nN; G = G_; c = c_; pairs = pairs_; offM = offM_; offN = offN_; ntK = ntK_; split = 0; sM = 0; sNt = 0; sSl = 0; sNtK = 0; }
    __device__ void init_split(int sM_, int nN_, int slices, int ntk_slice, int G_, int c_, int pairs_, int offM_, int offN_) { init(1, nN_, G_, c_, pairs_, offM_, offN_, ntk_slice); split = 1; sM = sM_; sNt = nN_; sSl = slices; sNtK = ntk_slice; nwg = nN_ * slices * (pairs_ ? 2 : 1); }
    __device__ bool next(int i, Unit& u) const {
        if (split) {
            const int L = i * G + c; if (L >= nwg) return false;
            const int sl = L % sSl, r = L / sSl, pn = r % sNt, which = r / sNt;
            u.pm = sM + which * offM; u.pn = pn + which * offN; u.k0 = sl * sNtK; u.nt = sNtK; return true;
        }
        const int j = pairs ? (i >> 1) : i, which = pairs ? (i & 1) : 0;
        const long L = (long)j * G + c; if (L >= nwg) return false;
        int wgid = (int)L; { const int q = nwg / NXCD, r = nwg % NXCD, xcd = wgid % NXCD, off = wgid / NXCD; wgid = (xcd < r ? xcd * (q + 1) : r * (q + 1) + (xcd - r) * q) + off; }
        const int nig = WGM * nN, gid = wgid / nig, fm = gid * WGM, gsz = (nM - fm) < WGM ? (nM - fm) : WGM;
        u.pm = fm + ((wgid % nig) % gsz) + which * offM; u.pn = (wgid % nig) / gsz + which * offN; u.k0 = 0; u.nt = ntK; return true;
    }
};

template <class Epi>
__device__ __forceinline__ void gemm_phase(LAS unsigned char* lds, const Gemm g, const Sched& S, const Epi& E) {
    const int tid = threadIdx.x, wid = __builtin_amdgcn_readfirstlane(tid >> 6), lane = tid & 63, wr = wid >> 2, wc = wid & 3, fr = lane & 15, fq = lane >> 4;
    const int K = g.K;
    unsigned voffA[2], voffB[2];
#pragma unroll
    for (int i = 0; i < 2; ++i) { int R, C; stage_rc(tid * 16 + i * 8192, R, C); const int Rb = (R & ~31) + perm32(R & 31);
        voffA[i] = (unsigned)(R * K + C) * 2u; voffB[i] = (unsigned)(Rb * K + C) * 2u; }
    const size_t kstep = (size_t)(BK * 2);
    const size_t hstep = (size_t)HALF * K * 2;
    const size_t tstep = 2 * hstep;
    const unsigned ldsw = (unsigned)wid * 1024u;
    const int aoff = lds_byte(wr * 64 + fr, fq * 8), boff = lds_byte(wc * 32 + fr, fq * 8);
#define PG8_SA(b, h) (((b) * 2 + (h)) * HTB)
#define PG8_SB(b, h) ((4 + (b) * 2 + (h)) * HTB)
#define PG8_STAGE(bufoff, gbase, voff) do { _Pragma("unroll") for (int _i = 0; _i < 2; ++_i) \
        __builtin_amdgcn_global_load_lds((const unsigned*)((const char*)(gbase) + (voff)[_i]), (LAS unsigned*)(lds + (bufoff) + ldsw + _i * 8192), 16, 0, 0); } while (0)
#define PG8_LDA(dst, b, h) do { _Pragma("unroll") for (int m = 0; m < 4; ++m) _Pragma("unroll") for (int k = 0; k < 2; ++k) dst[m][k] = *(const LAS bf16x8*)(lds + PG8_SA(b, h) + aoff + m * 2048 + k * 1024); } while (0)
#define PG8_LDB(dst, b, h) do { _Pragma("unroll") for (int n = 0; n < 2; ++n) _Pragma("unroll") for (int k = 0; k < 2; ++k) dst[n][k] = *(const LAS bf16x8*)(lds + PG8_SB(b, h) + boff + n * 2048 + k * 1024); } while (0)
#define PG8_MMA(ai, bj, At, Bt) do { __builtin_amdgcn_s_setprio(1); _Pragma("unroll") for (int m = 0; m < 4; ++m) _Pragma("unroll") for (int n = 0; n < 2; ++n) _Pragma("unroll") for (int k = 0; k < 2; ++k) \
        acc[ai][bj][m][n] = __builtin_amdgcn_mfma_f32_16x16x32_bf16(Bt[n][k], At[m][k], acc[ai][bj][m][n], 0, 0, 0); __builtin_amdgcn_s_setprio(0); } while (0)
#define PG8_WAIT_V(n) asm volatile("s_waitcnt vmcnt(" #n ")" ::: "memory")
#define PG8_WAIT_L(n) asm volatile("s_waitcnt lgkmcnt(" #n ")" ::: "memory")
#define PG8_BAR __builtin_amdgcn_s_barrier()
#define PG8_SCHED __builtin_amdgcn_sched_barrier(0)
    Unit cur, nxt; int ui = 0;
    if (!S.next(0, cur)) return;
    f32x4 acc[2][2][4][2];
#pragma unroll
    for (int a = 0; a < 2; ++a)
#pragma unroll
        for (int b = 0; b < 2; ++b)
#pragma unroll
            for (int m = 0; m < 4; ++m)
#pragma unroll
                for (int n = 0; n < 2; ++n) acc[a][b][m][n] = (f32x4){0.f, 0.f, 0.f, 0.f};
    bf16x8 At[4][2], B0[2][2], B1[2][2];
    const char* cA = (const char*)g.A + (size_t)cur.pm * tstep + (size_t)cur.k0 * kstep; const char* cB = (const char*)g.Bt + (size_t)cur.pn * tstep + (size_t)cur.k0 * kstep;
    PG8_STAGE(PG8_SB(0, 0), cB, voffB); PG8_STAGE(PG8_SB(0, 1), cB + hstep, voffB); PG8_STAGE(PG8_SA(0, 0), cA, voffA); PG8_STAGE(PG8_SA(0, 1), cA + hstep, voffA);
    if (wr == 1) PG8_BAR;
    PG8_WAIT_V(2); PG8_BAR;
    PG8_STAGE(PG8_SB(1, 0), cB + kstep, voffB); PG8_STAGE(PG8_SA(1, 0), cA + kstep, voffA); PG8_STAGE(PG8_SB(1, 1), cB + hstep + kstep, voffB);
    PG8_WAIT_V(6); PG8_BAR;
    for (;;) {
        const bool has_next = S.next(ui + 1, nxt);
        const char* nA = has_next ? (const char*)g.A + (size_t)nxt.pm * tstep + (size_t)nxt.k0 * kstep : cA; const char* nB = has_next ? (const char*)g.Bt + (size_t)nxt.pn * tstep + (size_t)nxt.k0 * kstep : cB;
        const int nt = cur.nt;
        for (int t = 0; t < nt; t += 2) {
            const bool last = (t == nt - 2);
            const char* a1 = cA + (size_t)(t + 1) * kstep;
            const char* a2 = last ? nA : cA + (size_t)(t + 2) * kstep; const char* b2 = last ? nB : cB + (size_t)(t + 2) * kstep;
            const char* a3 = a2 + kstep; const char* b3 = b2 + kstep;
            PG8_LDB(B0, 0, 0); PG8_LDB(B1, 0, 1); PG8_SCHED; PG8_LDA(At, 0, 0); PG8_STAGE(PG8_SA(1, 1), a1 + hstep, voffA);
            PG8_WAIT_V(8); PG8_WAIT_L(0); PG8_BAR; PG8_MMA(0, 0, At, B0); PG8_MMA(0, 1, At, B1); PG8_BAR; PG8_SCHED;
            PG8_LDA(At, 0, 1); PG8_STAGE(PG8_SB(0, 0), b2, voffB); PG8_STAGE(PG8_SB(0, 1), b2 + hstep, voffB); PG8_STAGE(PG8_SA(0, 0), a2, voffA);
            PG8_WAIT_V(8); PG8_WAIT_L(0); PG8_BAR; PG8_MMA(1, 0, At, B0); PG8_MMA(1, 1, At, B1); PG8_BAR; PG8_SCHED;
            PG8_LDB(B0, 1, 0); PG8_LDB(B1, 1, 1); PG8_SCHED; PG8_LDA(At, 1, 0); PG8_STAGE(PG8_SA(0, 1), a2 + hstep, voffA);
            PG8_WAIT_V(8); PG8_WAIT_L(0); PG8_BAR; PG8_MMA(0, 0, At, B0); PG8_MMA(0, 1, At, B1); PG8_BAR; PG8_SCHED;
            PG8_LDA(At, 1, 1); PG8_STAGE(PG8_SB(1, 0), b3, voffB); PG8_STAGE(PG8_SB(1, 1), b3 + hstep, voffB); PG8_STAGE(PG8_SA(1, 0), a3, voffA);
            PG8_WAIT_V(8); PG8_WAIT_L(0); PG8_BAR; PG8_MMA(1, 0, At, B0); PG8_MMA(1, 1, At, B1); PG8_BAR; PG8_SCHED;
        }
        if (wr == 0) PG8_BAR;
        E(acc, cur, wr, wc, fr, fq);
        if (!has_next) break;
#pragma unroll
        for (int a = 0; a < 2; ++a)
#pragma unroll
            for (int b = 0; b < 2; ++b)
#pragma unroll
                for (int m = 0; m < 4; ++m)
#pragma unroll
                    for (int n = 0; n < 2; ++n) acc[a][b][m][n] = (f32x4){0.f, 0.f, 0.f, 0.f};
        cur = nxt; cA = nA; cB = nB; ++ui;
        if (wr == 1) PG8_BAR;
    }
    PG8_WAIT_V(0);
    PG8_BAR;
#undef PG8_SA
#undef PG8_SB
#undef PG8_STAGE
#undef PG8_LDA
#undef PG8_LDB
#undef PG8_MMA
#undef PG8_WAIT_V
#undef PG8_WAIT_L
#undef PG8_BAR
#undef PG8_SCHED
}
}
using pg8::Unit;
typedef f32x4 Acc[2][2][4][2];

struct Params {
    const float *x_prompt, *x_sample, *state_conv, *state_ssm, *w_in, *w_s, *b_s, *ln_v_g, *ln_v_b, *w_conv, *a_log, *dt_bias, *w_onorm,
                *w_proj_a, *w_proj_b, *w_o, *ln1_g, *ln1_b, *w_up, *w_down, *ln2_g, *ln2_b;
    float* out; unsigned char* ws; int ph_lo, ph_hi, coop, pad;
};

__device__ __forceinline__ void store8bf(bf16_t* p, f32x4 v0, f32x4 v1) { u32x4 w; w.x = pk2(v0[0], v0[1]); w.y = pk2(v0[2], v0[3]); w.z = pk2(v1[0], v1[1]); w.w = pk2(v1[2], v1[3]); *(u32x4*)p = w; }

struct Epi1 {
    unsigned char* ws; const float* a_log; const float* dt_bias;
    __device__ __forceinline__ void operator()(const Acc& acc, const Unit& u, int wr, int wc, int fr, int fq) const {
        const int pn = u.pn; const int row0 = u.pm * 256 + wr * 64 + fr; const int cl = wc * 32 + 8 * fq;
        if (pn < 64) {
            int act, ld, cb; size_t boff;
            if (pn < 8) { boff = WS_U; act = 1; ld = DM; cb = pn * 256; }
            else if (pn < 16) { boff = WS_VA; act = 1; ld = DM; cb = (pn - 8) * 256; }
            else if (pn < 40) { boff = WS_QKV; act = 0; ld = DQKV; cb = (pn - 16) * 256; }
            else if (pn < 48) { boff = WS_Z; act = 2; ld = DM; cb = (pn - 40) * 256; }
            else if (pn < 56) { boff = WS_GA; act = 3; ld = DM; cb = (pn - 48) * 256; }
            else { boff = WS_GB; act = 3; ld = DM; cb = (pn - 56) * 256; }
            const bool stats = (pn >= 8 && pn < 16);
            bf16_t* base = (bf16_t*)(ws + boff);
            float* vstat = (float*)(ws + WS_VSTAT) + ((pn - 8) * 4 + wc) * 2;
            const unsigned off0 = (unsigned)(row0 * ld + cb + cl);
#pragma unroll
            for (int ai = 0; ai < 2; ++ai)
#pragma unroll
                for (int m = 0; m < 4; ++m) {
                    const unsigned off = off0 + (unsigned)((ai * 128 + m * 16) * ld); float s = 0.f, s2 = 0.f;
#pragma unroll
                    for (int bj = 0; bj < 2; ++bj) { f32x4 v0 = acc[ai][bj][m][0], v1 = acc[ai][bj][m][1];
                        if (act == 1) { v0 = gelu4(v0); v1 = gelu4(v1); }
                        else if (act >= 2) {
#pragma unroll
                            for (int e = 0; e < 4; ++e) { const float t0 = sigmoidf_(v0[e]), t1 = sigmoidf_(v1[e]); v0[e] = act == 2 ? v0[e] * t0 : t0; v1[e] = act == 2 ? v1[e] * t1 : t1; } }
                        if (stats) {
#pragma unroll
                            for (int e = 0; e < 4; ++e) { s += v0[e] + v1[e]; s2 += v0[e] * v0[e] + v1[e] * v1[e]; } }
                        store8bf(base + off + bj * 128, v0, v1); }
                    if (stats) { s += __shfl_xor(s, 16); s += __shfl_xor(s, 32); s2 += __shfl_xor(s2, 16); s2 += __shfl_xor(s2, 32);
                        if (fq == 0) { float* sp = vstat + (unsigned)((row0 + ai * 128 + m * 16) * 64); sp[0] = s; sp[1] = s2; } }
                    __builtin_amdgcn_sched_barrier(0);
                }
        } else if (wc == 0) {
            float* bg = (float*)(ws + WS_BG);
            const unsigned boff0 = (unsigned)(row0 * 32 + 8 * fq);
            if (fq < 2) {
#pragma unroll
                for (int ai = 0; ai < 2; ++ai)
#pragma unroll
                    for (int m = 0; m < 4; ++m) {
#pragma unroll
                        for (int n = 0; n < 2; ++n) { const f32x4 v = acc[ai][0][m][n]; f32x4 o;
#pragma unroll
                            for (int e = 0; e < 4; ++e) o[e] = sigmoidf_(v[e]);
                            *(f32x4*)(bg + boff0 + (unsigned)((ai * 128 + m * 16) * 32 + 4 * n)) = o; }
                        __builtin_amdgcn_sched_barrier(0); }
            } else {
                const int h0 = 8 * (fq - 2);
#pragma unroll
                for (int n = 0; n < 2; ++n) {
                    f32x4 na = *(const f32x4*)(a_log + h0 + 4 * n); const f32x4 db = *(const f32x4*)(dt_bias + h0 + 4 * n);
#pragma unroll
                    for (int e = 0; e < 4; ++e) na[e] = -__expf(na[e]);
#pragma unroll
                    for (int ai = 0; ai < 2; ++ai)
#pragma unroll
                        for (int m = 0; m < 4; ++m) { const f32x4 v = acc[ai][0][m][n]; f32x4 o;
#pragma unroll
                            for (int e = 0; e < 4; ++e) { const float xx = v[e] + db[e]; const float sp = xx > 20.f ? xx : __logf(1.0f + __expf(xx)); o[e] = na[e] * sp; }
                            *(f32x4*)(bg + boff0 + (unsigned)((ai * 128 + m * 16) * 32 + 4 * n)) = o;
                            __builtin_amdgcn_sched_barrier(0); }
                }
            }
        }
    }
};
struct Epi4 {
    unsigned char* ws;
    __device__ __forceinline__ void operator()(const Acc& acc, const Unit& u, int wr, int wc, int fr, int fq) const {
        const int which = u.pm >= 33 ? 1 : 0; const int pm = u.pm - 33 * which, pn = u.pn - 8 * which;
        const bf16_t* gate = (const bf16_t*)(ws + (which ? WS_GB : WS_GA)); bf16_t* mt = (bf16_t*)(ws + WS_MTMP); bf16_t* mb = (bf16_t*)(ws + WS_MB);
        const int row0 = pm * 256 + wr * 64 + fr, col0 = pn * 256 + wc * 32 + 8 * fq;
#pragma unroll
        for (int ai = 0; ai < 2; ++ai)
#pragma unroll
            for (int m = 0; m < 4; ++m) { const size_t off = (size_t)(row0 + ai * 128 + m * 16) * DM + col0;
#pragma unroll
                for (int bj = 0; bj < 2; ++bj) { const u32x4 gw = *(const u32x4*)(gate + off + bj * 128);
                    f32x4 g0 = {bflo(gw.x), bfhi(gw.x), bflo(gw.y), bfhi(gw.y)}, g1 = {bflo(gw.z), bfhi(gw.z), bflo(gw.w), bfhi(gw.w)};
                    f32x4 v0 = acc[ai][bj][m][0] * g0, v1 = acc[ai][bj][m][1] * g1;
                    if (which == 0) store8bf(mt + off + bj * 128, v0, v1);
                    else { const u32x4 tw = *(const u32x4*)(mt + off + bj * 128); v0 += (f32x4){bflo(tw.x), bfhi(tw.x), bflo(tw.y), bfhi(tw.y)}; v1 += (f32x4){bflo(tw.z), bfhi(tw.z), bflo(tw.w), bfhi(tw.w)}; store8bf(mb + off + bj * 128, v0, v1); } } }
    }
};
struct EpiRes {
    __device__ __forceinline__ void done(const Unit&) const {}
    const float* resf; const bf16_t* resb; bf16_t* out;
    __device__ __forceinline__ void operator()(const Acc& acc, const Unit& u, int wr, int wc, int fr, int fq) const {
        const int row0 = u.pm * 256 + wr * 64 + fr, col0 = u.pn * 256 + wc * 32 + 8 * fq;
#pragma unroll
        for (int ai = 0; ai < 2; ++ai)
#pragma unroll
            for (int m = 0; m < 4; ++m) { const size_t off = (size_t)(row0 + ai * 128 + m * 16) * DM + col0;
#pragma unroll
                for (int bj = 0; bj < 2; ++bj) { f32x4 r0, r1;
                    if (resf) { r0 = *(const f32x4*)(resf + off + bj * 128); r1 = *(const f32x4*)(resf + off + bj * 128 + 4); }
                    else { const u32x4 w = *(const u32x4*)(resb + off + bj * 128); r0 = (f32x4){bflo(w.x), bfhi(w.x), bflo(w.y), bfhi(w.y)}; r1 = (f32x4){bflo(w.z), bfhi(w.z), bflo(w.w), bfhi(w.w)}; }
                    store8bf(out + off + bj * 128, r0 * ALPHA + acc[ai][bj][m][0], r1 * ALPHA + acc[ai][bj][m][1]); } }
    }
};
struct Epi7 {
    bf16_t* H;
    __device__ __forceinline__ void operator()(const Acc& acc, const Unit& u, int wr, int wc, int fr, int fq) const {
        const int row0 = u.pm * 256 + wr * 64 + fr, col0 = u.pn * 256 + wc * 32 + 8 * fq;
#pragma unroll
        for (int ai = 0; ai < 2; ++ai)
#pragma unroll
            for (int m = 0; m < 4; ++m) { const size_t off = (size_t)(row0 + ai * 128 + m * 16) * DFF + col0;
#pragma unroll
                for (int bj = 0; bj < 2; ++bj) { f32x4 v0 = acc[ai][bj][m][0], v1 = acc[ai][bj][m][1];
#pragma unroll
                    for (int e = 0; e < 4; ++e) { const float a = fmaxf(v0[e], 0.f), b = fmaxf(v1[e], 0.f); v0[e] = a * a; v1[e] = b * b; }
                    store8bf(H + off + bj * 128, v0, v1); } }
    }
};

struct EpiSPart {
    float* part; int ld;
    __device__ __forceinline__ void operator()(const Acc& acc, const Unit& u, int wr, int wc, int fr, int fq) const {
        const int r0 = wr * 64 + fr, col0 = u.pn * 256 + wc * 32 + 8 * fq; float* base = part + (size_t)(u.k0 / u.nt) * 128 * ld;
#pragma unroll
        for (int m = 0; m < 4; ++m) { float* op = base + (size_t)(r0 + m * 16) * ld + col0;
#pragma unroll
            for (int bj = 0; bj < 2; ++bj) { *(f32x4*)(op + bj * 128) = acc[0][bj][m][0]; *(f32x4*)(op + bj * 128 + 4) = acc[0][bj][m][1]; } }
    }
};
struct EpiS4 {
    unsigned char* ws;
    __device__ __forceinline__ void operator()(const Acc& acc, const Unit& u, int wr, int wc, int fr, int fq) const {
        const int which = u.pm >= 33 ? 1 : 0; const int pn = u.pn - 8 * which;
        const bf16_t* gate = (const bf16_t*)(ws + (which ? WS_GB : WS_GA)); float* base = (float*)(ws + WS_PART) + (size_t)(which * 16 + u.k0 / u.nt) * 128 * DM;
        const int r0 = wr * 64 + fr, col0 = pn * 256 + wc * 32 + 8 * fq;
#pragma unroll
        for (int m = 0; m < 4; ++m) { const int r = r0 + m * 16;
#pragma unroll
            for (int bj = 0; bj < 2; ++bj) { const u32x4 gw = *(const u32x4*)(gate + (size_t)(MP + r) * DM + col0 + bj * 128);
                const f32x4 g0 = {bflo(gw.x), bfhi(gw.x), bflo(gw.y), bfhi(gw.y)}, g1 = {bflo(gw.z), bfhi(gw.z), bflo(gw.w), bfhi(gw.w)};
                float* op = base + (size_t)r * DM + col0 + bj * 128; *(f32x4*)op = acc[0][bj][m][0] * g0; *(f32x4*)(op + 4) = acc[0][bj][m][1] * g1; } }
    }
};

__device__ __forceinline__ void transpose_item(const float* W, int K, int N, bf16_t* WT, int dst_row0, LAS float* scr, int kb, int nb, int lane) {
    const int k0 = 64 * kb, n0 = 32 * nb;
#pragma unroll 8
    for (int i = 0; i < 32; ++i) { const int kk = 2 * i + (lane >> 5); scr[kk * 33 + (lane & 31)] = W[(size_t)(k0 + kk) * N + n0 + (lane & 31)]; }
    asm volatile("s_waitcnt lgkmcnt(0)" ::: "memory");
    const int c = lane & 7;
#pragma unroll
    for (int j = 0; j < 4; ++j) { const int n = (lane >> 3) + 8 * j; const LAS float* s = scr + (8 * c) * 33 + n;
        u32x4 o; o.x = pk2(s[0 * 33], s[1 * 33]); o.y = pk2(s[2 * 33], s[3 * 33]); o.z = pk2(s[4 * 33], s[5 * 33]); o.w = pk2(s[6 * 33], s[7 * 33]);
        *(u32x4*)(WT + (size_t)(dst_row0 + n) * K + k0 + 8 * c) = o; }
    asm volatile("s_waitcnt lgkmcnt(0)" ::: "memory");
}
__device__ __forceinline__ void transpose_item_fast(const float* W, int K, int N, bf16_t* WT, int dst_row0, LAS float* scr, int kb, int nb, int lane) {
    const int k0 = 64 * kb, n0 = 32 * nb;
    float v[32];
    const float* src = W + (size_t)(k0 + (lane >> 5)) * N + n0 + (lane & 31);
#pragma unroll
    for (int i = 0; i < 32; ++i) v[i] = src[(size_t)(2 * i) * N];
#pragma unroll
    for (int i = 0; i < 32; ++i) scr[(2 * i + (lane >> 5)) * 33 + (lane & 31)] = v[i];
    asm volatile("s_waitcnt lgkmcnt(0)" ::: "memory");
    const int c = lane & 7;
#pragma unroll
    for (int j = 0; j < 4; ++j) { const int n = (lane >> 3) + 8 * j; const LAS float* s = scr + (8 * c) * 33 + n;
        u32x4 o; o.x = pk2(s[0 * 33], s[1 * 33]); o.y = pk2(s[2 * 33], s[3 * 33]); o.z = pk2(s[4 * 33], s[5 * 33]); o.w = pk2(s[6 * 33], s[7 * 33]);
        *(u32x4*)(WT + (size_t)(dst_row0 + n) * K + k0 + 8 * c) = o; }
    asm volatile("s_waitcnt lgkmcnt(0)" ::: "memory");
}
__device__ __forceinline__ void transpose64(const float* W, int N, bf16_t* WT, int K, int k0, int n0, int dst_row0, LAS float* scr, int lane) {
    f32x4 v[16];
    const float* src = W + (size_t)(k0 + (lane >> 4)) * N + n0 + (lane & 15) * 4;
#pragma unroll
    for (int t = 0; t < 16; ++t) v[t] = *(const f32x4*)(src + (size_t)(4 * t) * N);
#pragma unroll
    for (int t = 0; t < 16; ++t) { LAS float* d = scr + (4 * t + (lane >> 4)) * 65 + (lane & 15) * 4; d[0] = v[t][0]; d[1] = v[t][1]; d[2] = v[t][2]; d[3] = v[t][3]; }
    asm volatile("s_waitcnt lgkmcnt(0)" ::: "memory");
    const int c = lane & 7;
#pragma unroll
    for (int j = 0; j < 8; ++j) { const int n = (lane >> 3) + 8 * j; const LAS float* s = scr + (8 * c) * 65 + n;
        u32x4 o; o.x = pk2(s[0 * 65], s[1 * 65]); o.y = pk2(s[2 * 65], s[3 * 65]); o.z = pk2(s[4 * 65], s[5 * 65]); o.w = pk2(s[6 * 65], s[7 * 65]);
        *(u32x4*)(WT + (size_t)(dst_row0 + n) * K + k0 + 8 * c) = o; }
    asm volatile("s_waitcnt lgkmcnt(0)" ::: "memory");
}
__device__ __forceinline__ void ln_row(const float* src, const float* g, const float* b, float* dstf, bf16_t* dstb, int lane, int nparts = 0, size_t pstride = 0, const float* res = nullptr) {
    f32x4 v[8]; float s = 0.f;
    if (nparts == 0) {
#pragma unroll
        for (int j = 0; j < 8; ++j) v[j] = *(const f32x4*)(src + (lane + 64 * j) * 4);
    } else {
#pragma unroll
        for (int j = 0; j < 8; ++j) v[j] = *(const f32x4*)(res + (lane + 64 * j) * 4) * ALPHA;
        for (int sl = 0; sl < nparts; ++sl) {
#pragma unroll
            for (int j = 0; j < 8; ++j) v[j] += *(const f32x4*)(src + (size_t)sl * pstride + (lane + 64 * j) * 4);
        }
    }
#pragma unroll
    for (int j = 0; j < 8; ++j) s += (v[j][0] + v[j][1]) + (v[j][2] + v[j][3]);
    const float mean = wave_sum(s) * (1.f / DM); float s2 = 0.f;
#pragma unroll
    for (int j = 0; j < 8; ++j) { v[j] = v[j] - mean; s2 += (v[j][0] * v[j][0] + v[j][1] * v[j][1]) + (v[j][2] * v[j][2] + v[j][3] * v[j][3]); }
    const float rstd = 1.0f / sqrtf(wave_sum(s2) * (1.f / DM) + LN_EPS);
#pragma unroll
    for (int j = 0; j < 8; ++j) { const int c = (lane + 64 * j) * 4; const f32x4 gg = *(const f32x4*)(g + c), bb = *(const f32x4*)(b + c); const f32x4 y = v[j] * rstd * gg + bb;
        if (dstf) *(f32x4*)(dstf + c) = y;
        if (dstb) { u32x2 w; w.x = pk2(y[0], y[1]); w.y = pk2(y[2], y[3]); *(u32x2*)(dstb + c) = w; } }
}

__device__ __forceinline__ void ln_row_b(const bf16_t* src, const float* g, const float* b, float* dstf, bf16_t* dstb, int lane) {
    float v[4][8]; float s = 0.f;
#pragma unroll
    for (int j = 0; j < 4; ++j) { const u32x4 w = *(const u32x4*)(src + (lane + 64 * j) * 8);
        v[j][0] = bflo(w.x); v[j][1] = bfhi(w.x); v[j][2] = bflo(w.y); v[j][3] = bfhi(w.y); v[j][4] = bflo(w.z); v[j][5] = bfhi(w.z); v[j][6] = bflo(w.w); v[j][7] = bfhi(w.w);
#pragma unroll
        for (int e = 0; e < 8; ++e) s += v[j][e]; }
    const float mean = wave_sum(s) * (1.f / DM); float s2 = 0.f;
#pragma unroll
    for (int j = 0; j < 4; ++j)
#pragma unroll
        for (int e = 0; e < 8; ++e) { v[j][e] -= mean; s2 += v[j][e] * v[j][e]; }
    const float rstd = 1.0f / sqrtf(wave_sum(s2) * (1.f / DM) + LN_EPS);
#pragma unroll
    for (int j = 0; j < 4; ++j) { const int c = (lane + 64 * j) * 8; const f32x4 g0 = *(const f32x4*)(g + c), g1 = *(const f32x4*)(g + c + 4), b0 = *(const f32x4*)(b + c), b1 = *(const f32x4*)(b + c + 4);
        const f32x4 y0 = (f32x4){v[j][0], v[j][1], v[j][2], v[j][3]} * rstd * g0 + b0, y1 = (f32x4){v[j][4], v[j][5], v[j][6], v[j][7]} * rstd * g1 + b1;
        if (dstf) { *(f32x4*)(dstf + c) = y0; *(f32x4*)(dstf + c + 4) = y1; }
        if (dstb) store8bf(dstb + c, y0, y1); }
}

__device__ __forceinline__ void prescan_item(const Params& p, LAS unsigned char* lds, int it, int cvt_base) {
    const int tid = threadIdx.x, wid = tid >> 6, lane = tid & 63;
    const int bh = it >> 5, n = it & 31, b = bh >> 4, h = bh & 15, t0 = n * 64, mrow0 = b * SEQ + t0;
    LAS bf16_t* Kb = (LAS bf16_t*)(lds);
    LAS bf16_t* Qb = (LAS bf16_t*)(lds + 17408);
    LAS float* NfT = (LAS float*)(lds + 34816);
    LAS bf16_t* KdT = (LAS bf16_t*)(lds + 52224);
    LAS bf16_t* VbT = (LAS bf16_t*)(lds + 70656);
    LAS bf16_t* KbgT = (LAS bf16_t*)(lds + 89088);
    LAS bf16_t* Tb = (LAS bf16_t*)(lds + 107520);
    LAS float* sm_beta = (LAS float*)(lds + 116736);
    LAS float* sm_gc = sm_beta + 64;
    LAS float* Wc = (LAS float*)(lds + 117248);
    LAS float* OH = (LAS float*)(lds + 123392);
    unsigned char* ps = p.ws + WS_PS + (size_t)it * PS_ITEM;
    const float* bg = (const float*)(p.ws + WS_BG);
    const bf16_t* qkv = (const bf16_t*)(p.ws + WS_QKV);
    const int ri = tid >> 3, c0 = (tid & 7) * 16;
    u32x4 raw[3][4][2];
    {
        const unsigned char* qb = (const unsigned char*)qkv;
#pragma unroll
        for (int j = 0; j < 4; ++j) {
            const int tt = t0 + ri - 3 + j, ttc = tt < 0 ? 0 : tt;
            const unsigned off = (unsigned)(((b * SEQ + ttc) * DQKV + h * 128 + c0) * 2);
#pragma unroll
            for (int sec = 0; sec < 2; ++sec) {
                u32x4 a0 = *(const u32x4*)(qb + (size_t)(off + sec * 4096u)), a1 = *(const u32x4*)(qb + (size_t)(off + sec * 4096u + 16u));
                if (tt < 0) { a0 = (u32x4){0u, 0u, 0u, 0u}; a1 = (u32x4){0u, 0u, 0u, 0u}; }
                raw[sec][j][0] = a0; raw[sec][j][1] = a1;
            }
        }
    }
#pragma unroll
    for (int k = 0; k < 3; ++k) { const int idx = tid + 512 * k, j = idx / 384, rem = idx % 384; Wc[idx] = p.w_conv[(size_t)j * DQKV + (rem >> 7) * DM + h * 128 + (rem & 127)]; }
    if (tid >= 384) OH[tid - 384] = (tid == 384 + 64) ? 1.f : 0.f;
    if (wid == 0) {
        const float be = bg[(size_t)(mrow0 + lane) * 32 + h]; float g = bg[(size_t)(mrow0 + lane) * 32 + 16 + h];
#pragma unroll
        for (int o = 1; o < 64; o <<= 1) { const float t = __shfl_up(g, o); if (lane >= o) g += t; }
        sm_beta[lane] = be; sm_gc[lane] = g;
        if (lane == 63) ((float*)(p.ws + WS_GL))[it] = __expf(g);
    }
    lds_barrier();
    {
        const int i = ri;
        const int isw = i ^ ((tid & 7) << 3);
        const float gci = sm_gc[i], bei = sm_beta[i], gcl = sm_gc[63];
        const float eg = __expf(gci), ekd = __expf(gcl - gci);
#pragma unroll
        for (int sec = 0; sec < 3; ++sec) {
            float vals[16];
            asm volatile("" ::: "memory"); __builtin_amdgcn_sched_barrier(0);
            if (sec == 1) {
                const unsigned char* qb = (const unsigned char*)qkv;
#pragma unroll
                for (int j = 0; j < 4; ++j) { const int tt = t0 + ri - 3 + j, ttc = tt < 0 ? 0 : tt; const unsigned off = (unsigned)(((b * SEQ + ttc) * DQKV + h * 128 + c0) * 2) + 8192u;
                    u32x4 a0 = *(const u32x4*)(qb + (size_t)off), a1 = *(const u32x4*)(qb + (size_t)(off + 16u));
                    if (tt < 0) { a0 = (u32x4){0u, 0u, 0u, 0u}; a1 = (u32x4){0u, 0u, 0u, 0u}; }
                    raw[2][j][0] = a0; raw[2][j][1] = a1; }
                asm volatile("" ::: "memory"); __builtin_amdgcn_sched_barrier(0);
            }
#pragma unroll
            for (int e = 0; e < 16; ++e) vals[e] = 0.f;
#pragma unroll
            for (int j = 0; j < 4; ++j) {
                const LAS float* wp = Wc + (j * 3 + sec) * 128 + c0;
                const f32x4 w0 = *(const LAS f32x4*)wp, w1 = *(const LAS f32x4*)(wp + 4), w2 = *(const LAS f32x4*)(wp + 8), w3 = *(const LAS f32x4*)(wp + 12);
                const u32x4 r0 = raw[sec][j][0], r1 = raw[sec][j][1];
                vals[0] += bflo(r0.x) * w0[0]; vals[1] += bfhi(r0.x) * w0[1]; vals[2] += bflo(r0.y) * w0[2]; vals[3] += bfhi(r0.y) * w0[3];
                vals[4] += bflo(r0.z) * w1[0]; vals[5] += bfhi(r0.z) * w1[1]; vals[6] += bflo(r0.w) * w1[2]; vals[7] += bfhi(r0.w) * w1[3];
                vals[8] += bflo(r1.x) * w2[0]; vals[9] += bfhi(r1.x) * w2[1]; vals[10] += bflo(r1.y) * w2[2]; vals[11] += bfhi(r1.y) * w2[3];
                vals[12] += bflo(r1.z) * w3[0]; vals[13] += bfhi(r1.z) * w3[1]; vals[14] += bflo(r1.w) * w3[2]; vals[15] += bfhi(r1.w) * w3[3];
            }
#pragma unroll
            for (int e = 0; e < 16; ++e) vals[e] = siluf_(vals[e]);
            if (sec < 2) {
                float sq = 0.f;
#pragma unroll
                for (int e = 0; e < 16; ++e) sq += vals[e] * vals[e];
                sq += __shfl_xor(sq, 1); sq += __shfl_xor(sq, 2); sq += __shfl_xor(sq, 4);
                const float rn = (1.0f / sqrtf(sq + RMS_EPS)) * (sec == 0 ? 0.08838834764831845f : 1.0f);
#pragma unroll
                for (int e = 0; e < 16; ++e) vals[e] *= rn;
                unsigned w8[8];
#pragma unroll
                for (int e = 0; e < 8; ++e) w8[e] = pk2(vals[2 * e], vals[2 * e + 1]);
                LAS bf16_t* dst = (sec == 0 ? Qb : Kb) + i * 136 + c0;
                *(LAS u32x4*)dst = (u32x4){w8[0], w8[1], w8[2], w8[3]}; *(LAS u32x4*)(dst + 8) = (u32x4){w8[4], w8[5], w8[6], w8[7]};
                asm volatile("" ::: "memory"); __builtin_amdgcn_sched_barrier(0);
                if (sec == 0) {
#pragma unroll
                    for (int e = 0; e < 8; ++e) w8[e] = pk2(vals[2 * e] * eg, vals[2 * e + 1] * eg);
                    bf16_t* qdp = (bf16_t*)(ps + PS_QD) + i * 128 + c0;
                    *(u32x4*)qdp = (u32x4){w8[0], w8[1], w8[2], w8[3]}; *(u32x4*)(qdp + 8) = (u32x4){w8[4], w8[5], w8[6], w8[7]};
                } else {
#pragma unroll
                    for (int e = 0; e < 16; ++e) KdT[(c0 + e) * 72 + isw] = (bf16_t)(pk2(vals[e] * ekd, 0.f) & 0xffffu);
                    asm volatile("" ::: "memory"); __builtin_amdgcn_sched_barrier(0);
                    const float bk = bei * eg;
#pragma unroll
                    for (int e = 0; e < 16; ++e) KbgT[(c0 + e) * 72 + isw] = (bf16_t)(pk2(bk * vals[e], 0.f) & 0xffffu);
                }
            } else {
#pragma unroll
                for (int e = 0; e < 16; ++e) VbT[(c0 + e) * 72 + isw] = (bf16_t)(pk2(bei * vals[e], 0.f) & 0xffffu);
            }
        }
    }
    lds_barrier();
    {
        const int mat = wid >> 2, mi = wid & 3, fr = lane & 15, fq = lane >> 4;
        LAS bf16_t* Asrc = mat ? Qb : Kb;
        bf16x8 af[4];
#pragma unroll
        for (int s = 0; s < 4; ++s) af[s] = *(const LAS bf16x8*)(Asrc + (16 * mi + fr) * 136 + 32 * s + 8 * fq);
#pragma unroll
        for (int nj = 0; nj < 4; ++nj) {
            f32x4 acc = {0.f, 0.f, 0.f, 0.f};
            if (nj <= mi) {
#pragma unroll
                for (int s = 0; s < 4; ++s) { const bf16x8 bfr = *(const LAS bf16x8*)(Kb + (16 * nj + fr) * 136 + 32 * s + 8 * fq); acc = __builtin_amdgcn_mfma_f32_16x16x32_bf16(af[s], bfr, acc, 0, 0, 0); }
            }
            const int jj = 16 * nj + fr; const float gcj = sm_gc[jj];
            if (mat == 0) { f32x4 o;
#pragma unroll
                for (int j = 0; j < 4; ++j) { const int i = 16 * mi + 4 * fq + j; const float dec = __expf(fminf(sm_gc[i] - gcj, 0.f)); o[j] = (i > jj) ? sm_beta[i] * acc[j] * dec : 0.f; }
                *(LAS f32x4*)(NfT + jj * 68 + 16 * mi + 4 * fq) = o;
            } else {
#pragma unroll
                for (int j = 0; j < 4; ++j) { const int i = 16 * mi + 4 * fq + j; const float dec = __expf(fminf(sm_gc[i] - gcj, 0.f));
                    ((bf16_t*)(ps + PS_AT))[i * 64 + jj] = (bf16_t)(pk2((i >= jj) ? acc[j] * dec : 0.f, 0.f) & 0xffffu); }
            }
        }
    }
    lds_barrier();
    if (tid < 128) {
        const int c = tid >> 1, half = tid & 1; f32x2 r2[16];
        const LAS float* ohp = OH + 64 - c + 4 * half;
#pragma unroll
        for (int li = 0; li < 8; ++li) { r2[2 * li] = (f32x2){ohp[8 * li], ohp[8 * li + 1]}; r2[2 * li + 1] = (f32x2){ohp[8 * li + 2], ohp[8 * li + 3]}; }
        const LAS float* nb = NfT + half * 4;
#pragma unroll
        for (int j = 0; j < 63; ++j) {
            const int jc = j >> 2, lj = jc >> 1, ej = j & 3;
            const float xm = (ej & 2) ? ((ej & 1) ? r2[2 * lj + 1].y : r2[2 * lj + 1].x) : ((ej & 1) ? r2[2 * lj].y : r2[2 * lj].x);
            const float xo = __shfl_xor(xm, 1);
            const float xj = ((jc & 1) == half) ? xm : xo;
            const f32x2 xj2 = {xj, xj};
#pragma unroll
            for (int li = lj; li < 8; ++li) {
                f32x4 nv = *(const LAS f32x4*)(nb + j * 68 + 8 * li);
                if (li == lj) {
                    const int rowb = 4 * (2 * li + half);
#pragma unroll
                    for (int e = 0; e < 4; ++e) nv[e] = (rowb + e > j) ? nv[e] : 0.f;
                }
                r2[2 * li] = r2[2 * li] - (f32x2){nv[0], nv[1]} * xj2; r2[2 * li + 1] = r2[2 * li + 1] - (f32x2){nv[2], nv[3]} * xj2;
            }
            asm volatile("" ::: "memory"); __builtin_amdgcn_sched_barrier(0);
        }
#pragma unroll
        for (int li = 0; li < 8; ++li) { const int rb = 4 * (2 * li + half);
            Tb[(rb) * 72 + c] = (bf16_t)(pk2(r2[2 * li].x, 0.f) & 0xffffu); Tb[(rb + 1) * 72 + c] = (bf16_t)(pk2(r2[2 * li].y, 0.f) & 0xffffu);
            Tb[(rb + 2) * 72 + c] = (bf16_t)(pk2(r2[2 * li + 1].x, 0.f) & 0xffffu); Tb[(rb + 3) * 72 + c] = (bf16_t)(pk2(r2[2 * li + 1].y, 0.f) & 0xffffu); }
    } else if (tid >= 256) {
        const int t2 = tid - 256; bf16_t* kd = (bf16_t*)(ps + PS_KDT);
#pragma unroll
        for (int k = 0; k < 4; ++k) { const int q = t2 + 256 * k, row = q >> 3, cc = q & 7; *(u32x4*)(kd + row * 64 + cc * 8) = *(const LAS u32x4*)(KdT + row * 72 + (cc ^ ((row >> 4) & 7)) * 8); }
        if (cvt_base >= 0) {
            LAS float* scr = (LAS float*)(lds + 124928 + (wid - 4) * 8448);
#pragma unroll 1
            for (int r = 0; r < 2; ++r) { const int t = cvt_base + (wid - 4) * 2 + r;
                if (t < 8192) transpose_item_fast(p.w_up, DM, DFF, (bf16_t*)(p.ws + WS_WUPT), 32 * (t & 255), scr, t >> 8, t & 255, lane);
                else { const int u = t - 8192; transpose_item_fast(p.w_down, DFF, DM, (bf16_t*)(p.ws + WS_WDNT), 32 * (u & 63), scr, u >> 6, u & 63, lane); } }
        }
    }
    lds_barrier();
    {
        const int fr = lane & 15, fq = lane >> 4;
        float* wout = (float*)(ps + PS_W); bf16_t* kout = (bf16_t*)(ps + PS_KCD);
        bf16x8 tf[4][2];
#pragma unroll
        for (int mi = 0; mi < 4; ++mi)
#pragma unroll
            for (int s = 0; s < 2; ++s) tf[mi][s] = *(const LAS bf16x8*)(Tb + (16 * mi + fr) * 72 + 32 * s + 8 * fq);
#pragma unroll
        for (int t = 0; t < 2; ++t) {
            const int ni = wid * 2 + t;
            const bf16x8 b0 = *(const LAS bf16x8*)(VbT + (16 * ni + fr) * 72 + 8 * (fq ^ (ni & 7))), b1 = *(const LAS bf16x8*)(VbT + (16 * ni + fr) * 72 + 8 * ((4 + fq) ^ (ni & 7)));
#pragma unroll
            for (int mi = 0; mi < 4; ++mi) {
                f32x4 acc = {0.f, 0.f, 0.f, 0.f};
                acc = __builtin_amdgcn_mfma_f32_16x16x32_bf16(tf[mi][0], b0, acc, 0, 0, 0);
                acc = __builtin_amdgcn_mfma_f32_16x16x32_bf16(tf[mi][1], b1, acc, 0, 0, 0);
                if (ni < 8) {
                    const int e = 16 * ni + fr; const unsigned wb = (unsigned)((e >> 5) * 1024 + (fq >> 1) * 128 + (fq & 1) * 32 + (e & 31));
                    unsigned* w32 = (unsigned*)wout + wb + (unsigned)((mi >> 1) * 512 + (mi & 1) * 256);
                    w32[0] = pk2(acc[0], acc[1]); w32[64] = pk2(acc[2], acc[3]);
                } else {
                    const unsigned kb_ = (unsigned)(4 * fq * 128 + 16 * (ni - 8) + fr);
#pragma unroll
                    for (int j = 0; j < 4; ++j) kout[kb_ + (unsigned)((16 * mi + j) * 128)] = (bf16_t)(pk2(-acc[j], 0.f) & 0xffffu);
                }
                asm volatile("" ::: "memory"); __builtin_amdgcn_sched_barrier(0);
            }
        }
    }
    lds_barrier();
}

__device__ __forceinline__ bf16x8 packs(const f32x16& x, int s) {
    u32x4 w; w.x = pk2(x[8 * s], x[8 * s + 1]); w.y = pk2(x[8 * s + 2], x[8 * s + 3]); w.z = pk2(x[8 * s + 4], x[8 * s + 5]); w.w = pk2(x[8 * s + 6], x[8 * s + 7]); return __builtin_bit_cast(bf16x8, w);
}
__device__ __forceinline__ bf16x8 ldA2(const LAS bf16_t* p) { const u32x2 a = *(const LAS u32x2*)p, b = *(const LAS u32x2*)(p + 8); u32x4 w = {a.x, a.y, b.x, b.y}; return __builtin_bit_cast(bf16x8, w); }
#define MFMA32(a, b, c) __builtin_amdgcn_mfma_f32_32x32x16_bf16((a), (b), (c), 0, 0, 0)
__device__ __forceinline__ int crow(int reg, int hh) { return (reg & 3) + 8 * (reg >> 2) + 4 * hh; }

__device__ __forceinline__ void scan_stage(const unsigned char* src, LAS unsigned char* bb, int t2) {
    constexpr int O_KCD = 0, O_QD = 16896, O_KDT = 33792, O_AT = 51200;
#pragma unroll
    for (int half = 0; half < 2; ++half) {
        u32x4 stg[7];
#pragma unroll
        for (int k = 0; k < 7; ++k) stg[k] = *(const u32x4*)(src + (size_t)(t2 + 256 * (7 * half + k)) * 16);
#pragma unroll
        for (int k = 0; k < 7; ++k) { const int kk = 7 * half + k, q = t2 + 256 * kk; LAS unsigned char* d_;
            if (kk < 4) d_ = bb + O_KCD + (q >> 4) * 264 + (q & 15) * 16; else if (kk < 8) d_ = bb + O_QD + ((q - 1024) >> 4) * 264 + (q & 15) * 16;
            else if (kk < 12) d_ = bb + O_KDT + ((q - 2048) >> 3) * 136 + (q & 7) * 16; else d_ = bb + O_AT + ((q - 3072) >> 3) * 136 + (q & 7) * 16;
            *(LAS u32x2*)d_ = (u32x2){stg[k].x, stg[k].y}; *(LAS u32x2*)(d_ + 8) = (u32x2){stg[k].z, stg[k].w}; }
    }
}
__device__ __forceinline__ void scan_onorm(const Params& p, const LAS bf16_t* Ob, bf16_t* zrow0, int h, int t2) {
    const int oi = t2 >> 2, oq = t2 & 3; u32x4 ov[4];
#pragma unroll
    for (int k = 0; k < 4; ++k) ov[k] = *(const LAS u32x4*)(Ob + oi * 136 + oq * 32 + 8 * k);
    float ov_f[32];
#pragma unroll
    for (int k = 0; k < 4; ++k) { ov_f[8 * k] = bflo(ov[k].x); ov_f[8 * k + 1] = bfhi(ov[k].x); ov_f[8 * k + 2] = bflo(ov[k].y); ov_f[8 * k + 3] = bfhi(ov[k].y);
        ov_f[8 * k + 4] = bflo(ov[k].z); ov_f[8 * k + 5] = bfhi(ov[k].z); ov_f[8 * k + 6] = bflo(ov[k].w); ov_f[8 * k + 7] = bfhi(ov[k].w); }
    float ss = 0.f;
#pragma unroll
    for (int e = 0; e < 32; ++e) ss += ov_f[e] * ov_f[e];
    ss += __shfl_xor(ss, 1); ss += __shfl_xor(ss, 2);
    const float rstd = 1.0f / sqrtf(ss * (1.f / 128.f) + RMS_EPS);
    bf16_t* zp = zrow0 + (size_t)oi * DM + h * 128 + oq * 32; const float* wn = p.w_onorm + oq * 32;
#pragma unroll
    for (int k = 0; k < 4; ++k) { const u32x4 zw = *(const u32x4*)(zp + 8 * k); const f32x4 w0 = *(const f32x4*)(wn + 8 * k), w1 = *(const f32x4*)(wn + 8 * k + 4);
        u32x4 o; o.x = pk2(ov_f[8 * k] * rstd * w0[0] * bflo(zw.x), ov_f[8 * k + 1] * rstd * w0[1] * bfhi(zw.x));
        o.y = pk2(ov_f[8 * k + 2] * rstd * w0[2] * bflo(zw.y), ov_f[8 * k + 3] * rstd * w0[3] * bfhi(zw.y));
        o.z = pk2(ov_f[8 * k + 4] * rstd * w1[0] * bflo(zw.z), ov_f[8 * k + 5] * rstd * w1[1] * bfhi(zw.z));
        o.w = pk2(ov_f[8 * k + 6] * rstd * w1[2] * bflo(zw.w), ov_f[8 * k + 7] * rstd * w1[3] * bfhi(zw.w));
        *(u32x4*)(zp + 8 * k) = o; }
}
__device__ __forceinline__ void scan_bh(const Params& p, LAS unsigned char* lds, int bh) {
    const int tid = threadIdx.x, wid = __builtin_amdgcn_readfirstlane(tid >> 6), lane = tid & 63, r = lane & 31, hh = lane >> 5;
    const int b = bh >> 4, h = bh & 15;
    constexpr int BUFB = 59904, O_KCD = 0, O_QD = 16896, O_KDT = 33792, O_AT = 51200, OBUFB = 17408;
    LAS unsigned char* Obase = lds + 2 * BUFB;
    const unsigned char* psb = p.ws + WS_PS + (size_t)(bh * 32) * PS_ITEM;
    const float* gl = (const float*)(p.ws + WS_GL) + bh * 32;
    bf16_t* Zb = (bf16_t*)(p.ws + WS_Z) + (size_t)(b * SEQ) * DM;
    if (wid >= 4) scan_stage(psb + PS_KCD, lds, tid - 256);
    lds_barrier();
    if (wid < 4) {
        f32x16 S[4], Vn[2], O[2];
#pragma unroll
        for (int d = 0; d < 4; ++d)
#pragma unroll
            for (int i = 0; i < 16; ++i) S[d][i] = 0.f;
        const int e0 = 32 * wid + r;
        { const unsigned* wsrc = (const unsigned*)(psb + PS_W) + wid * 1024 + lane;
#pragma unroll
            for (int mi = 0; mi < 2; ++mi)
#pragma unroll
                for (int k = 0; k < 8; ++k) { const unsigned u = wsrc[(mi * 8 + k) * 64]; Vn[mi][2 * k] = bflo(u); Vn[mi][2 * k + 1] = bfhi(u); } }
        const float glv = gl[lane & 31];
        for (int n = 0; n < 32; ++n) {
            LAS unsigned char* bb = lds + (n & 1) * BUFB;
            unsigned Wp[16];
            if (n + 1 < 32) { const unsigned* wsrc = (const unsigned*)(psb + (size_t)(n + 1) * PS_ITEM + PS_W) + wid * 1024 + lane;
#pragma unroll
                for (int k = 0; k < 16; ++k) Wp[k] = wsrc[k * 64]; }
            const LAS bf16_t* kcd = (const LAS bf16_t*)(bb + O_KCD); const LAS bf16_t* qdl = (const LAS bf16_t*)(bb + O_QD);
            const LAS bf16_t* kdt = (const LAS bf16_t*)(bb + O_KDT); const LAS bf16_t* att = (const LAS bf16_t*)(bb + O_AT);
            LAS bf16_t* Obuf = (LAS bf16_t*)(Obase + (n & 1) * OBUFB);
#pragma unroll
            for (int mi = 0; mi < 2; ++mi)
#pragma unroll
                for (int i = 0; i < 16; ++i) O[mi][i] = 0.f;
#pragma unroll
            for (int s = 0; s < 8; ++s) {
                bf16x8 ac[4];
#pragma unroll
                for (int mi = 0; mi < 2; ++mi) { ac[mi] = ldA2(kcd + (32 * mi + r) * 132 + 16 * s + 4 * hh); ac[2 + mi] = ldA2(qdl + (32 * mi + r) * 132 + 16 * s + 4 * hh); }
                const bf16x8 sf = packs(S[s >> 1], s & 1);
#pragma unroll
                for (int mi = 0; mi < 2; ++mi) { Vn[mi] = MFMA32(ac[mi], sf, Vn[mi]); O[mi] = MFMA32(ac[2 + mi], sf, O[mi]); }
                __builtin_amdgcn_sched_barrier(0);
            }
            bf16x8 vf[4];
#pragma unroll
            for (int s = 0; s < 4; ++s) vf[s] = packs(Vn[s >> 1], s & 1);
            if (n + 1 < 32) {
#pragma unroll
                for (int mi = 0; mi < 2; ++mi)
#pragma unroll
                    for (int k = 0; k < 8; ++k) { Vn[mi][2 * k] = bflo(Wp[mi * 8 + k]); Vn[mi][2 * k + 1] = bfhi(Wp[mi * 8 + k]); } }
#pragma unroll
            for (int s = 0; s < 2; ++s) O[0] = MFMA32(ldA2(att + (r) * 68 + 16 * s + 4 * hh), vf[s], O[0]);
#pragma unroll
            for (int s = 0; s < 4; ++s) O[1] = MFMA32(ldA2(att + (32 + r) * 68 + 16 * s + 4 * hh), vf[s], O[1]);
            const float g_l = __builtin_bit_cast(float, __builtin_amdgcn_readlane(__builtin_bit_cast(int, glv), n));
#pragma unroll
            for (int d = 0; d < 4; ++d) { S[d] = S[d] * g_l;
#pragma unroll
                for (int s = 0; s < 4; ++s) S[d] = MFMA32(ldA2(kdt + (32 * d + r) * 68 + 16 * s + 4 * hh), vf[s], S[d]); }
#pragma unroll
            for (int mi = 0; mi < 2; ++mi)
#pragma unroll
                for (int i = 0; i < 16; ++i) Obuf[(32 * mi + crow(i, hh)) * 136 + e0] = (bf16_t)(pk2(O[mi][i], 0.f) & 0xffffu);
            lds_barrier();
        }
        float* so = p.out + O_SP + (size_t)bh * 16384;
#pragma unroll
        for (int d = 0; d < 4; ++d)
#pragma unroll
            for (int i = 0; i < 16; ++i) so[(32 * d + crow(i, hh)) * 128 + e0] = S[d][i];
    } else {
        const int t2 = tid - 256, oi = t2 >> 2, oq = t2 & 3;
        u32x4 stg[8], stgb[6], zr[4];
#define SCAN_LD_A(item) do { const unsigned char* s_ = psb + (size_t)(item) * PS_ITEM + PS_KCD; _Pragma("unroll") for (int k = 0; k < 8; ++k) stg[k] = *(const u32x4*)(s_ + (size_t)(t2 + 256 * k) * 16); } while (0)
#define SCAN_LD_B(item) do { const unsigned char* s_ = psb + (size_t)(item) * PS_ITEM + PS_KCD; _Pragma("unroll") for (int k = 0; k < 6; ++k) stgb[k] = *(const u32x4*)(s_ + (size_t)(t2 + 256 * (8 + k)) * 16); } while (0)
#define SCAN_ST_A(bufi) do { LAS unsigned char* bb_ = lds + (bufi) * BUFB; _Pragma("unroll") for (int k = 0; k < 8; ++k) { const int q = t2 + 256 * k; LAS unsigned char* d_; \
            if (k < 4) d_ = bb_ + O_KCD + (q >> 4) * 264 + (q & 15) * 16; else d_ = bb_ + O_QD + ((q - 1024) >> 4) * 264 + (q & 15) * 16; \
            *(LAS u32x2*)d_ = (u32x2){stg[k].x, stg[k].y}; *(LAS u32x2*)(d_ + 8) = (u32x2){stg[k].z, stg[k].w}; } } while (0)
#define SCAN_ST_B(bufi) do { LAS unsigned char* bb_ = lds + (bufi) * BUFB; _Pragma("unroll") for (int k = 0; k < 6; ++k) { const int q = t2 + 256 * (8 + k); LAS unsigned char* d_; \
            if (k < 4) d_ = bb_ + O_KDT + ((q - 2048) >> 3) * 136 + (q & 7) * 16; else d_ = bb_ + O_AT + ((q - 3072) >> 3) * 136 + (q & 7) * 16; \
            *(LAS u32x2*)d_ = (u32x2){stgb[k].x, stgb[k].y}; *(LAS u32x2*)(d_ + 8) = (u32x2){stgb[k].z, stgb[k].w}; } } while (0)
#define SCAN_ZLD(chunk) do { const bf16_t* zp_ = Zb + (size_t)((chunk) * 64 + oi) * DM + h * 128 + oq * 32; _Pragma("unroll") for (int k = 0; k < 4; ++k) zr[k] = *(const u32x4*)(zp_ + 8 * k); } while (0)
#define SCAN_NORM(obuf, chunk) do { const LAS bf16_t* Ob_ = (const LAS bf16_t*)(obuf); u32x4 ov[4]; SCAN_ZLD(chunk); \
            _Pragma("unroll") for (int k = 0; k < 4; ++k) ov[k] = *(const LAS u32x4*)(Ob_ + oi * 136 + oq * 32 + 8 * k); \
            float ss = 0.f; \
            _Pragma("unroll") for (int k = 0; k < 4; ++k) { const float a0 = bflo(ov[k].x), a1 = bfhi(ov[k].x), a2 = bflo(ov[k].y), a3 = bfhi(ov[k].y), a4 = bflo(ov[k].z), a5 = bfhi(ov[k].z), a6 = bflo(ov[k].w), a7 = bfhi(ov[k].w); \
                ss += (a0 * a0 + a1 * a1) + (a2 * a2 + a3 * a3) + (a4 * a4 + a5 * a5) + (a6 * a6 + a7 * a7); } \
            ss += __shfl_xor(ss, 1); ss += __shfl_xor(ss, 2); \
            const float rstd = 1.0f / sqrtf(ss * (1.f / 128.f) + RMS_EPS); \
            bf16_t* zp_ = Zb + (size_t)((chunk) * 64 + oi) * DM + h * 128 + oq * 32; const float* wn = p.w_onorm + oq * 32; \
            _Pragma("unroll") for (int k = 0; k < 4; ++k) { const u32x4 zw = zr[k]; const f32x4 w0 = *(const f32x4*)(wn + 8 * k) * rstd, w1 = *(const f32x4*)(wn + 8 * k + 4) * rstd; \
                u32x4 o; o.x = pk2(bflo(ov[k].x) * w0[0] * bflo(zw.x), bfhi(ov[k].x) * w0[1] * bfhi(zw.x)); \
                o.y = pk2(bflo(ov[k].y) * w0[2] * bflo(zw.y), bfhi(ov[k].y) * w0[3] * bfhi(zw.y)); \
                o.z = pk2(bflo(ov[k].z) * w1[0] * bflo(zw.z), bfhi(ov[k].z) * w1[1] * bfhi(zw.z)); \
                o.w = pk2(bflo(ov[k].w) * w1[2] * bflo(zw.w), bfhi(ov[k].w) * w1[3] * bfhi(zw.w)); \
                *(u32x4*)(zp_ + 8 * k) = o; asm volatile("" ::: "memory"); } } while (0)
        SCAN_LD_A(1); SCAN_LD_B(1);
        for (int n = 0; n < 32; ++n) {
            if (n + 1 < 32) { SCAN_ST_A((n + 1) & 1); SCAN_ST_B((n + 1) & 1); }
            if (n + 2 < 32) { SCAN_LD_A(n + 2); SCAN_LD_B(n + 2); }
            if (n >= 1) SCAN_NORM(Obase + ((n - 1) & 1) * OBUFB, n - 1);
            lds_barrier();
        }
        SCAN_NORM(Obase + OBUFB, 31);
#undef SCAN_LD_A
#undef SCAN_LD_B
#undef SCAN_ST_A
#undef SCAN_ST_B
#undef SCAN_ZLD
#undef SCAN_NORM
    }
    lds_barrier();
}

__device__ __forceinline__ void sample_prefetch(const Params& p, int it, f32x4 (&Sn)[8]) {
    const int tid = threadIdx.x; const float* S0 = p.state_ssm + (size_t)it * 16384 + (tid >> 5) * 1024 + (tid & 31) * 4;
#pragma unroll
    for (int i = 0; i < 8; ++i) Sn[i] = *(const f32x4*)(S0 + i * 128);
}
__device__ __forceinline__ void sample_item(const Params& p, LAS unsigned char* lds, int it, const f32x4 (&Sr)[8]) {
    const int tid = threadIdx.x, wid = tid >> 6, lane = tid & 63;
    const int b = it >> 4, h = it & 15, m = MP + b;
    const int e4 = (tid & 31) * 4, dg = tid >> 5;
    LAS float* vq = (LAS float*)lds;
    LAS float* red = vq + 384;
    LAS float* vnew = vq + 400;
    LAS float* part = vq + 1024;
    const bf16_t* qkv = (const bf16_t*)(p.ws + WS_QKV); const float* bg = (const float*)(p.ws + WS_BG); bf16_t* Zb = (bf16_t*)(p.ws + WS_Z);
    if (tid < 384) { const int sec = tid >> 7, c = tid & 127, col = sec * DM + h * 128 + c;
        float a = bf2f(qkv[(size_t)m * DQKV + col]) * p.w_conv[3 * DQKV + col];
#pragma unroll
        for (int j = 0; j < 3; ++j) a += p.state_conv[(size_t)(b * 3 + j) * DQKV + col] * p.w_conv[j * DQKV + col];
        vq[sec * 128 + c] = siluf_(a); }
    lds_barrier();
    if (wid < 2) { const float a = vq[wid * 128 + lane], c2 = vq[wid * 128 + 64 + lane]; const float s = wave_sum(a * a + c2 * c2); if (lane == 0) red[wid] = s; }
    lds_barrier();
    if (tid < 256) { const int sec = tid >> 7; const float rs = 1.0f / sqrtf(red[sec] + RMS_EPS) * (sec == 0 ? 0.08838834764831845f : 1.0f); vq[tid] *= rs; }
    lds_barrier();
    if (wid == 0) { const float s = wave_sum(vq[lane] * vq[128 + lane] + vq[64 + lane] * vq[192 + lane]); if (lane == 0) red[2] = s; }
    {
        f32x4 ks = {0.f, 0.f, 0.f, 0.f}, qs = {0.f, 0.f, 0.f, 0.f};
#pragma unroll
        for (int i = 0; i < 8; ++i) { const float kk = vq[128 + dg * 8 + i], qq = vq[dg * 8 + i]; ks += Sr[i] * kk; qs += Sr[i] * qq; }
        *(LAS f32x4*)(part + dg * 128 + e4) = ks; *(LAS f32x4*)(part + 2048 + dg * 128 + e4) = qs;
    }
    lds_barrier();
    const float beta = bg[(size_t)m * 32 + h], eg = __expf(bg[(size_t)m * 32 + 16 + h]);
    float o = 0.f;
    if (tid < 128) { float kS = 0.f, qS = 0.f;
#pragma unroll
        for (int d = 0; d < 16; ++d) { kS += part[d * 128 + tid]; qS += part[2048 + d * 128 + tid]; }
        const float vn = beta * (vq[256 + tid] - eg * kS); o = eg * qS + red[2] * vn; vnew[tid] = vn;
        const float s = wave_sum(o * o); if (lane == 0) red[4 + wid] = s; }
    lds_barrier();
    if (tid < 128) { const float rstd = 1.0f / sqrtf((red[4] + red[5]) * (1.f / 128.f) + RMS_EPS); bf16_t* zp = Zb + (size_t)m * DM + h * 128 + tid;
        *zp = (bf16_t)(pk2(o * rstd * p.w_onorm[tid] * bf2f(*zp), 0.f) & 0xffffu); }
    {
        float* So = p.out + O_SS + (size_t)it * 16384; const f32x4 vn4 = *(const LAS f32x4*)(vnew + e4);
#pragma unroll
        for (int i = 0; i < 8; ++i) { const float kk = vq[128 + dg * 8 + i]; *(f32x4*)(So + (dg * 8 + i) * 128 + e4) = Sr[i] * eg + vn4 * kk; }
    }
    lds_barrier();
}

__device__ __forceinline__ void mixerA_item(const Params& p, LAS unsigned char* lds, int it) {
    const int tid = threadIdx.x, wid = tid >> 6, lane = tid & 63, fr = lane & 15, fq = lane >> 4;
    const int b = it >> 8, c = (it >> 4) & 15, g = it & 15, m0 = b * SEQ + c * 128;
    LAS bf16_t* Wt = (LAS bf16_t*)lds;
    LAS bf16_t* VnT = (LAS bf16_t*)(lds + 34816);
    LAS float* st = (LAS float*)(lds + 68608);
    const float* vstat = (const float*)(p.ws + WS_VSTAT); const bf16_t* VA = (const bf16_t*)(p.ws + WS_VA); bf16_t* U = (bf16_t*)(p.ws + WS_U);
    if (tid < 128) { const float* sp = vstat + (size_t)(m0 + tid) * 64; float s = 0.f, s2 = 0.f;
#pragma unroll
        for (int k = 0; k < 16; ++k) { const f32x4 v = *(const f32x4*)(sp + 4 * k); s += v[0] + v[2]; s2 += v[1] + v[3]; }
        const float mu = s * (1.f / DM), var = fmaxf(s2 * (1.f / DM) - mu * mu, 0.f); st[2 * tid] = mu; st[2 * tid + 1] = 1.0f / sqrtf(var + LN_EPS); }
    {
        const float* ws_ = p.w_s + (size_t)g * 16384;
#pragma unroll
        for (int k = 0; k < 8; ++k) { const int idx = tid + 512 * k, t = idx >> 5, s4 = (idx & 31) * 4; f32x4 w = *(const f32x4*)(ws_ + t * 128 + s4);
#pragma unroll
            for (int e = 0; e < 4; ++e) if (s4 + e > t) w[e] = 0.f;
            *(LAS u32x2*)(Wt + t * 136 + s4) = (u32x2){pk2(w[0], w[1]), pk2(w[2], w[3])}; }
    }
    lds_barrier();
#pragma unroll
    for (int k = 0; k < 4; ++k) {
        const int q = tid + 512 * k, l = q & 63, grp = q >> 6, s = (grp >> 2) * 16 + (l >> 2), dc = (grp & 3) * 4 + (l & 3);
        const u32x4 raw = *(const u32x4*)(VA + (size_t)(m0 + s) * DM + g * 128 + dc * 8);
        const float mu = st[2 * s], rs = st[2 * s + 1];
        const float* gp = p.ln_v_g + g * 128 + dc * 8; const float* bp = p.ln_v_b + g * 128 + dc * 8;
        const f32x4 g0 = *(const f32x4*)gp, g1 = *(const f32x4*)(gp + 4), b0 = *(const f32x4*)bp, b1 = *(const f32x4*)(bp + 4);
        float v[8] = {bflo(raw.x), bfhi(raw.x), bflo(raw.y), bfhi(raw.y), bflo(raw.z), bfhi(raw.z), bflo(raw.w), bfhi(raw.w)};
#pragma unroll
        for (int e = 0; e < 8; ++e) { const float gg = e < 4 ? g0[e & 3] : g1[e & 3], bb = e < 4 ? b0[e & 3] : b1[e & 3]; const float y = (v[e] - mu) * rs * gg + bb;
            VnT[(dc * 8 + e) * 132 + s] = (bf16_t)(pk2(y, 0.f) & 0xffffu); }
    }
    lds_barrier();
    {
        bf16x8 wf[4];
        const int nks = ((16 * wid + 15) >> 5) + 1;
#pragma unroll
        for (int s = 0; s < 4; ++s) wf[s] = *(const LAS bf16x8*)(Wt + (16 * wid + fr) * 136 + 32 * s + 8 * fq);
        const int t = 16 * wid + fr; const float bs = p.b_s[g * 128 + t];
#pragma unroll
        for (int mb = 0; mb < 8; ++mb) {
            f32x4 acc = {0.f, 0.f, 0.f, 0.f};
#pragma unroll
            for (int s = 0; s < 4; ++s) if (s < nks) {
                const LAS bf16_t* vp = VnT + (16 * mb + fr) * 132 + 32 * s + 8 * fq; const u32x2 a0 = *(const LAS u32x2*)vp, a1 = *(const LAS u32x2*)(vp + 4);
                u32x4 aw = {a0.x, a0.y, a1.x, a1.y};
                acc = __builtin_amdgcn_mfma_f32_16x16x32_bf16(__builtin_bit_cast(bf16x8, aw), wf[s], acc, 0, 0, 0); }
            bf16_t* up = U + (size_t)(m0 + t) * DM + g * 128 + 16 * mb + 4 * fq; const u32x2 uw = *(const u32x2*)up;
            u32x2 o; o.x = pk2(bflo(uw.x) * (acc[0] + bs), bfhi(uw.x) * (acc[1] + bs)); o.y = pk2(bflo(uw.y) * (acc[2] + bs), bfhi(uw.y) * (acc[3] + bs));
            *(u32x2*)up = o;
        }
    }
    lds_barrier();
}

#define XB_TMO      128
#define XB_XCNT(j)  (256  + 64 * (j))
#define XB_XSUB(j)  (1280 + 64 * (j))
#define XB_XGEN(j)  (2304 + 64 * (j))
#define XB_TOP      3328
#define XB_TOPGEN   3392
#define XCD_BAR_WORDS 3456
#define XB_SPIN_CAP (1u << 18)
__device__ __forceinline__ unsigned xb_ld(unsigned* p)              { return __hip_atomic_load(p, __ATOMIC_RELAXED, __HIP_MEMORY_SCOPE_AGENT); }
__device__ __forceinline__ unsigned xb_add(unsigned* p, unsigned v) { return __hip_atomic_fetch_add(p, v, __ATOMIC_RELAXED, __HIP_MEMORY_SCOPE_AGENT); }
__device__ __forceinline__ unsigned xb_xcc_id() { return (unsigned)__builtin_amdgcn_s_getreg((3 << 11) | 20) & 0xFu; }
#define XB_SPIN(cond, bar) do { unsigned _sp = 0; while (cond) { __builtin_amdgcn_s_sleep(1); \
    if ((++_sp & 255u) == 0u) { if (xb_ld(&(bar)[XB_TMO])) break; if (_sp > XB_SPIN_CAP) { atomicAdd(&(bar)[XB_TMO], 1u); break; } } } } while (0)
struct XcdBarrier { unsigned* bar; unsigned x; volatile LAS unsigned* st; };
__device__ __forceinline__ XcdBarrier xcd_barrier_post(unsigned* bar, volatile LAS unsigned* st) {
    XcdBarrier b; b.bar = bar; b.x = xb_xcc_id(); b.st = st;
    if (threadIdx.x == 0) (void)xb_add(&bar[XB_XCNT(b.x)], 1u);
    return b;
}
__device__ __forceinline__ void xcd_barrier_complete(unsigned* bar, unsigned x, unsigned& nloc, unsigned& nx) {
    const unsigned G = gridDim.x * gridDim.y * gridDim.z;
    unsigned sum, cnt, mine, sp = 0u;
    for (;;) {
        sum = 0u; cnt = 0u; mine = 0u;
#pragma unroll
        for (unsigned j = 0; j < 16; ++j) { const unsigned c = xb_ld(&bar[XB_XCNT(j)]); sum += c; cnt += (c > 0u) ? 1u : 0u; mine = (j == x) ? c : mine; }
        if (sum == G) break;
        __builtin_amdgcn_s_sleep(1);
        if ((++sp & 255u) == 0u) { if (xb_ld(&bar[XB_TMO])) break; if (sp > XB_SPIN_CAP) { atomicAdd(&bar[XB_TMO], 1u); break; } }
    }
    nloc = mine > 0u ? mine : 1u; nx = cnt > 0u ? cnt : 1u;
}
__device__ __forceinline__ void xcd_barrier(const XcdBarrier& b) {
    asm volatile("s_waitcnt vmcnt(0)" ::: "memory");
    __syncthreads();
    if (threadIdx.x == 0) {
        unsigned* bar = b.bar;
        __builtin_amdgcn_s_waitcnt(0);
        unsigned nloc = b.st[0], nx = b.st[1];
        if (nloc == 0u) { xcd_barrier_complete(bar, b.x, nloc, nx); b.st[0] = nloc; b.st[1] = nx; }
        const unsigned old = xb_add(&bar[XB_XSUB(b.x)], 1u);
        const unsigned gen = old / nloc;
        if (old + 1u == (gen + 1u) * nloc) {
            __builtin_amdgcn_fence(__ATOMIC_RELEASE, "agent");
            asm volatile("s_waitcnt vmcnt(0)" ::: "memory");
            const unsigned og = xb_add(&bar[XB_TOP], 1u);
            const unsigned tg = og / nx;
            if (og + 1u == (tg + 1u) * nx) xb_add(&bar[XB_TOPGEN], 1u);
            else XB_SPIN(xb_ld(&bar[XB_TOPGEN]) == tg, bar);
            __builtin_amdgcn_fence(__ATOMIC_ACQUIRE, "agent");
            xb_add(&bar[XB_XGEN(b.x)], 1u);
            asm volatile("s_waitcnt vmcnt(0)" ::: "memory");
        } else {
            XB_SPIN(xb_ld(&bar[XB_XGEN(b.x)]) == gen, bar);
            __builtin_amdgcn_fence(__ATOMIC_ACQUIRE, "agent");
            asm volatile("s_waitcnt vmcnt(0)" ::: "memory");
        }
    }
    __syncthreads();
}

__device__ __forceinline__ unsigned char* opq(unsigned char* q) { asm volatile("" : "+s"(q)); return q; }
__global__ void __launch_bounds__(512, 2) mega_fwd(Params p) {
    extern __shared__ __attribute__((aligned(16))) unsigned char smem[];
    LAS unsigned char* lds = (LAS unsigned char*)smem;
    cg::grid_group grid = cg::this_grid();
    const int tid = threadIdx.x, wid = tid >> 6, lane = tid & 63, G = gridDim.x, blk = blockIdx.x;
    unsigned char* ws = p.ws;
#ifndef PHMASK
#define PHMASK 0x3ff
#endif
#define IN(k) (((PHMASK >> (k)) & 1) && p.ph_lo <= (k) && (k) < p.ph_hi)
#define SEAM(k) do { if (IN(k) && IN((k) + 1)) { if (p.coop == 2) grid.sync(); else xcd_barrier(xbar); } } while (0)
    volatile LAS unsigned* xst = (volatile LAS unsigned*)(lds + 160000);
    if (tid < 2) xst[tid] = 0u;
    __syncthreads();
    const XcdBarrier xbar = xcd_barrier_post((unsigned*)ws, xst);

    if (IN(0)) { unsigned char* ws = opq(p.ws);
        LAS float* scr = (LAS float*)(lds + wid * 16640);
        const int gw = blk * 8 + wid, NGW = G * 8;
        constexpr int I_IN = 32 * 256, I_BG = 32, I_P = 32 * 32, NIT = I_IN + I_BG + 3 * I_P;
        for (int it = gw; it < NIT; it += NGW) {
            int r = it;
            if (r < I_IN) { const int kb = r >> 8, nb = r & 255; const int n0 = nb < 192 ? 64 * nb : 12320 + 64 * (nb - 192); const int drow = nb < 192 ? n0 : n0 - 32;
                transpose64(p.w_in, 16416, (bf16_t*)(ws + WS_W1T), DM, 64 * kb, n0, drow, scr, lane); continue; }
            r -= I_IN;
            if (r < I_BG) { transpose_item(p.w_in, DM, 16416, (bf16_t*)(ws + WS_W1T), 16384, scr, r, 384, lane); continue; }
            r -= I_BG;
            if (r < I_P) { transpose64(p.w_proj_a, DM, (bf16_t*)(ws + WS_WPT), DM, 64 * (r >> 5), 64 * (r & 31), 64 * (r & 31), scr, lane); continue; } r -= I_P;
            if (r < I_P) { transpose64(p.w_proj_b, DM, (bf16_t*)(ws + WS_WPT), DM, 64 * (r >> 5), 64 * (r & 31), DM + 64 * (r & 31), scr, lane); continue; } r -= I_P;
            transpose64(p.w_o, DM, (bf16_t*)(ws + WS_WOT), DM, 64 * (r >> 5), 64 * (r & 31), 64 * (r & 31), scr, lane);
        }
        bf16_t* xb = (bf16_t*)(ws + WS_XB);
#pragma unroll 4
        for (size_t q = (size_t)blk * 512 + tid; q < (size_t)MPAD * DM / 8; q += (size_t)G * 512) {
            const size_t e = q * 8; const int row = (int)(e / DM);
            u32x4 o = {0u, 0u, 0u, 0u};
            if (row < MT) { const float* src = row < MP ? p.x_prompt + e : p.x_sample + (e - (size_t)MP * DM); const f32x4 a = *(const f32x4*)src, c2 = *(const f32x4*)(src + 4);
                o.x = pk2(a[0], a[1]); o.y = pk2(a[2], a[3]); o.z = pk2(c2[0], c2[1]); o.w = pk2(c2[2], c2[3]); }
            *(u32x4*)(xb + e) = o;
        }
        bf16_t* w1 = (bf16_t*)(ws + WS_W1T);
        for (size_t q = (size_t)blk * 512 + tid; q < (size_t)224 * DM / 8; q += (size_t)G * 512) *(u32x4*)(w1 + (size_t)16416 * DM + q * 8) = (u32x4){0u, 0u, 0u, 0u};
    }
    SEAM(0);
    if (IN(1)) { unsigned char* ws = opq(p.ws);
        pg8::Gemm g{(const bf16_t*)(ws + WS_XB), (const bf16_t*)(ws + WS_W1T), MPAD, N1, DM};
        pg8::Sched S; S.init(33, 65, G, blk, 0, 0, 0, 32);
        Epi1 E{ws, p.a_log, p.dt_bias};
        pg8::gemm_phase<Epi1>(lds, g, S, E);
    }
    SEAM(1);
    if (IN(2)) { unsigned char* ws = opq(p.ws);
        { int k = 0; for (int it = blk; it < 2048; it += G, ++k) prescan_item(p, lds, it, (G == 256 && k < 8) ? blk * 64 + k * 8 : -1); }
    }
    SEAM(2);
    if (IN(3)) { unsigned char* ws = opq(p.ws);
        const bool split = G > 64;
        if (blk < 64) { for (int bh = blk; bh < 64; bh += (split ? 64 : G)) scan_bh(p, lds, bh); }
        if (!split || blk >= 64) {
            const int oi = split ? blk - 64 : blk, on = split ? G - 64 : G;
            const bf16_t* qkv = (const bf16_t*)(ws + WS_QKV);
            for (int q = oi * 512 + tid; q < NBP * 3 * DQKV / 4; q += on * 512) { const int e = q * 4, col = e % DQKV, j = (e / DQKV) % 3, bb = e / (3 * DQKV);
                const u32x2 r = *(const u32x2*)(qkv + (size_t)(bb * SEQ + SEQ - 3 + j) * DQKV + col); *(f32x4*)(p.out + O_CP + e) = (f32x4){bflo(r.x), bfhi(r.x), bflo(r.y), bfhi(r.y)}; }
#pragma unroll 2
            for (int q = oi * 512 + tid; q < MS * 3 * DQKV / 4; q += on * 512) { const int e = q * 4, col = e % DQKV, j = (e / DQKV) % 3, bb = e / (3 * DQKV); f32x4 v;
                if (j < 2) v = *(const f32x4*)(p.state_conv + (size_t)(bb * 3 + j + 1) * DQKV + col);
                else { const u32x2 r = *(const u32x2*)(qkv + (size_t)(MP + bb) * DQKV + col); v = (f32x4){bflo(r.x), bfhi(r.x), bflo(r.y), bfhi(r.y)}; }
                *(f32x4*)(p.out + O_CS + e) = v; }
            const float* vstat = (const float*)(ws + WS_VSTAT); const bf16_t* VA = (const bf16_t*)(ws + WS_VA); bf16_t* U = (bf16_t*)(ws + WS_U);
            for (int row = oi * 8 + wid; row < MS; row += on * 8) { const int m = MP + row;
                const f32x2 st = lane < 32 ? *(const f32x2*)(vstat + (size_t)m * 64 + 2 * lane) : (f32x2){0.f, 0.f};
                const float s = wave_sum(st.x), s2 = wave_sum(st.y);
                const float mu = s * (1.f / DM), var = fmaxf(s2 * (1.f / DM) - mu * mu, 0.f), rs = 1.0f / sqrtf(var + LN_EPS);
#pragma unroll
                for (int k = 0; k < 8; ++k) { const int cc = (lane + 64 * k) * 4, gg = cc >> 7;
                    const u32x2 va = *(const u32x2*)(VA + (size_t)m * DM + cc); const f32x4 lg = *(const f32x4*)(p.ln_v_g + cc), lb = *(const f32x4*)(p.ln_v_b + cc);
                    f32x4 vn = {bflo(va.x), bfhi(va.x), bflo(va.y), bfhi(va.y)}; vn = (vn - mu) * rs * lg + lb;
                    *(f32x4*)(p.out + O_GV + (size_t)row * DM + cc) = vn;
                    const float w00 = p.w_s[(size_t)gg * 16384], bs0 = p.b_s[gg * 128];
                    bf16_t* up = U + (size_t)m * DM + cc; const u32x2 uw = *(const u32x2*)up;
                    *(u32x2*)up = (u32x2){pk2(bflo(uw.x) * (w00 * vn[0] + bs0), bfhi(uw.x) * (w00 * vn[1] + bs0)), pk2(bflo(uw.y) * (w00 * vn[2] + bs0), bfhi(uw.y) * (w00 * vn[3] + bs0))}; }
            }
        }
        {
            unsigned* qctr = (unsigned*)ws + 3584;
            volatile LAS int* slot = (volatile LAS int*)(lds + 160016);
            if (tid == 0) { slot[0] = (int)__hip_atomic_fetch_add(qctr, 1u, __ATOMIC_RELAXED, __HIP_MEMORY_SCOPE_AGENT); slot[1] = (int)__hip_atomic_fetch_add(qctr, 1u, __ATOMIC_RELAXED, __HIP_MEMORY_SCOPE_AGENT); }
            lds_barrier();
            int cur = slot[0], nxt = slot[1], par = 0;
            f32x4 Sr[8], Sn[8];
            if (cur < 2048) sample_prefetch(p, cur, Sr);
            lds_barrier();
            while (cur < 3072) {
                unsigned tick = 0u;
                if (tid == 0) tick = __hip_atomic_fetch_add(qctr, 1u, __ATOMIC_RELAXED, __HIP_MEMORY_SCOPE_AGENT);
                if (nxt < 2048) sample_prefetch(p, nxt, Sn);
                if (cur < 2048) sample_item(p, lds, cur, Sr); else mixerA_item(p, lds, cur - 2048);
                if (tid == 0) slot[par] = (int)tick;
                lds_barrier();
                const int nn = slot[par]; par ^= 1;
#pragma unroll
                for (int i = 0; i < 8; ++i) Sr[i] = Sn[i];
                cur = nxt; nxt = nn;
            }
        }
    }
    SEAM(3);
    if (IN(4)) { unsigned char* ws = opq(p.ws);
        pg8::Gemm g{(const bf16_t*)(ws + WS_U), (const bf16_t*)(ws + WS_WPT), 2 * MPAD, 2 * DM, DM};
        { pg8::Sched S; S.init(32, 8, G, blk, 1, 33, 8, 32); Epi4 E{ws}; pg8::gemm_phase<Epi4>(lds, g, S, E); }
        { pg8::Sched S; S.init_split(32, 8, 16, 2, G, blk, 1, 33, 8); EpiS4 E{ws}; pg8::gemm_phase<EpiS4>(lds, g, S, E); }
    }
    SEAM(4);
    if (IN(5)) { unsigned char* ws = opq(p.ws);
        {
            const float* part = (const float*)(ws + WS_PART); bf16_t* MB = (bf16_t*)(ws + WS_MB);
            for (int q = blk * 512 + tid; q < MS * DM / 4; q += G * 512) { f32x4 v = *(const f32x4*)(part + 4 * q);
#pragma unroll 8
                for (int sl = 1; sl < 32; ++sl) v += *(const f32x4*)(part + (size_t)sl * MS * DM + 4 * q);
                *(u32x2*)(MB + (size_t)MP * DM + 4 * q) = (u32x2){pk2(v[0], v[1]), pk2(v[2], v[3])}; }
        }
        pg8::Gemm g{(const bf16_t*)(ws + WS_MB), (const bf16_t*)(ws + WS_WOT), MPAD, DM, DM};
        { pg8::Sched S; S.init(32, 8, G, blk, 0, 0, 0, 32); EpiRes E{p.x_prompt, nullptr, (bf16_t*)(ws + WS_R1)}; pg8::gemm_phase<EpiRes>(lds, g, S, E); }
        xcd_barrier(xbar);
        { pg8::Sched S; S.init_split(32, 8, 16, 2, G, blk, 0, 0, 0); EpiSPart E{(float*)(ws + WS_PART), DM}; pg8::gemm_phase<EpiSPart>(lds, g, S, E); }
    }
    SEAM(5);
    if (IN(6)) { unsigned char* ws = opq(p.ws);
        const int gw = blk * 8 + wid, NGW = G * 8;
        for (int m = gw; m < MT; m += NGW) {
            if (m < MP) ln_row_b((const bf16_t*)(ws + WS_R1) + (size_t)m * DM, p.ln1_g, p.ln1_b, nullptr, (bf16_t*)(ws + WS_X1B) + (size_t)m * DM, lane);
            else ln_row((const float*)(ws + WS_PART) + (size_t)(m - MP) * DM, p.ln1_g, p.ln1_b, (float*)(ws + WS_X1) + (size_t)m * DM, (bf16_t*)(ws + WS_X1B) + (size_t)m * DM, lane, 16, (size_t)MS * DM, p.x_sample + (size_t)(m - MP) * DM);
        }
        LAS float* scr = (LAS float*)(lds + wid * 16640);
        if (G != 256) for (int it = gw; it < 8192; it += NGW) {
            if (it < 4096) transpose64(p.w_up, DFF, (bf16_t*)(ws + WS_WUPT), DM, 64 * (it >> 7), 64 * (it & 127), 64 * (it & 127), scr, lane);
            else { const int r = it - 4096; transpose64(p.w_down, DM, (bf16_t*)(ws + WS_WDNT), DFF, 64 * (r >> 5), 64 * (r & 31), 64 * (r & 31), scr, lane); }
        }
    }
    SEAM(6);
    if (IN(7)) { unsigned char* ws = opq(p.ws);
        pg8::Gemm g{(const bf16_t*)(ws + WS_X1B), (const bf16_t*)(ws + WS_WUPT), MPAD, DFF, DM};
        { pg8::Sched S; S.init(32, 32, G, blk, 0, 0, 0, 32); Epi7 E{(bf16_t*)(ws + WS_H)}; pg8::gemm_phase<Epi7>(lds, g, S, E); }
        { pg8::Sched S; S.init_split(32, 32, 8, 4, G, blk, 0, 0, 0); EpiSPart E{(float*)(ws + WS_PART), DFF}; pg8::gemm_phase<EpiSPart>(lds, g, S, E); }
    }
    SEAM(7);
    if (IN(8)) { unsigned char* ws = opq(p.ws);
        {
            const float* part = (const float*)(ws + WS_PART); bf16_t* H = (bf16_t*)(ws + WS_H);
            for (int q = blk * 512 + tid; q < MS * DFF / 4; q += G * 512) { f32x4 v = *(const f32x4*)(part + 4 * q);
#pragma unroll
                for (int sl = 1; sl < 8; ++sl) v += *(const f32x4*)(part + (size_t)sl * MS * DFF + 4 * q);
#pragma unroll
                for (int e = 0; e < 4; ++e) { const float a = fmaxf(v[e], 0.f); v[e] = a * a; }
                *(u32x2*)(H + (size_t)MP * DFF + 4 * q) = (u32x2){pk2(v[0], v[1]), pk2(v[2], v[3])}; }
        }
        pg8::Gemm g{(const bf16_t*)(ws + WS_H), (const bf16_t*)(ws + WS_WDNT), MPAD, DM, DFF};
        { pg8::Sched S; S.init(32, 8, G, blk, 0, 0, 0, 128); EpiRes E{nullptr, (const bf16_t*)(ws + WS_X1B), (bf16_t*)(ws + WS_R2)}; pg8::gemm_phase<EpiRes>(lds, g, S, E); }
        xcd_barrier(xbar);
        { pg8::Sched S; S.init_split(32, 8, 32, 4, G, blk, 0, 0, 0); EpiSPart E{(float*)(ws + WS_PART), DM}; pg8::gemm_phase<EpiSPart>(lds, g, S, E); }
    }
    SEAM(8);
    if (IN(9)) { unsigned char* ws = opq(p.ws);
        const int gw = blk * 8 + wid, NGW = G * 8;
        for (int m = gw; m < MT; m += NGW) {
            if (m < MP) ln_row_b((const bf16_t*)(ws + WS_R2) + (size_t)m * DM, p.ln2_g, p.ln2_b, p.out + (size_t)m * DM, nullptr, lane);
            else ln_row((const float*)(ws + WS_PART) + (size_t)(m - MP) * DM, p.ln2_g, p.ln2_b, p.out + (size_t)m * DM, nullptr, lane, 32, (size_t)MS * DM, (const float*)(ws + WS_X1) + (size_t)m * DM);
        }
    }
#undef IN
#undef SEAM
}

extern "C" void kernel_launch(void* const* d_in, const int* in_sizes, int n_in, void* d_out, int out_size, void* d_ws, size_t ws_size, hipStream_t stream) {
    static int grid = 0;
    if (grid == 0) {
        int dev = 0, cus = 0, per_cu = 0;
        if (n_in != 22 || ws_size < WS_END) { fprintf(stderr, "kernel_launch: unexpected inputs (n_in %d, ws %zu)\n", n_in, ws_size); grid = -1; return; }
        hipGetDevice(&dev);
        hipDeviceGetAttribute(&cus, hipDeviceAttributeMultiprocessorCount, dev);
        if (hipFuncSetAttribute((const void*)mega_fwd, hipFuncAttributeMaxDynamicSharedMemorySize, LDS_BYTES) != hipSuccess) { fprintf(stderr, "kernel_launch: hipFuncSetAttribute failed\n"); grid = -1; return; }
        if (hipOccupancyMaxActiveBlocksPerMultiprocessor(&per_cu, (const void*)mega_fwd, 512, LDS_BYTES) != hipSuccess || per_cu < 1) { fprintf(stderr, "kernel_launch: occupancy query says %d\n", per_cu); per_cu = 1; }
        (void)hipGetLastError();
        grid = cus;
    }
    if (grid < 0) return;
    Params p{};
    const float** pp = (const float**)&p;
    for (int i = 0; i < 22; ++i) pp[i] = (const float*)d_in[i];
    p.out = (float*)d_out; p.ws = (unsigned char*)d_ws; p.ph_lo = 0; p.ph_hi = 10; p.coop = 1; p.pad = 0;
    if (hipMemsetAsync(d_ws, 0, 16384, stream) != hipSuccess) { fprintf(stderr, "kernel_launch: memset failed\n"); return; }
    void* args[] = {&p};
    hipError_t e = hipLaunchCooperativeKernel((const void*)mega_fwd, dim3(grid), dim3(512), args, LDS_BYTES, stream);
    if (e != hipSuccess) fprintf(stderr, "cooperative launch failed: %s (grid %d)\n", hipGetErrorString(e), grid);
}
```

```cpp
#include <hip/hip_runtime.h>
#include <hip/hip_cooperative_groups.h>
#include <cstdio>
#include <cstdint>
namespace cg = cooperative_groups;

#define LAS __attribute__((address_space(3)))
typedef unsigned short bf16_t;
typedef short bf16x8 __attribute__((ext_vector_type(8)));
typedef short s16x4 __attribute__((ext_vector_type(4)));
typedef float f32x2 __attribute__((ext_vector_type(2)));
typedef float f32x4 __attribute__((ext_vector_type(4)));
typedef float f32x16 __attribute__((ext_vector_type(16)));
typedef unsigned u32x2 __attribute__((ext_vector_type(2)));
typedef unsigned u32x4 __attribute__((ext_vector_type(4)));

constexpr int DM = 2048, SEQ = 2048, NBP = 4, MP = 8192, MS = 128, MT = 8320, MPAD = 8448;
constexpr int N1 = 16640, DFF = 8192, DQKV = 6144;
constexpr float ALPHA = 1.189207115002721f, LN_EPS = 1e-5f, RMS_EPS = 1e-6f;
constexpr int LDS_BYTES = 160768;
constexpr size_t MiB = 1u << 20;
constexpr size_t WS_BG = 1 * MiB, WS_VSTAT = 3 * MiB, WS_GL = 6 * MiB;
constexpr size_t WS_WPT = 8 * MiB, WS_WOT = 24 * MiB, WS_U = 32 * MiB, WS_Z = 65 * MiB, WS_VA = 98 * MiB, WS_QKV = 131 * MiB;
constexpr size_t WS_GA = 230 * MiB, WS_GB = 263 * MiB, WS_W1T = 296 * MiB, WS_XB = 361 * MiB, WS_PS = 296 * MiB;
constexpr size_t WS_MTMP = 296 * MiB, WS_MB = 362 * MiB, WS_R1 = 395 * MiB, WS_H = 296 * MiB;
constexpr size_t WS_WUPT = 440 * MiB, WS_WDNT = 472 * MiB,
     WS_X1 = 131 * MiB, WS_X1B = 197 * MiB, WS_R2 = 230 * MiB;
constexpr size_t WS_PART = 98 * MiB;
constexpr size_t WS_END = 504 * MiB;
constexpr int PS_ITEM = 73728;
constexpr int PS_W = 0, PS_KCD = 16384, PS_QD = 32768, PS_KDT = 49152, PS_AT = 65536;
constexpr size_t O_YP = 0, O_YS = 16777216, O_CP = 17039360, O_SP = 17113088, O_GV = 18161664, O_CS = 18423808, O_SS = 20783104;

__device__ __forceinline__ unsigned pk2(float lo, float hi) { typedef __bf16 b2 __attribute__((ext_vector_type(2))); f32x2 v = {lo, hi}; b2 b = __builtin_convertvector(v, b2); return __builtin_bit_cast(unsigned, b); }
__device__ __forceinline__ float bf2f(unsigned short b) { return __uint_as_float((unsigned)b << 16); }
__device__ __forceinline__ float bflo(unsigned w) { return __uint_as_float(w << 16); }
__device__ __forceinline__ float bfhi(unsigned w) { return __uint_as_float(w & 0xffff0000u); }
__device__ __forceinline__ float sigmoidf_(float x) { return 1.0f / (1.0f + __expf(-x)); }
__device__ __forceinline__ float siluf_(float x) { return x / (1.0f + __expf(-x)); }
__device__ __forceinline__ float wave_sum(float v) {
#pragma unroll
    for (int o = 1; o < 64; o <<= 1) v += __shfl_xor(v, o);
    return v;
}
__device__ __forceinline__ void lds_barrier() { asm volatile("s_waitcnt lgkmcnt(0)\n\ts_barrier" ::: "memory"); }
__device__ __forceinline__ f32x2 gelu_pk(f32x2 v) {
    const f32x2 av = __builtin_elementwise_abs(v), d = av * 0.2316418882f + 1.0f;
    f32x2 t; t.x = __builtin_amdgcn_rcpf(d.x); t.y = __builtin_amdgcn_rcpf(d.y);
    f32x2 q = t * 0.5307027145f + (-0.7265760135f); q = q * t + 0.7107068705f; q = q * t + (-0.142248368f); q = q * t + 0.127414796f; q = q * t;
    const f32x2 s = (v * v) * (-0.72134752044f);
    f32x2 e; e.x = __builtin_amdgcn_exp2f(s.x); e.y = __builtin_amdgcn_exp2f(s.y);
    const f32x2 m = v * (q * e), r = v - m;
    f32x2 o; o.x = v.x < 0.f ? m.x : r.x; o.y = v.y < 0.f ? m.y : r.y; return o;
}
__device__ __forceinline__ f32x4 gelu4(f32x4 v) { f32x2 a = gelu_pk((f32x2){v[0], v[1]}), b = gelu_pk((f32x2){v[2], v[3]}); return (f32x4){a.x, a.y, b.x, b.y}; }

namespace pg8 {
constexpr int BM = 256, BK = 64, HALF = 128, HTB = HALF * BK * 2, STAGE_BYTES = 8 * HTB, NXCD = 8, WGM = 8;
__host__ __device__ __forceinline__ int lds_byte(int r, int c) { const int st = (r >> 4) * 2 + (c >> 5), rr = r & 15, cc = c & 31, ob = rr * 64 + cc * 2; return st * 1024 + (ob ^ (((ob >> 9) & 1) << 5)); }
__host__ __device__ __forceinline__ void stage_rc(int b, int& R, int& C) { const int st = b / 1024, sb = b % 1024, swz = sb ^ (((sb >> 9) & 1) << 5); R = (st >> 1) * 16 + swz / 64; C = (st & 1) * 32 + (swz % 64) / 2; }
__host__ __device__ __forceinline__ int perm32(int rho) { const int n = rho >> 4, i = rho & 15; return 8 * (i >> 2) + 4 * n + (i & 3); }
struct Unit { int pm, pn, k0, nt; };
struct Gemm { const bf16_t* A; const bf16_t* Bt; int M, N, K; };
struct Sched {
    int nM, nN, nwg, G, c, pairs, offM, offN, ntK;
    int split, sM, sNt, sSl, sNtK;
    __device__ void init(int nM_, int nN_, int G_, int c_, int pairs_, int offM_, int offN_, int ntK_) { nM = nM_; nN = nN_; nwg = nM * nN; G = G_; c = c_; pairs = pairs_; offM = offM_; offN = offN_; ntK = ntK_; split = 0; sM = 0; sNt = 0; sSl = 0; sNtK = 0; }
    __device__ void init_split(int sM_, int nN_, int slices, int ntk_slice, int G_, int c_, int pairs_, int offM_, int offN_) { init(1, nN_, G_, c_, pairs_, offM_, offN_, ntk_slice); split = 1; sM = sM_; sNt = nN_; sSl = slices; sNtK = ntk_slice; nwg = nN_ * slices * (pairs_ ? 2 : 1); }
    __device__ bool next(int i, Unit& u) const {
        if (split) {
            const int L = i * G + c; if (L >= nwg) return false;
            const int sl = L % sSl, r = L / sSl, pn = r % sNt, which = r / sNt;
            u.pm = sM + which * offM; u.pn = pn + which * offN; u.k0 = sl * sNtK; u.nt = sNtK; return true;
        }
        const int j = pairs ? (i >> 1) : i, which = pairs ? (i & 1) : 0;
        const long L = (long)j * G + c; if (L >= nwg) return false;
        int wgid = (int)L; { const int q = nwg / NXCD, r = nwg % NXCD, xcd = wgid % NXCD, off = wgid / NXCD; wgid = (xcd < r ? xcd * (q + 1) : r * (q + 1) + (xcd - r) * q) + off; }
        const int nig = WGM * nN, gid = wgid / nig, fm = gid * WGM, gsz = (nM - fm) < WGM ? (nM - fm) : WGM;
        u.pm = fm + ((wgid % nig) % gsz) + which * offM; u.pn = (wgid % nig) / gsz + which * offN; u.k0 = 0; u.nt = ntK; return true;
    }
};

template <class Epi>
__device__ __forceinline__ void gemm_phase(LAS unsigned char* lds, const Gemm g, const Sched& S, const Epi& E) {
    const int tid = threadIdx.x, wid = __builtin_amdgcn_readfirstlane(tid >> 6), lane = tid & 63, wr = wid >> 2, wc = wid & 3, fr = lane & 15, fq = lane >> 4;
    const int K = g.K;
    unsigned voffA[2], voffB[2];
#pragma unroll
    for (int i = 0; i < 2; ++i) { int R, C; stage_rc(tid * 16 + i * 8192, R, C); const int Rb = (R & ~31) + perm32(R & 31);
        voffA[i] = (unsigned)(R * K + C) * 2u; voffB[i] = (unsigned)(Rb * K + C) * 2u; }
    const size_t kstep = (size_t)(BK * 2);
    const size_t hstep = (size_t)HALF * K * 2;
    const size_t tstep = 2 * hstep;
    const unsigned ldsw = (unsigned)wid * 1024u;
    const int aoff = lds_byte(wr * 64 + fr, fq * 8), boff = lds_byte(wc * 32 + fr, fq * 8);
#define PG8_SA(b, h) (((b) * 2 + (h)) * HTB)
#define PG8_SB(b, h) ((4 + (b) * 2 + (h)) * HTB)
#define PG8_STAGE(bufoff, gbase, voff) do { _Pragma("unroll") for (int _i = 0; _i < 2; ++_i) \
        __builtin_amdgcn_global_load_lds((const unsigned*)((const char*)(gbase) + (voff)[_i]), (LAS unsigned*)(lds + (bufoff) + ldsw + _i * 8192), 16, 0, 0); } while (0)
#define PG8_LDA(dst, b, h) do { _Pragma("unroll") for (int m = 0; m < 4; ++m) _Pragma("unroll") for (int k = 0; k < 2; ++k) dst[m][k] = *(const LAS bf16x8*)(lds + PG8_SA(b, h) + aoff + m * 2048 + k * 1024); } while (0)
#define PG8_LDB(dst, b, h) do { _Pragma("unroll") for (int n = 0; n < 2; ++n) _Pragma("unroll") for (int k = 0; k < 2; ++k) dst[n][k] = *(const LAS bf16x8*)(lds + PG8_SB(b, h) + boff + n * 2048 + k * 1024); } while (0)
#define PG8_MMA(ai, bj, At, Bt) do { __builtin_amdgcn_s_setprio(1); _Pragma("unroll") for (int m = 0; m < 4; ++m) _Pragma("unroll") for (int n = 0; n < 2; ++n) _Pragma("unroll") for (int k = 0; k < 2; ++k) \
        acc[ai][bj][m][n] = __builtin_amdgcn_mfma_f32_16x16x32_bf16(Bt[n][k], At[m][k], acc[ai][bj][m][n], 0, 0, 0); __builtin_amdgcn_s_setprio(0); } while (0)
#define PG8_WAIT_V(n) asm volatile("s_waitcnt vmcnt(" #n ")" ::: "memory")
#define PG8_WAIT_L(n) asm volatile("s_waitcnt lgkmcnt(" #n ")" ::: "memory")
#define PG8_BAR __builtin_amdgcn_s_barrier()
#define PG8_SCHED __builtin_amdgcn_sched_barrier(0)
    Unit cur, nxt; int ui = 0;
    if (!S.next(0, cur)) return;
    f32x4 acc[2][2][4][2];
#pragma unroll
    for (int a = 0; a < 2; ++a)
#pragma unroll
        for (int b = 0; b < 2; ++b)
#pragma unroll
            for (int m = 0; m < 4; ++m)
#pragma unroll
                for (int n = 0; n < 2; ++n) acc[a][b][m][n] = (f32x4){0.f, 0.f, 0.f, 0.f};
    bf16x8 At[4][2], B0[2][2], B1[2][2];
    const char* cA = (const char*)g.A + (size_t)cur.pm * tstep + (size_t)cur.k0 * kstep; const char* cB = (const char*)g.Bt + (size_t)cur.pn * tstep + (size_t)cur.k0 * kstep;
    PG8_STAGE(PG8_SB(0, 0), cB, voffB); PG8_STAGE(PG8_SB(0, 1), cB + hstep, voffB); PG8_STAGE(PG8_SA(0, 0), cA, voffA); PG8_STAGE(PG8_SA(0, 1), cA + hstep, voffA);
    if (wr == 1) PG8_BAR;
    PG8_WAIT_V(2); PG8_BAR;
    PG8_STAGE(PG8_SB(1, 0), cB + kstep, voffB); PG8_STAGE(PG8_SA(1, 0), cA + kstep, voffA); PG8_STAGE(PG8_SB(1, 1), cB + hstep + kstep, voffB);
    PG8_WAIT_V(6); PG8_BAR;
    for (;;) {
        const bool has_next = S.next(ui + 1, nxt);
        const char* nA = has_next ? (const char*)g.A + (size_t)nxt.pm * tstep + (size_t)nxt.k0 * kstep : cA; const char* nB = has_next ? (const char*)g.Bt + (size_t)nxt.pn * tstep + (size_t)nxt.k0 * kstep : cB;
        const int nt = cur.nt;
        for (int t = 0; t < nt; t += 2) {
            const bool last = (t == nt - 2);
            const char* a1 = cA + (size_t)(t + 1) * kstep;
            const char* a2 = last ? nA : cA + (size_t)(t + 2) * kstep; const char* b2 = last ? nB : cB + (size_t)(t + 2) * kstep;
            const char* a3 = a2 + kstep; const char* b3 = b2 + kstep;
            PG8_LDB(B0, 0, 0); PG8_LDB(B1, 0, 1); PG8_SCHED; PG8_LDA(At, 0, 0); PG8_STAGE(PG8_SA(1, 1), a1 + hstep, voffA);
            PG8_WAIT_V(8); PG8_WAIT_L(0); PG8_BAR; PG8_MMA(0, 0, At, B0); PG8_MMA(0, 1, At, B1); PG8_BAR; PG8_SCHED;
            PG8_LDA(At, 0, 1); PG8_STAGE(PG8_SB(0, 0), b2, voffB); PG8_STAGE(PG8_SB(0, 1), b2 + hstep, voffB); PG8_STAGE(PG8_SA(0, 0), a2, voffA);
            PG8_WAIT_V(8); PG8_WAIT_L(0); PG8_BAR; PG8_MMA(1, 0, At, B0); PG8_MMA(1, 1, At, B1); PG8_BAR; PG8_SCHED;
            PG8_LDB(B0, 1, 0); PG8_LDB(B1, 1, 1); PG8_SCHED; PG8_LDA(At, 1, 0); PG8_STAGE(PG8_SA(0, 1), a2 + hstep, voffA);
            PG8_WAIT_V(8); PG8_WAIT_L(0); PG8_BAR; PG8_MMA(0, 0, At, B0); PG8_MMA(0, 1, At, B1); PG8_BAR; PG8_SCHED;
            PG8_LDA(At, 1, 1); PG8_STAGE(PG8_SB(1, 0), b3, voffB); PG8_STAGE(PG8_SB(1, 1), b3 + hstep, voffB); PG8_STAGE(PG8_SA(1, 0), a3, voffA);
            PG8_WAIT_V(8); PG8_WAIT_L(0); PG8_BAR; PG8_MMA(1, 0, At, B0); PG8_MMA(1, 1, At, B1); PG8_BAR; PG8_SCHED;
        }
        if (wr == 0) PG8_BAR;
        E(acc, cur, wr, wc, fr, fq);
        if (!has_next) break;
#pragma unroll
        for (int a = 0; a < 2; ++a)
#pragma unroll
            for (int b = 0; b < 2; ++b)
#pragma unroll
                for (int m = 0; m < 4; ++m)
#pragma unroll
                    for (int n = 0; n < 2; ++n) acc[a][b][m][n] = (f32x4){0.f, 0.f, 0.f, 0.f};
        cur = nxt; cA = nA; cB = nB; ++ui;
        if (wr == 1) PG8_BAR;
    }
    PG8_WAIT_V(0);
    PG8_BAR;
#undef PG8_SA
#undef PG8_SB
#undef PG8_STAGE
#undef PG8_LDA
#undef PG8_LDB
#undef PG8_MMA
#undef PG8_WAIT_V
#undef PG8_WAIT_L
#undef PG8_BAR
#undef PG8_SCHED
}
}
using pg8::Unit;
typedef f32x4 Acc[2][2][4][2];

struct Params {
    const float *x_prompt, *x_sample, *state_conv, *state_ssm, *w_in, *w_s, *b_s, *ln_v_g, *ln_v_b, *w_conv, *a_log, *dt_bias, *w_onorm,
                *w_proj_a, *w_proj_b, *w_o, *ln1_g, *ln1_b, *w_up, *w_down, *ln2_g, *ln2_b;
    float* out; unsigned char* ws; int ph_lo, ph_hi, coop, pad;
};

__device__ __forceinline__ void store8bf(bf16_t* p, f32x4 v0, f32x4 v1) { u32x4 w; w.x = pk2(v0[0], v0[1]); w.y = pk2(v0[2], v0[3]); w.z = pk2(v1[0], v1[1]); w.w = pk2(v1[2], v1[3]); *(u32x4*)p = w; }

struct Epi1 {
    unsigned char* ws; const float* a_log; const float* dt_bias;
    __device__ __forceinline__ void operator()(const Acc& acc, const Unit& u, int wr, int wc, int fr, int fq) const {
        const int pn = u.pn; const int row0 = u.pm * 256 + wr * 64 + fr; const int cl = wc * 32 + 8 * fq;
        if (pn < 64) {
            int act, ld, cb; size_t boff;
            if (pn < 8) { boff = WS_U; act = 1; ld = DM; cb = pn * 256; }
            else if (pn < 16) { boff = WS_VA; act = 1; ld = DM; cb = (pn - 8) * 256; }
            else if (pn < 40) { boff = WS_QKV; act = 0; ld = DQKV; cb = (pn - 16) * 256; }
            else if (pn < 48) { boff = WS_Z; act = 2; ld = DM; cb = (pn - 40) * 256; }
            else if (pn < 56) { boff = WS_GA; act = 3; ld = DM; cb = (pn - 48) * 256; }
            else { boff = WS_GB; act = 3; ld = DM; cb = (pn - 56) * 256; }
            const bool stats = (pn >= 8 && pn < 16);
            bf16_t* base = (bf16_t*)(ws + boff);
            float* vstat = (float*)(ws + WS_VSTAT) + ((pn - 8) * 4 + wc) * 2;
            const unsigned off0 = (unsigned)(row0 * ld + cb + cl);
#pragma unroll
            for (int ai = 0; ai < 2; ++ai)
#pragma unroll
                for (int m = 0; m < 4; ++m) {
                    const unsigned off = off0 + (unsigned)((ai * 128 + m * 16) * ld); float s = 0.f, s2 = 0.f;
#pragma unroll
                    for (int bj = 0; bj < 2; ++bj) { f32x4 v0 = acc[ai][bj][m][0], v1 = acc[ai][bj][m][1];
                        if (act == 1) { v0 = gelu4(v0); v1 = gelu4(v1); }
                        else if (act >= 2) {
#pragma unroll
                            for (int e = 0; e < 4; ++e) { const float t0 = sigmoidf_(v0[e]), t1 = sigmoidf_(v1[e]); v0[e] = act == 2 ? v0[e] * t0 : t0; v1[e] = act == 2 ? v1[e] * t1 : t1; } }
                        if (stats) {
#pragma unroll
                            for (int e = 0; e < 4; ++e) { s += v0[e] + v1[e]; s2 += v0[e] * v0[e] + v1[e] * v1[e]; } }
                        store8bf(base + off + bj * 128, v0, v1); }
                    if (stats) { s += __shfl_xor(s, 16); s += __shfl_xor(s, 32); s2 += __shfl_xor(s2, 16); s2 += __shfl_xor(s2, 32);
                        if (fq == 0) { float* sp = vstat + (unsigned)((row0 + ai * 128 + m * 16) * 64); sp[0] = s; sp[1] = s2; } }
                    __builtin_amdgcn_sched_barrier(0);
                }
        } else if (wc == 0) {
            float* bg = (float*)(ws + WS_BG);
            const unsigned boff0 = (unsigned)(row0 * 32 + 8 * fq);
            if (fq < 2) {
#pragma unroll
                for (int ai = 0; ai < 2; ++ai)
#pragma unroll
                    for (int m = 0; m < 4; ++m) {
#pragma unroll
                        for (int n = 0; n < 2; ++n) { const f32x4 v = acc[ai][0][m][n]; f32x4 o;
#pragma unroll
                            for (int e = 0; e < 4; ++e) o[e] = sigmoidf_(v[e]);
                            *(f32x4*)(bg + boff0 + (unsigned)((ai * 128 + m * 16) * 32 + 4 * n)) = o; }
                        __builtin_amdgcn_sched_barrier(0); }
            } else {
                const int h0 = 8 * (fq - 2);
#pragma unroll
                for (int n = 0; n < 2; ++n) {
                    f32x4 na = *(const f32x4*)(a_log + h0 + 4 * n); const f32x4 db = *(const f32x4*)(dt_bias + h0 + 4 * n);
#pragma unroll
                    for (int e = 0; e < 4; ++e) na[e] = -__expf(na[e]);
#pragma unroll
                    for (int ai = 0; ai < 2; ++ai)
#pragma unroll
                        for (int m = 0; m < 4; ++m) { const f32x4 v = acc[ai][0][m][n]; f32x4 o;
#pragma unroll
                            for (int e = 0; e < 4; ++e) { const float xx = v[e] + db[e]; const float sp = xx > 20.f ? xx : __logf(1.0f + __expf(xx)); o[e] = na[e] * sp; }
                            *(f32x4*)(bg + boff0 + (unsigned)((ai * 128 + m * 16) * 32 + 4 * n)) = o;
                            __builtin_amdgcn_sched_barrier(0); }
                }
            }
        }
    }
};
struct Epi4 {
    unsigned char* ws;
    __device__ __forceinline__ void operator()(const Acc& acc, const Unit& u, int wr, int wc, int fr, int fq) const {
        const int which = u.pm >= 33 ? 1 : 0; const int pm = u.pm - 33 * which, pn = u.pn - 8 * which;
        const bf16_t* gate = (const bf16_t*)(ws + (which ? WS_GB : WS_GA)); bf16_t* mt = (bf16_t*)(ws + WS_MTMP); bf16_t* mb = (bf16_t*)(ws + WS_MB);
        const int row0 = pm * 256 + wr * 64 + fr, col0 = pn * 256 + wc * 32 + 8 * fq;
#pragma unroll
        for (int ai = 0; ai < 2; ++ai)
#pragma unroll
            for (int m = 0; m < 4; ++m) { const size_t off = (size_t)(row0 + ai * 128 + m * 16) * DM + col0;
#pragma unroll
                for (int bj = 0; bj < 2; ++bj) { const u32x4 gw = *(const u32x4*)(gate + off + bj * 128);
                    f32x4 g0 = {bflo(gw.x), bfhi(gw.x), bflo(gw.y), bfhi(gw.y)}, g1 = {bflo(gw.z), bfhi(gw.z), bflo(gw.w), bfhi(gw.w)};
                    f32x4 v0 = acc[ai][bj][m][0] * g0, v1 = acc[ai][bj][m][1] * g1;
                    if (which == 0) store8bf(mt + off + bj * 128, v0, v1);
                    else { const u32x4 tw = *(const u32x4*)(mt + off + bj * 128); v0 += (f32x4){bflo(tw.x), bfhi(tw.x), bflo(tw.y), bfhi(tw.y)}; v1 += (f32x4){bflo(tw.z), bfhi(tw.z), bflo(tw.w), bfhi(tw.w)}; store8bf(mb + off + bj * 128, v0, v1); } } }
    }
};
struct EpiRes {
    __device__ __forceinline__ void done(const Unit&) const {}
    const float* resf; const bf16_t* resb; bf16_t* out;
    __device__ __forceinline__ void operator()(const Acc& acc, const Unit& u, int wr, int wc, int fr, int fq) const {
        const int row0 = u.pm * 256 + wr * 64 + fr, col0 = u.pn * 256 + wc * 32 + 8 * fq;
#pragma unroll
        for (int ai = 0; ai < 2; ++ai)
#pragma unroll
            for (int m = 0; m < 4; ++m) { const size_t off = (size_t)(row0 + ai * 128 + m * 16) * DM + col0;
#pragma unroll
                for (int bj = 0; bj < 2; ++bj) { f32x4 r0, r1;
                    if (resf) { r0 = *(const f32x4*)(resf + off + bj * 128); r1 = *(const f32x4*)(resf + off + bj * 128 + 4); }
                    else { const u32x4 w = *(const u32x4*)(resb + off + bj * 128); r0 = (f32x4){bflo(w.x), bfhi(w.x), bflo(w.y), bfhi(w.y)}; r1 = (f32x4){bflo(w.z), bfhi(w.z), bflo(w.w), bfhi(w.w)}; }
                    store8bf(out + off + bj * 128, r0 * ALPHA + acc[ai][bj][m][0], r1 * ALPHA + acc[ai][bj][m][1]); } }
    }
};
struct Epi7 {
    bf16_t* H;
    __device__ __forceinline__ void operator()(const Acc& acc, const Unit& u, int wr, int wc, int fr, int fq) const {
        const int row0 = u.pm * 256 + wr * 64 + fr, col0 = u.pn * 256 + wc * 32 + 8 * fq;
#pragma unroll
        for (int ai = 0; ai < 2; ++ai)
#pragma unroll
            for (int m = 0; m < 4; ++m) { const size_t off = (size_t)(row0 + ai * 128 + m * 16) * DFF + col0;
#pragma unroll
                for (int bj = 0; bj < 2; ++bj) { f32x4 v0 = acc[ai][bj][m][0], v1 = acc[ai][bj][m][1];
#pragma unroll
                    for (int e = 0; e < 4; ++e) { const float a = fmaxf(v0[e], 0.f), b = fmaxf(v1[e], 0.f); v0[e] = a * a; v1[e] = b * b; }
                    store8bf(H + off + bj * 128, v0, v1); } }
    }
};

struct EpiSPart {
    float* part; int ld;
    __device__ __forceinline__ void operator()(const Acc& acc, const Unit& u, int wr, int wc, int fr, int fq) const {
        const int r0 = wr * 64 + fr, col0 = u.pn * 256 + wc * 32 + 8 * fq; float* base = part + (size_t)(u.k0 / u.nt) * 128 * ld;
#pragma unroll
        for (int m = 0; m < 4; ++m) { float* op = base + (size_t)(r0 + m * 16) * ld + col0;
#pragma unroll
            for (int bj = 0; bj < 2; ++bj) { *(f32x4*)(op + bj * 128) = acc[0][bj][m][0]; *(f32x4*)(op + bj * 128 + 4) = acc[0][bj][m][1]; } }
    }
};
struct EpiS4 {
    unsigned char* ws;
    __device__ __forceinline__ void operator()(const Acc& acc, const Unit& u, int wr, int wc, int fr, int fq) const {
        const int which = u.pm >= 33 ? 1 : 0; const int pn = u.pn - 8 * which;
        const bf16_t* gate = (const bf16_t*)(ws + (which ? WS_GB : WS_GA)); float* base = (float*)(ws + WS_PART) + (size_t)(which * 16 + u.k0 / u.nt) * 128 * DM;
        const int r0 = wr * 64 + fr, col0 = pn * 256 + wc * 32 + 8 * fq;
#pragma unroll
        for (int m = 0; m < 4; ++m) { const int r = r0 + m * 16;
#pragma unroll
            for (int bj = 0; bj < 2; ++bj) { const u32x4 gw = *(const u32x4*)(gate + (size_t)(MP + r) * DM + col0 + bj * 128);
                const f32x4 g0 = {bflo(gw.x), bfhi(gw.x), bflo(gw.y), bfhi(gw.y)}, g1 = {bflo(gw.z), bfhi(gw.z), bflo(gw.w), bfhi(gw.w)};
                float* op = base + (size_t)r * DM + col0 + bj * 128; *(f32x4*)op = acc[0][bj][m][0] * g0; *(f32x4*)(op + 4) = acc[0][bj][m][1] * g1; } }
    }
};

__device__ __forceinline__ void transpose_item(const float* W, int K, int N, bf16_t* WT, int dst_row0, LAS float* scr, int kb, int nb, int lane) {
    const int k0 = 64 * kb, n0 = 32 * nb;
#pragma unroll 8
    for (int i = 0; i < 32; ++i) { const int kk = 2 * i + (lane >> 5); scr[kk * 33 + (lane & 31)] = W[(size_t)(k0 + kk) * N + n0 + (lane & 31)]; }
    asm volatile("s_waitcnt lgkmcnt(0)" ::: "memory");
    const int c = lane & 7;
#pragma unroll
    for (int j = 0; j < 4; ++j) { const int n = (lane >> 3) + 8 * j; const LAS float* s = scr + (8 * c) * 33 + n;
        u32x4 o; o.x = pk2(s[0 * 33], s[1 * 33]); o.y = pk2(s[2 * 33], s[3 * 33]); o.z = pk2(s[4 * 33], s[5 * 33]); o.w = pk2(s[6 * 33], s[7 * 33]);
        *(u32x4*)(WT + (size_t)(dst_row0 + n) * K + k0 + 8 * c) = o; }
    asm volatile("s_waitcnt lgkmcnt(0)" ::: "memory");
}
__device__ __forceinline__ void transpose_item_fast(const float* W, int K, int N, bf16_t* WT, int dst_row0, LAS float* scr, int kb, int nb, int lane) {
    const int k0 = 64 * kb, n0 = 32 * nb;
    float v[32];
    const float* src = W + (size_t)(k0 + (lane >> 5)) * N + n0 + (lane & 31);
#pragma unroll
    for (int i = 0; i < 32; ++i) v[i] = src[(size_t)(2 * i) * N];
#pragma unroll
    for (int i = 0; i < 32; ++i) scr[(2 * i + (lane >> 5)) * 33 + (lane & 31)] = v[i];
    asm volatile("s_waitcnt lgkmcnt(0)" ::: "memory");
    const int c = lane & 7;
#pragma unroll
    for (int j = 0; j < 4; ++j) { const int n = (lane >> 3) + 8 * j; const LAS float* s = scr + (8 * c) * 33 + n;
        u32x4 o; o.x = pk2(s[0 * 33], s[1 * 33]); o.y = pk2(s[2 * 33], s[3 * 33]); o.z = pk2(s[4 * 33], s[5 * 33]); o.w = pk2(s[6 * 33], s[7 * 33]);
        *(u32x4*)(WT + (size_t)(dst_row0 + n) * K + k0 + 8 * c) = o; }
    asm volatile("s_waitcnt lgkmcnt(0)" ::: "memory");
}
__device__ __forceinline__ void transpose64(const float* W, int N, bf16_t* WT, int K, int k0, int n0, int dst_row0, LAS float* scr, int lane) {
    f32x4 v[16];
    const float* src = W + (size_t)(k0 + (lane >> 4)) * N + n0 + (lane & 15) * 4;
#pragma unroll
    for (int t = 0; t < 16; ++t) v[t] = *(const f32x4*)(src + (size_t)(4 * t) * N);
#pragma unroll
    for (int t = 0; t < 16; ++t) { LAS float* d = scr + (4 * t + (lane >> 4)) * 65 + (lane & 15) * 4; d[0] = v[t][0]; d[1] = v[t][1]; d[2] = v[t][2]; d[3] = v[t][3]; }
    asm volatile("s_waitcnt lgkmcnt(0)" ::: "memory");
    const int c = lane & 7;
#pragma unroll
    for (int j = 0; j < 8; ++j) { const int n = (lane >> 3) + 8 * j; const LAS float* s = scr + (8 * c) * 65 + n;
        u32x4 o; o.x = pk2(s[0 * 65], s[1 * 65]); o.y = pk2(s[2 * 65], s[3 * 65]); o.z = pk2(s[4 * 65], s[5 * 65]); o.w = pk2(s[6 * 65], s[7 * 65]);
        *(u32x4*)(WT + (size_t)(dst_row0 + n) * K + k0 + 8 * c) = o; }
    asm volatile("s_waitcnt lgkmcnt(0)" ::: "memory");
}
__device__ __forceinline__ void ln_row(const float* src, const float* g, const float* b, float* dstf, bf16_t* dstb, int lane, int nparts = 0, size_t pstride = 0, const float* res = nullptr) {
    f32x4 v[8]; float s = 0.f;
    if (nparts == 0) {
#pragma unroll
        for (int j = 0; j < 8; ++j) v[j] = *(const f32x4*)(src + (lane + 64 * j) * 4);
    } else {
#pragma unroll
        for (int j = 0; j < 8; ++j) v[j] = *(const f32x4*)(res + (lane + 64 * j) * 4) * ALPHA;
        for (int sl = 0; sl < nparts; ++sl) {
#pragma unroll
            for (int j = 0; j < 8; ++j) v[j] += *(const f32x4*)(src + (size_t)sl * pstride + (lane + 64 * j) * 4);
        }
    }
#pragma unroll
    for (int j = 0; j < 8; ++j) s += (v[j][0] + v[j][1]) + (v[j][2] + v[j][3]);
    const float mean = wave_sum(s) * (1.f / DM); float s2 = 0.f;
#pragma unroll
    for (int j = 0; j < 8; ++j) { v[j] = v[j] - mean; s2 += (v[j][0] * v[j][0] + v[j][1] * v[j][1]) + (v[j][2] * v[j][2] + v[j][3] * v[j][3]); }
    const float rstd = 1.0f / sqrtf(wave_sum(s2) * (1.f / DM) + LN_EPS);
#pragma unroll
    for (int j = 0; j < 8; ++j) { const int c = (lane + 64 * j) * 4; const f32x4 gg = *(const f32x4*)(g + c), bb = *(const f32x4*)(b + c); const f32x4 y = v[j] * rstd * gg + bb;
        if (dstf) *(f32x4*)(dstf + c) = y;
        if (dstb) { u32x2 w; w.x = pk2(y[0], y[1]); w.y = pk2(y[2], y[3]); *(u32x2*)(dstb + c) = w; } }
}

__device__ __forceinline__ void ln_row_b(const bf16_t* src, const float* g, const float* b, float* dstf, bf16_t* dstb, int lane) {
    float v[4][8]; float s = 0.f;
#pragma unroll
    for (int j = 0; j < 4; ++j) { const u32x4 w = *(const u32x4*)(src + (lane + 64 * j) * 8);
        v[j][0] = bflo(w.x); v[j][1] = bfhi(w.x); v[j][2] = bflo(w.y); v[j][3] = bfhi(w.y); v[j][4] = bflo(w.z); v[j][5] = bfhi(w.z); v[j][6] = bflo(w.w); v[j][7] = bfhi(w.w);
#pragma unroll
        for (int e = 0; e < 8; ++e) s += v[j][e]; }
    const float mean = wave_sum(s) * (1.f / DM); float s2 = 0.f;
#pragma unroll
    for (int j = 0; j < 4; ++j)
#pragma unroll
        for (int e = 0; e < 8; ++e) { v[j][e] -= mean; s2 += v[j][e] * v[j][e]; }
    const float rstd = 1.0f / sqrtf(wave_sum(s2) * (1.f / DM) + LN_EPS);
#pragma unroll
    for (int j = 0; j < 4; ++j) { const int c = (lane + 64 * j) * 8; const f32x4 g0 = *(const f32x4*)(g + c), g1 = *(const f32x4*)(g + c + 4), b0 = *(const f32x4*)(b + c), b1 = *(const f32x4*)(b + c + 4);
        const f32x4 y0 = (f32x4){v[j][0], v[j][1], v[j][2], v[j][3]} * rstd * g0 + b0, y1 = (f32x4){v[j][4], v[j][5], v[j][6], v[j][7]} * rstd * g1 + b1;
        if (dstf) { *(f32x4*)(dstf + c) = y0; *(f32x4*)(dstf + c + 4) = y1; }
        if (dstb) store8bf(dstb + c, y0, y1); }
}

__device__ __forceinline__ void prescan_item(const Params& p, LAS unsigned char* lds, int it, int cvt_base) {
    const int tid = threadIdx.x, wid = tid >> 6, lane = tid & 63;
    const int bh = it >> 5, n = it & 31, b = bh >> 4, h = bh & 15, t0 = n * 64, mrow0 = b * SEQ + t0;
    LAS bf16_t* Kb = (LAS bf16_t*)(lds);
    LAS bf16_t* Qb = (LAS bf16_t*)(lds + 17408);
    LAS float* NfT = (LAS float*)(lds + 34816);
    LAS bf16_t* KdT = (LAS bf16_t*)(lds + 52224);
    LAS bf16_t* VbT = (LAS bf16_t*)(lds + 70656);
    LAS bf16_t* KbgT = (LAS bf16_t*)(lds + 89088);
    LAS bf16_t* Tb = (LAS bf16_t*)(lds + 107520);
    LAS float* sm_beta = (LAS float*)(lds + 116736);
    LAS float* sm_gc = sm_beta + 64;
    LAS float* Wc = (LAS float*)(lds + 117248);
    LAS float* OH = (LAS float*)(lds + 123392);
    unsigned char* ps = p.ws + WS_PS + (size_t)it * PS_ITEM;
    const float* bg = (const float*)(p.ws + WS_BG);
    const bf16_t* qkv = (const bf16_t*)(p.ws + WS_QKV);
    const int ri = tid >> 3, c0 = (tid & 7) * 16;
    u32x4 raw[3][4][2];
    {
        const unsigned char* qb = (const unsigned char*)qkv;
#pragma unroll
        for (int j = 0; j < 4; ++j) {
            const int tt = t0 + ri - 3 + j, ttc = tt < 0 ? 0 : tt;
            const unsigned off = (unsigned)(((b * SEQ + ttc) * DQKV + h * 128 + c0) * 2);
#pragma unroll
            for (int sec = 0; sec < 2; ++sec) {
                u32x4 a0 = *(const u32x4*)(qb + (size_t)(off + sec * 4096u)), a1 = *(const u32x4*)(qb + (size_t)(off + sec * 4096u + 16u));
                if (tt < 0) { a0 = (u32x4){0u, 0u, 0u, 0u}; a1 = (u32x4){0u, 0u, 0u, 0u}; }
                raw[sec][j][0] = a0; raw[sec][j][1] = a1;
            }
        }
    }
#pragma unroll
    for (int k = 0; k < 3; ++k) { const int idx = tid + 512 * k, j = idx / 384, rem = idx % 384; Wc[idx] = p.w_conv[(size_t)j * DQKV + (rem >> 7) * DM + h * 128 + (rem & 127)]; }
    if (tid >= 384) OH[tid - 384] = (tid == 384 + 64) ? 1.f : 0.f;
    if (wid == 0) {
        const float be = bg[(size_t)(mrow0 + lane) * 32 + h]; float g = bg[(size_t)(mrow0 + lane) * 32 + 16 + h];
#pragma unroll
        for (int o = 1; o < 64; o <<= 1) { const float t = __shfl_up(g, o); if (lane >= o) g += t; }
        sm_beta[lane] = be; sm_gc[lane] = g;
        if (lane == 63) ((float*)(p.ws + WS_GL))[it] = __expf(g);
    }
    lds_barrier();
    {
        const int i = ri;
        const int isw = i ^ ((tid & 7) << 3);
        const float gci = sm_gc[i], bei = sm_beta[i], gcl = sm_gc[63];
        const float eg = __expf(gci), ekd = __expf(gcl - gci);
#pragma unroll
        for (int sec = 0; sec < 3; ++sec) {
            float vals[16];
            asm volatile("" ::: "memory"); __builtin_amdgcn_sched_barrier(0);
            if (sec == 1) {
                const unsigned char* qb = (const unsigned char*)qkv;
#pragma unroll
                for (int j = 0; j < 4; ++j) { const int tt = t0 + ri - 3 + j, ttc = tt < 0 ? 0 : tt; const unsigned off = (unsigned)(((b * SEQ + ttc) * DQKV + h * 128 + c0) * 2) + 8192u;
                    u32x4 a0 = *(const u32x4*)(qb + (size_t)off), a1 = *(const u32x4*)(qb + (size_t)(off + 16u));
                    if (tt < 0) { a0 = (u32x4){0u, 0u, 0u, 0u}; a1 = (u32x4){0u, 0u, 0u, 0u}; }
                    raw[2][j][0] = a0; raw[2][j][1] = a1; }
                asm volatile("" ::: "memory"); __builtin_amdgcn_sched_barrier(0);
            }
#pragma unroll
            for (int e = 0; e < 16; ++e) vals[e] = 0.f;
#pragma unroll
            for (int j = 0; j < 4; ++j) {
                const LAS float* wp = Wc + (j * 3 + sec) * 128 + c0;
                const f32x4 w0 = *(const LAS f32x4*)wp, w1 = *(const LAS f32x4*)(wp + 4), w2 = *(const LAS f32x4*)(wp + 8), w3 = *(const LAS f32x4*)(wp + 12);
                const u32x4 r0 = raw[sec][j][0], r1 = raw[sec][j][1];
                vals[0] += bflo(r0.x) * w0[0]; vals[1] += bfhi(r0.x) * w0[1]; vals[2] += bflo(r0.y) * w0[2]; vals[3] += bfhi(r0.y) * w0[3];
                vals[4] += bflo(r0.z) * w1[0]; vals[5] += bfhi(r0.z) * w1[1]; vals[6] += bflo(r0.w) * w1[2]; vals[7] += bfhi(r0.w) * w1[3];
                vals[8] += bflo(r1.x) * w2[0]; vals[9] += bfhi(r1.x) * w2[1]; vals[10] += bflo(r1.y) * w2[2]; vals[11] += bfhi(r1.y) * w2[3];
                vals[12] += bflo(r1.z) * w3[0]; vals[13] += bfhi(r1.z) * w3[1]; vals[14] += bflo(r1.w) * w3[2]; vals[15] += bfhi(r1.w) * w3[3];
            }
#pragma unroll
            for (int e = 0; e < 16; ++e) vals[e] = siluf_(vals[e]);
            if (sec < 2) {
                float sq = 0.f;
#pragma unroll
                for (int e = 0; e < 16; ++e) sq += vals[e] * vals[e];
                sq += __shfl_xor(sq, 1); sq += __shfl_xor(sq, 2); sq += __shfl_xor(sq, 4);
                const float rn = (1.0f / sqrtf(sq + RMS_EPS)) * (sec == 0 ? 0.08838834764831845f : 1.0f);
#pragma unroll
                for (int e = 0; e < 16; ++e) vals[e] *= rn;
                unsigned w8[8];
#pragma unroll
                for (int e = 0; e < 8; ++e) w8[e] = pk2(vals[2 * e], vals[2 * e + 1]);
                LAS bf16_t* dst = (sec == 0 ? Qb : Kb) + i * 136 + c0;
                *(LAS u32x4*)dst = (u32x4){w8[0], w8[1], w8[2], w8[3]}; *(LAS u32x4*)(dst + 8) = (u32x4){w8[4], w8[5], w8[6], w8[7]};
                asm volatile("" ::: "memory"); __builtin_amdgcn_sched_barrier(0);
                if (sec == 0) {
#pragma unroll
                    for (int e = 0; e < 8; ++e) w8[e] = pk2(vals[2 * e] * eg, vals[2 * e + 1] * eg);
                    bf16_t* qdp = (bf16_t*)(ps + PS_QD) + i * 128 + c0;
                    *(u32x4*)qdp = (u32x4){w8[0], w8[1], w8[2], w8[3]}; *(u32x4*)(qdp + 8) = (u32x4){w8[4], w8[5], w8[6], w8[7]};
                } else {
#pragma unroll
                    for (int e = 0; e < 16; ++e) KdT[(c0 + e) * 72 + isw] = (bf16_t)(pk2(vals[e] * ekd, 0.f) & 0xffffu);
                    asm volatile("" ::: "memory"); __builtin_amdgcn_sched_barrier(0);
                    const float bk = bei * eg;
#pragma unroll
                    for (int e = 0; e < 16; ++e) KbgT[(c0 + e) * 72 + isw] = (bf16_t)(pk2(bk * vals[e], 0.f) & 0xffffu);
                }
            } else {
#pragma unroll
                for (int e = 0; e < 16; ++e) VbT[(c0 + e) * 72 + isw] = (bf16_t)(pk2(bei * vals[e], 0.f) & 0xffffu);
            }
        }
    }
    lds_barrier();
    {
        const int mat = wid >> 2, mi = wid & 3, fr = lane & 15, fq = lane >> 4;
        LAS bf16_t* Asrc = mat ? Qb : Kb;
        bf16x8 af[4];
#pragma unroll
        for (int s = 0; s < 4; ++s) af[s] = *(const LAS bf16x8*)(Asrc + (16 * mi + fr) * 136 + 32 * s + 8 * fq);
#pragma unroll
        for (int nj = 0; nj < 4; ++nj) {
            f32x4 acc = {0.f, 0.f, 0.f, 0.f};
            if (nj <= mi) {
#pragma unroll
                for (int s = 0; s < 4; ++s) { const bf16x8 bfr = *(const LAS bf16x8*)(Kb + (16 * nj + fr) * 136 + 32 * s + 8 * fq); acc = __builtin_amdgcn_mfma_f32_16x16x32_bf16(af[s], bfr, acc, 0, 0, 0); }
            }
            const int jj = 16 * nj + fr; const float gcj = sm_gc[jj];
            if (mat == 0) { f32x4 o;
#pragma unroll
                for (int j = 0; j < 4; ++j) { const int i = 16 * mi + 4 * fq + j; const float dec = __expf(fminf(sm_gc[i] - gcj, 0.f)); o[j] = (i > jj) ? sm_beta[i] * acc[j] * dec : 0.f; }
                *(LAS f32x4*)(NfT + jj * 68 + 16 * mi + 4 * fq) = o;
            } else {
#pragma unroll
                for (int j = 0; j < 4; ++j) { const int i = 16 * mi + 4 * fq + j; const float dec = __expf(fminf(sm_gc[i] - gcj, 0.f));
                    ((bf16_t*)(ps + PS_AT))[i * 64 + jj] = (bf16_t)(pk2((i >= jj) ? acc[j] * dec : 0.f, 0.f) & 0xffffu); }
            }
        }
    }
    lds_barrier();
    if (tid < 128) {
        const int c = tid >> 1, half = tid & 1; f32x2 r2[16];
        const LAS float* ohp = OH + 64 - c + 4 * half;
#pragma unroll
        for (int li = 0; li < 8; ++li) { r2[2 * li] = (f32x2){ohp[8 * li], ohp[8 * li + 1]}; r2[2 * li + 1] = (f32x2){ohp[8 * li + 2], ohp[8 * li + 3]}; }
        const LAS float* nb = NfT + half * 4;
#pragma unroll
        for (int j = 0; j < 63; ++j) {
            const int jc = j >> 2, lj = jc >> 1, ej = j & 3;
            const float xm = (ej & 2) ? ((ej & 1) ? r2[2 * lj + 1].y : r2[2 * lj + 1].x) : ((ej & 1) ? r2[2 * lj].y : r2[2 * lj].x);
            const float xo = __shfl_xor(xm, 1);
            const float xj = ((jc & 1) == half) ? xm : xo;
            const f32x2 xj2 = {xj, xj};
#pragma unroll
            for (int li = lj; li < 8; ++li) {
                f32x4 nv = *(const LAS f32x4*)(nb + j * 68 + 8 * li);
                if (li == lj) {
                    const int rowb = 4 * (2 * li + half);
#pragma unroll
                    for (int e = 0; e < 4; ++e) nv[e] = (rowb + e > j) ? nv[e] : 0.f;
                }
                r2[2 * li] = r2[2 * li] - (f32x2){nv[0], nv[1]} * xj2; r2[2 * li + 1] = r2[2 * li + 1] - (f32x2){nv[2], nv[3]} * xj2;
            }
            asm volatile("" ::: "memory"); __builtin_amdgcn_sched_barrier(0);
        }
#pragma unroll
        for (int li = 0; li < 8; ++li) { const int rb = 4 * (2 * li + half);
            Tb[(rb) * 72 + c] = (bf16_t)(pk2(r2[2 * li].x, 0.f) & 0xffffu); Tb[(rb + 1) * 72 + c] = (bf16_t)(pk2(r2[2 * li].y, 0.f) & 0xffffu);
            Tb[(rb + 2) * 72 + c] = (bf16_t)(pk2(r2[2 * li + 1].x, 0.f) & 0xffffu); Tb[(rb + 3) * 72 + c] = (bf16_t)(pk2(r2[2 * li + 1].y, 0.f) & 0xffffu); }
    } else if (tid >= 256) {
        const int t2 = tid - 256; bf16_t* kd = (bf16_t*)(ps + PS_KDT);
#pragma unroll
        for (int k = 0; k < 4; ++k) { const int q = t2 + 256 * k, row = q >> 3, cc = q & 7; *(u32x4*)(kd + row * 64 + cc * 8) = *(const LAS u32x4*)(KdT + row * 72 + (cc ^ ((row >> 4) & 7)) * 8); }
        if (cvt_base >= 0) {
            LAS float* scr = (LAS float*)(lds + 124928 + (wid - 4) * 8448);
#pragma unroll 1
            for (int r = 0; r < 2; ++r) { const int t = cvt_base + (wid - 4) * 2 + r;
                if (t < 8192) transpose_item_fast(p.w_up, DM, DFF, (bf16_t*)(p.ws + WS_WUPT), 32 * (t & 255), scr, t >> 8, t & 255, lane);
                else { const int u = t - 8192; transpose_item_fast(p.w_down, DFF, DM, (bf16_t*)(p.ws + WS_WDNT), 32 * (u & 63), scr, u >> 6, u & 63, lane); } }
        }
    }
    lds_barrier();
    {
        const int fr = lane & 15, fq = lane >> 4;
        float* wout = (float*)(ps + PS_W); bf16_t* kout = (bf16_t*)(ps + PS_KCD);
        bf16x8 tf[4][2];
#pragma unroll
        for (int mi = 0; mi < 4; ++mi)
#pragma unroll
            for (int s = 0; s < 2; ++s) tf[mi][s] = *(const LAS bf16x8*)(Tb + (16 * mi + fr) * 72 + 32 * s + 8 * fq);
#pragma unroll
        for (int t = 0; t < 2; ++t) {
            const int ni = wid * 2 + t;
            const bf16x8 b0 = *(const LAS bf16x8*)(VbT + (16 * ni + fr) * 72 + 8 * (fq ^ (ni & 7))), b1 = *(const LAS bf16x8*)(VbT + (16 * ni + fr) * 72 + 8 * ((4 + fq) ^ (ni & 7)));
#pragma unroll
            for (int mi = 0; mi < 4; ++mi) {
                f32x4 acc = {0.f, 0.f, 0.f, 0.f};
                acc = __builtin_amdgcn_mfma_f32_16x16x32_bf16(tf[mi][0], b0, acc, 0, 0, 0);
                acc = __builtin_amdgcn_mfma_f32_16x16x32_bf16(tf[mi][1], b1, acc, 0, 0, 0);
                if (ni < 8) {
                    const int e = 16 * ni + fr; const unsigned wb = (unsigned)((e >> 5) * 1024 + (fq >> 1) * 128 + (fq & 1) * 32 + (e & 31));
                    unsigned* w32 = (unsigned*)wout + wb + (unsigned)((mi >> 1) * 512 + (mi & 1) * 256);
                    w32[0] = pk2(acc[0], acc[1]); w32[64] = pk2(acc[2], acc[3]);
                } else {
                    const unsigned kb_ = (unsigned)(4 * fq * 128 + 16 * (ni - 8) + fr);
#pragma unroll
                    for (int j = 0; j < 4; ++j) kout[kb_ + (unsigned)((16 * mi + j) * 128)] = (bf16_t)(pk2(-acc[j], 0.f) & 0xffffu);
                }
                asm volatile("" ::: "memory"); __builtin_amdgcn_sched_barrier(0);
            }
        }
    }
    lds_barrier();
}

__device__ __forceinline__ bf16x8 packs(const f32x16& x, int s) {
    u32x4 w; w.x = pk2(x[8 * s], x[8 * s + 1]); w.y = pk2(x[8 * s + 2], x[8 * s + 3]); w.z = pk2(x[8 * s + 4], x[8 * s + 5]); w.w = pk2(x[8 * s + 6], x[8 * s + 7]); return __builtin_bit_cast(bf16x8, w);
}
__device__ __forceinline__ bf16x8 ldA2(const LAS bf16_t* p) { const u32x2 a = *(const LAS u32x2*)p, b = *(const LAS u32x2*)(p + 8); u32x4 w = {a.x, a.y, b.x, b.y}; return __builtin_bit_cast(bf16x8, w); }
#define MFMA32(a, b, c) __builtin_amdgcn_mfma_f32_32x32x16_bf16((a), (b), (c), 0, 0, 0)
__device__ __forceinline__ int crow(int reg, int hh) { return (reg & 3) + 8 * (reg >> 2) + 4 * hh; }

__device__ __forceinline__ void scan_stage(const unsigned char* src, LAS unsigned char* bb, int t2) {
    constexpr int O_KCD = 0, O_QD = 16896, O_KDT = 33792, O_AT = 51200;
#pragma unroll
    for (int half = 0; half < 2; ++half) {
        u32x4 stg[7];
#pragma unroll
        for (int k = 0; k < 7; ++k) stg[k] = *(const u32x4*)(src + (size_t)(t2 + 256 * (7 * half + k)) * 16);
#pragma unroll
        for (int k = 0; k < 7; ++k) { const int kk = 7 * half + k, q = t2 + 256 * kk; LAS unsigned char* d_;
            if (kk < 4) d_ = bb + O_KCD + (q >> 4) * 264 + (q & 15) * 16; else if (kk < 8) d_ = bb + O_QD + ((q - 1024) >> 4) * 264 + (q & 15) * 16;
            else if (kk < 12) d_ = bb + O_KDT + ((q - 2048) >> 3) * 136 + (q & 7) * 16; else d_ = bb + O_AT + ((q - 3072) >> 3) * 136 + (q & 7) * 16;
            *(LAS u32x2*)d_ = (u32x2){stg[k].x, stg[k].y}; *(LAS u32x2*)(d_ + 8) = (u32x2){stg[k].z, stg[k].w}; }
    }
}
__device__ __forceinline__ void scan_onorm(const Params& p, const LAS bf16_t* Ob, bf16_t* zrow0, int h, int t2) {
    const int oi = t2 >> 2, oq = t2 & 3; u32x4 ov[4];
#pragma unroll
    for (int k = 0; k < 4; ++k) ov[k] = *(const LAS u32x4*)(Ob + oi * 136 + oq * 32 + 8 * k);
    float ov_f[32];
#pragma unroll
    for (int k = 0; k < 4; ++k) { ov_f[8 * k] = bflo(ov[k].x); ov_f[8 * k + 1] = bfhi(ov[k].x); ov_f[8 * k + 2] = bflo(ov[k].y); ov_f[8 * k + 3] = bfhi(ov[k].y);
        ov_f[8 * k + 4] = bflo(ov[k].z); ov_f[8 * k + 5] = bfhi(ov[k].z); ov_f[8 * k + 6] = bflo(ov[k].w); ov_f[8 * k + 7] = bfhi(ov[k].w); }
    float ss = 0.f;
#pragma unroll
    for (int e = 0; e < 32; ++e) ss += ov_f[e] * ov_f[e];
    ss += __shfl_xor(ss, 1); ss += __shfl_xor(ss, 2);
    const float rstd = 1.0f / sqrtf(ss * (1.f / 128.f) + RMS_EPS);
    bf16_t* zp = zrow0 + (size_t)oi * DM + h * 128 + oq * 32; const float* wn = p.w_onorm + oq * 32;
#pragma unroll
    for (int k = 0; k < 4; ++k) { const u32x4 zw = *(const u32x4*)(zp + 8 * k); const f32x4 w0 = *(const f32x4*)(wn + 8 * k), w1 = *(const f32x4*)(wn + 8 * k + 4);
        u32x4 o; o.x = pk2(ov_f[8 * k] * rstd * w0[0] * bflo(zw.x), ov_f[8 * k + 1] * rstd * w0[1] * bfhi(zw.x));
        o.y = pk2(ov_f[8 * k + 2] * rstd * w0[2] * bflo(zw.y), ov_f[8 * k + 3] * rstd * w0[3] * bfhi(zw.y));
        o.z = pk2(ov_f[8 * k + 4] * rstd * w1[0] * bflo(zw.z), ov_f[8 * k + 5] * rstd * w1[1] * bfhi(zw.z));
        o.w = pk2(ov_f[8 * k + 6] * rstd * w1[2] * bflo(zw.w), ov_f[8 * k + 7] * rstd * w1[3] * bfhi(zw.w));
        *(u32x4*)(zp + 8 * k) = o; }
}
__device__ __forceinline__ void scan_bh(const Params& p, LAS unsigned char* lds, int bh) {
    const int tid = threadIdx.x, wid = __builtin_amdgcn_readfirstlane(tid >> 6), lane = tid & 63, r = lane & 31, hh = lane >> 5;
    const int b = bh >> 4, h = bh & 15;
    constexpr int BUFB = 59904, O_KCD = 0, O_QD = 16896, O_KDT = 33792, O_AT = 51200, OBUFB = 17408;
    LAS unsigned char* Obase = lds + 2 * BUFB;
    const unsigned char* psb = p.ws + WS_PS + (size_t)(bh * 32) * PS_ITEM;
    const float* gl = (const float*)(p.ws + WS_GL) + bh * 32;
    bf16_t* Zb = (bf16_t*)(p.ws + WS_Z) + (size_t)(b * SEQ) * DM;
    if (wid >= 4) scan_stage(psb + PS_KCD, lds, tid - 256);
    lds_barrier();
    if (wid < 4) {
        f32x16 S[4], Vn[2], O[2];
#pragma unroll
        for (int d = 0; d < 4; ++d)
#pragma unroll
            for (int i = 0; i < 16; ++i) S[d][i] = 0.f;
        const int e0 = 32 * wid + r;
        { const unsigned* wsrc = (const unsigned*)(psb + PS_W) + wid * 1024 + lane;
#pragma unroll
            for (int mi = 0; mi < 2; ++mi)
#pragma unroll
                for (int k = 0; k < 8; ++k) { const unsigned u = wsrc[(mi * 8 + k) * 64]; Vn[mi][2 * k] = bflo(u); Vn[mi][2 * k + 1] = bfhi(u); } }
        const float glv = gl[lane & 31];
        for (int n = 0; n < 32; ++n) {
            LAS unsigned char* bb = lds + (n & 1) * BUFB;
            unsigned Wp[16];
            if (n + 1 < 32) { const unsigned* wsrc = (const unsigned*)(psb + (size_t)(n + 1) * PS_ITEM + PS_W) + wid * 1024 + lane;
#pragma unroll
                for (int k = 0; k < 16; ++k) Wp[k] = wsrc[k * 64]; }
            const LAS bf16_t* kcd = (const LAS bf16_t*)(bb + O_KCD); const LAS bf16_t* qdl = (const LAS bf16_t*)(bb + O_QD);
            const LAS bf16_t* kdt = (const LAS bf16_t*)(bb + O_KDT); const LAS bf16_t* att = (const LAS bf16_t*)(bb + O_AT);
            LAS bf16_t* Obuf = (LAS bf16_t*)(Obase + (n & 1) * OBUFB);
#pragma unroll
            for (int mi = 0; mi < 2; ++mi)
#pragma unroll
                for (int i = 0; i < 16; ++i) O[mi][i] = 0.f;
#pragma unroll
            for (int s = 0; s < 8; ++s) {
                bf16x8 ac[4];
#pragma unroll
                for (int mi = 0; mi < 2; ++mi) { ac[mi] = ldA2(kcd + (32 * mi + r) * 132 + 16 * s + 4 * hh); ac[2 + mi] = ldA2(qdl + (32 * mi + r) * 132 + 16 * s + 4 * hh); }
                const bf16x8 sf = packs(S[s >> 1], s & 1);
#pragma unroll
                for (int mi = 0; mi < 2; ++mi) { Vn[mi] = MFMA32(ac[mi], sf, Vn[mi]); O[mi] = MFMA32(ac[2 + mi], sf, O[mi]); }
                __builtin_amdgcn_sched_barrier(0);
            }
            bf16x8 vf[4];
#pragma unroll
            for (int s = 0; s < 4; ++s) vf[s] = packs(Vn[s >> 1], s & 1);
            if (n + 1 < 32) {
#pragma unroll
                for (int mi = 0; mi < 2; ++mi)
#pragma unroll
                    for (int k = 0; k < 8; ++k) { Vn[mi][2 * k] = bflo(Wp[mi * 8 + k]); Vn[mi][2 * k + 1] = bfhi(Wp[mi * 8 + k]); } }
#pragma unroll
            for (int s = 0; s < 2; ++s) O[0] = MFMA32(ldA2(att + (r) * 68 + 16 * s + 4 * hh), vf[s], O[0]);
#pragma unroll
            for (int s = 0; s < 4; ++s) O[1] = MFMA32(ldA2(att + (32 + r) * 68 + 16 * s + 4 * hh), vf[s], O[1]);
            const float g_l = __builtin_bit_cast(float, __builtin_amdgcn_readlane(__builtin_bit_cast(int, glv), n));
#pragma unroll
            for (int d = 0; d < 4; ++d) { S[d] = S[d] * g_l;
#pragma unroll
                for (int s = 0; s < 4; ++s) S[d] = MFMA32(ldA2(kdt + (32 * d + r) * 68 + 16 * s + 4 * hh), vf[s], S[d]); }
#pragma unroll
            for (int mi = 0; mi < 2; ++mi)
#pragma unroll
                for (int i = 0; i < 16; ++i) Obuf[(32 * mi + crow(i, hh)) * 136 + e0] = (bf16_t)(pk2(O[mi][i], 0.f) & 0xffffu);
            lds_barrier();
        }
        float* so = p.out + O_SP + (size_t)bh * 16384;
#pragma unroll
        for (int d = 0; d < 4; ++d)
#pragma unroll
            for (int i = 0; i < 16; ++i) so[(32 * d + crow(i, hh)) * 128 + e0] = S[d][i];
    } else {
        const int t2 = tid - 256, oi = t2 >> 2, oq = t2 & 3;
        u32x4 stg[8], stgb[6], zr[4];
#define SCAN_LD_A(item) do { const unsigned char* s_ = psb + (size_t)(item) * PS_ITEM + PS_KCD; _Pragma("unroll") for (int k = 0; k < 8; ++k) stg[k] = *(const u32x4*)(s_ + (size_t)(t2 + 256 * k) * 16); } while (0)
#define SCAN_LD_B(item) do { const unsigned char* s_ = psb + (size_t)(item) * PS_ITEM + PS_KCD; _Pragma("unroll") for (int k = 0; k < 6; ++k) stgb[k] = *(const u32x4*)(s_ + (size_t)(t2 + 256 * (8 + k)) * 16); } while (0)
#define SCAN_ST_A(bufi) do { LAS unsigned char* bb_ = lds + (bufi) * BUFB; _Pragma("unroll") for (int k = 0; k < 8; ++k) { const int q = t2 + 256 * k; LAS unsigned char* d_; \
            if (k < 4) d_ = bb_ + O_KCD + (q >> 4) * 264 + (q & 15) * 16; else d_ = bb_ + O_QD + ((q - 1024) >> 4) * 264 + (q & 15) * 16; \
            *(LAS u32x2*)d_ = (u32x2){stg[k].x, stg[k].y}; *(LAS u32x2*)(d_ + 8) = (u32x2){stg[k].z, stg[k].w}; } } while (0)
#define SCAN_ST_B(bufi) do { LAS unsigned char* bb_ = lds + (bufi) * BUFB; _Pragma("unroll") for (int k = 0; k < 6; ++k) { const int q = t2 + 256 * (8 + k); LAS unsigned char* d_; \
            if (k < 4) d_ = bb_ + O_KDT + ((q - 2048) >> 3) * 136 + (q & 7) * 16; else d_ = bb_ + O_AT + ((q - 3072) >> 3) * 136 + (q & 7) * 16; \
            *(LAS u32x2*)d_ = (u32x2){stgb[k].x, stgb[k].y}; *(LAS u32x2*)(d_ + 8) = (u32x2){stgb[k].z, stgb[k].w}; } } while (0)
#define SCAN_ZLD(chunk) do { const bf16_t* zp_ = Zb + (size_t)((chunk) * 64 + oi) * DM + h * 128 + oq * 32; _Pragma("unroll") for (int k = 0; k < 4; ++k) zr[k] = *(const u32x4*)(zp_ + 8 * k); } while (0)
#define SCAN_NORM(obuf, chunk) do { const LAS bf16_t* Ob_ = (const LAS bf16_t*)(obuf); u32x4 ov[4]; SCAN_ZLD(chunk); \
            _Pragma("unroll") for (int k = 0; k < 4; ++k) ov[k] = *(const LAS u32x4*)(Ob_ + oi * 136 + oq * 32 + 8 * k); \
            float ss = 0.f; \
            _Pragma("unroll") for (int k = 0; k < 4; ++k) { const float a0 = bflo(ov[k].x), a1 = bfhi(ov[k].x), a2 = bflo(ov[k].y), a3 = bfhi(ov[k].y), a4 = bflo(ov[k].z), a5 = bfhi(ov[k].z), a6 = bflo(ov[k].w), a7 = bfhi(ov[k].w); \
                ss += (a0 * a0 + a1 * a1) + (a2 * a2 + a3 * a3) + (a4 * a4 + a5 * a5) + (a6 * a6 + a7 * a7); } \
            ss += __shfl_xor(ss, 1); ss += __shfl_xor(ss, 2); \
            const float rstd = 1.0f / sqrtf(ss * (1.f / 128.f) + RMS_EPS); \
            bf16_t* zp_ = Zb + (size_t)((chunk) * 64 + oi) * DM + h * 128 + oq * 32; const float* wn = p.w_onorm + oq * 32; \
            _Pragma("unroll") for (int k = 0; k < 4; ++k) { const u32x4 zw = zr[k]; const f32x4 w0 = *(const f32x4*)(wn + 8 * k) * rstd, w1 = *(const f32x4*)(wn + 8 * k + 4) * rstd; \
                u32x4 o; o.x = pk2(bflo(ov[k].x) * w0[0] * bflo(zw.x), bfhi(ov[k].x) * w0[1] * bfhi(zw.x)); \
                o.y = pk2(bflo(ov[k].y) * w0[2] * bflo(zw.y), bfhi(ov[k].y) * w0[3] * bfhi(zw.y)); \
                o.z = pk2(bflo(ov[k].z) * w1[0] * bflo(zw.z), bfhi(ov[k].z) * w1[1] * bfhi(zw.z)); \
                o.w = pk2(bflo(ov[k].w) * w1[2] * bflo(zw.w), bfhi(ov[k].w) * w1[3] * bfhi(zw.w)); \
                *(u32x4*)(zp_ + 8 * k) = o; asm volatile("" ::: "memory"); } } while (0)
        SCAN_LD_A(1); SCAN_LD_B(1);
        for (int n = 0; n < 32; ++n) {
            if (n + 1 < 32) { SCAN_ST_A((n + 1) & 1); SCAN_ST_B((n + 1) & 1); }
            if (n + 2 < 32) { SCAN_LD_A(n + 2); SCAN_LD_B(n + 2); }
            if (n >= 1) SCAN_NORM(Obase + ((n - 1) & 1) * OBUFB, n - 1);
            lds_barrier();
        }
        SCAN_NORM(Obase + OBUFB, 31);
#undef SCAN_LD_A
#undef SCAN_LD_B
#undef SCAN_ST_A
#undef SCAN_ST_B
#undef SCAN_ZLD
#undef SCAN_NORM
    }
    lds_barrier();
}

__device__ __forceinline__ void sample_prefetch(const Params& p, int it, f32x4 (&Sn)[8]) {
    const int tid = threadIdx.x; const float* S0 = p.state_ssm + (size_t)it * 16384 + (tid >> 5) * 1024 + (tid & 31) * 4;
#pragma unroll
    for (int i = 0; i < 8; ++i) Sn[i] = *(const f32x4*)(S0 + i * 128);
}
__device__ __forceinline__ void sample_item(const Params& p, LAS unsigned char* lds, int it, const f32x4 (&Sr)[8]) {
    const int tid = threadIdx.x, wid = tid >> 6, lane = tid & 63;
    const int b = it >> 4, h = it & 15, m = MP + b;
    const int e4 = (tid & 31) * 4, dg = tid >> 5;
    LAS float* vq = (LAS float*)lds;
    LAS float* red = vq + 384;
    LAS float* vnew = vq + 400;
    LAS float* part = vq + 1024;
    const bf16_t* qkv = (const bf16_t*)(p.ws + WS_QKV); const float* bg = (const float*)(p.ws + WS_BG); bf16_t* Zb = (bf16_t*)(p.ws + WS_Z);
    if (tid < 384) { const int sec = tid >> 7, c = tid & 127, col = sec * DM + h * 128 + c;
        float a = bf2f(qkv[(size_t)m * DQKV + col]) * p.w_conv[3 * DQKV + col];
#pragma unroll
        for (int j = 0; j < 3; ++j) a += p.state_conv[(size_t)(b * 3 + j) * DQKV + col] * p.w_conv[j * DQKV + col];
        vq[sec * 128 + c] = siluf_(a); }
    lds_barrier();
    if (wid < 2) { const float a = vq[wid * 128 + lane], c2 = vq[wid * 128 + 64 + lane]; const float s = wave_sum(a * a + c2 * c2); if (lane == 0) red[wid] = s; }
    lds_barrier();
    if (tid < 256) { const int sec = tid >> 7; const float rs = 1.0f / sqrtf(red[sec] + RMS_EPS) * (sec == 0 ? 0.08838834764831845f : 1.0f); vq[tid] *= rs; }
    lds_barrier();
    if (wid == 0) { const float s = wave_sum(vq[lane] * vq[128 + lane] + vq[64 + lane] * vq[192 + lane]); if (lane == 0) red[2] = s; }
    {
        f32x4 ks = {0.f, 0.f, 0.f, 0.f}, qs = {0.f, 0.f, 0.f, 0.f};
#pragma unroll
        for (int i = 0; i < 8; ++i) { const float kk = vq[128 + dg * 8 + i], qq = vq[dg * 8 + i]; ks += Sr[i] * kk; qs += Sr[i] * qq; }
        *(LAS f32x4*)(part + dg * 128 + e4) = ks; *(LAS f32x4*)(part + 2048 + dg * 128 + e4) = qs;
    }
    lds_barrier();
    const float beta = bg[(size_t)m * 32 + h], eg = __expf(bg[(size_t)m * 32 + 16 + h]);
    float o = 0.f;
    if (tid < 128) { float kS = 0.f, qS = 0.f;
#pragma unroll
        for (int d = 0; d < 16; ++d) { kS += part[d * 128 + tid]; qS += part[2048 + d * 128 + tid]; }
        const float vn = beta * (vq[256 + tid] - eg * kS); o = eg * qS + red[2] * vn; vnew[tid] = vn;
        const float s = wave_sum(o * o); if (lane == 0) red[4 + wid] = s; }
    lds_barrier();
    if (tid < 128) { const float rstd = 1.0f / sqrtf((red[4] + red[5]) * (1.f / 128.f) + RMS_EPS); bf16_t* zp = Zb + (size_t)m * DM + h * 128 + tid;
        *zp = (bf16_t)(pk2(o * rstd * p.w_onorm[tid] * bf2f(*zp), 0.f) & 0xffffu); }
    {
        float* So = p.out + O_SS + (size_t)it * 16384; const f32x4 vn4 = *(const LAS f32x4*)(vnew + e4);
#pragma unroll
        for (int i = 0; i < 8; ++i) { const float kk = vq[128 + dg * 8 + i]; *(f32x4*)(So + (dg * 8 + i) * 128 + e4) = Sr[i] * eg + vn4 * kk; }
    }
    lds_barrier();
}

__device__ __forceinline__ void mixerA_item(const Params& p, LAS unsigned char* lds, int it) {
    const int tid = threadIdx.x, wid = tid >> 6, lane = tid & 63, fr = lane & 15, fq = lane >> 4;
    const int b = it >> 8, c = (it >> 4) & 15, g = it & 15, m0 = b * SEQ + c * 128;
    LAS bf16_t* Wt = (LAS bf16_t*)lds;
    LAS bf16_t* VnT = (LAS bf16_t*)(lds + 34816);
    LAS float* st = (LAS float*)(lds + 68608);
    const float* vstat = (const float*)(p.ws + WS_VSTAT); const bf16_t* VA = (const bf16_t*)(p.ws + WS_VA); bf16_t* U = (bf16_t*)(p.ws + WS_U);
    if (tid < 128) { const float* sp = vstat + (size_t)(m0 + tid) * 64; float s = 0.f, s2 = 0.f;
#pragma unroll
        for (int k = 0; k < 16; ++k) { const f32x4 v = *(const f32x4*)(sp + 4 * k); s += v[0] + v[2]; s2 += v[1] + v[3]; }
        const float mu = s * (1.f / DM), var = fmaxf(s2 * (1.f / DM) - mu * mu, 0.f); st[2 * tid] = mu; st[2 * tid + 1] = 1.0f / sqrtf(var + LN_EPS); }
    {
        const float* ws_ = p.w_s + (size_t)g * 16384;
#pragma unroll
        for (int k = 0; k < 8; ++k) { const int idx = tid + 512 * k, t = idx >> 5, s4 = (idx & 31) * 4; f32x4 w = *(const f32x4*)(ws_ + t * 128 + s4);
#pragma unroll
            for (int e = 0; e < 4; ++e) if (s4 + e > t) w[e] = 0.f;
            *(LAS u32x2*)(Wt + t * 136 + s4) = (u32x2){pk2(w[0], w[1]), pk2(w[2], w[3])}; }
    }
    lds_barrier();
#pragma unroll
    for (int k = 0; k < 4; ++k) {
        const int q = tid + 512 * k, l = q & 63, grp = q >> 6, s = (grp >> 2) * 16 + (l >> 2), dc = (grp & 3) * 4 + (l & 3);
        const u32x4 raw = *(const u32x4*)(VA + (size_t)(m0 + s) * DM + g * 128 + dc * 8);
        const float mu = st[2 * s], rs = st[2 * s + 1];
        const float* gp = p.ln_v_g + g * 128 + dc * 8; const float* bp = p.ln_v_b + g * 128 + dc * 8;
        const f32x4 g0 = *(const f32x4*)gp, g1 = *(const f32x4*)(gp + 4), b0 = *(const f32x4*)bp, b1 = *(const f32x4*)(bp + 4);
        float v[8] = {bflo(raw.x), bfhi(raw.x), bflo(raw.y), bfhi(raw.y), bflo(raw.z), bfhi(raw.z), bflo(raw.w), bfhi(raw.w)};
#pragma unroll
        for (int e = 0; e < 8; ++e) { const float gg = e < 4 ? g0[e & 3] : g1[e & 3], bb = e < 4 ? b0[e & 3] : b1[e & 3]; const float y = (v[e] - mu) * rs * gg + bb;
            VnT[(dc * 8 + e) * 132 + s] = (bf16_t)(pk2(y, 0.f) & 0xffffu); }
    }
    lds_barrier();
    {
        bf16x8 wf[4];
        const int nks = ((16 * wid + 15) >> 5) + 1;
#pragma unroll
        for (int s = 0; s < 4; ++s) wf[s] = *(const LAS bf16x8*)(Wt + (16 * wid + fr) * 136 + 32 * s + 8 * fq);
        const int t = 16 * wid + fr; const float bs = p.b_s[g * 128 + t];
#pragma unroll
        for (int mb = 0; mb < 8; ++mb) {
            f32x4 acc = {0.f, 0.f, 0.f, 0.f};
#pragma unroll
            for (int s = 0; s < 4; ++s) if (s < nks) {
                const LAS bf16_t* vp = VnT + (16 * mb + fr) * 132 + 32 * s + 8 * fq; const u32x2 a0 = *(const LAS u32x2*)vp, a1 = *(const LAS u32x2*)(vp + 4);
                u32x4 aw = {a0.x, a0.y, a1.x, a1.y};
                acc = __builtin_amdgcn_mfma_f32_16x16x32_bf16(__builtin_bit_cast(bf16x8, aw), wf[s], acc, 0, 0, 0); }
            bf16_t* up = U + (size_t)(m0 + t) * DM + g * 128 + 16 * mb + 4 * fq; const u32x2 uw = *(const u32x2*)up;
            u32x2 o; o.x = pk2(bflo(uw.x) * (acc[0] + bs), bfhi(uw.x) * (acc[1] + bs)); o.y = pk2(bflo(uw.y) * (acc[2] + bs), bfhi(uw.y) * (acc[3] + bs));
            *(u32x2*)up = o;
        }
    }
    lds_barrier();
}

#define XB_TMO      128
#define XB_XCNT(j)  (256  + 64 * (j))
#define XB_XSUB(j)  (1280 + 64 * (j))
#define XB_XGEN(j)  (2304 + 64 * (j))
#define XB_TOP      3328
#define XB_TOPGEN   3392
#define XCD_BAR_WORDS 3456
#define XB_SPIN_CAP (1u << 18)
__device__ __forceinline__ unsigned xb_ld(unsigned* p)              { return __hip_atomic_load(p, __ATOMIC_RELAXED, __HIP_MEMORY_SCOPE_AGENT); }
__device__ __forceinline__ unsigned xb_add(unsigned* p, unsigned v) { return __hip_atomic_fetch_add(p, v, __ATOMIC_RELAXED, __HIP_MEMORY_SCOPE_AGENT); }
__device__ __forceinline__ unsigned xb_xcc_id() { return (unsigned)__builtin_amdgcn_s_getreg((3 << 11) | 20) & 0xFu; }
#define XB_SPIN(cond, bar) do { unsigned _sp = 0; while (cond) { __builtin_amdgcn_s_sleep(1); \
    if ((++_sp & 255u) == 0u) { if (xb_ld(&(bar)[XB_TMO])) break; if (_sp > XB_SPIN_CAP) { atomicAdd(&(bar)[XB_TMO], 1u); break; } } } } while (0)
struct XcdBarrier { unsigned* bar; unsigned x; volatile LAS unsigned* st; };
__device__ __forceinline__ XcdBarrier xcd_barrier_post(unsigned* bar, volatile LAS unsigned* st) {
    XcdBarrier b; b.bar = bar; b.x = xb_xcc_id(); b.st = st;
    if (threadIdx.x == 0) (void)xb_add(&bar[XB_XCNT(b.x)], 1u);
    return b;
}
__device__ __forceinline__ void xcd_barrier_complete(unsigned* bar, unsigned x, unsigned& nloc, unsigned& nx) {
    const unsigned G = gridDim.x * gridDim.y * gridDim.z;
    unsigned sum, cnt, mine, sp = 0u;
    for (;;) {
        sum = 0u; cnt = 0u; mine = 0u;
#pragma unroll
        for (unsigned j = 0; j < 16; ++j) { const unsigned c = xb_ld(&bar[XB_XCNT(j)]); sum += c; cnt += (c > 0u) ? 1u : 0u; mine = (j == x) ? c : mine; }
        if (sum == G) break;
        __builtin_amdgcn_s_sleep(1);
        if ((++sp & 255u) == 0u) { if (xb_ld(&bar[XB_TMO])) break; if (sp > XB_SPIN_CAP) { atomicAdd(&bar[XB_TMO], 1u); break; } }
    }
    nloc = mine > 0u ? mine : 1u; nx = cnt > 0u ? cnt : 1u;
}
__device__ __forceinline__ void xcd_barrier(const XcdBarrier& b) {
    asm volatile("s_waitcnt vmcnt(0)" ::: "memory");
    __syncthreads();
    if (threadIdx.x == 0) {
        unsigned* bar = b.bar;
        __builtin_amdgcn_s_waitcnt(0);
        unsigned nloc = b.st[0], nx = b.st[1];
        if (nloc == 0u) { xcd_barrier_complete(bar, b.x, nloc, nx); b.st[0] = nloc; b.st[1] = nx; }
        const unsigned old = xb_add(&bar[XB_XSUB(b.x)], 1u);
        const unsigned gen = old / nloc;
        if (old + 1u == (gen + 1u) * nloc) {
            __builtin_amdgcn_fence(__ATOMIC_RELEASE, "agent");
            asm volatile("s_waitcnt vmcnt(0)" ::: "memory");
            const unsigned og = xb_add(&bar[XB_TOP], 1u);
            const unsigned tg = og / nx;
            if (og + 1u == (tg + 1u) * nx) xb_add(&bar[XB_TOPGEN], 1u);
            else XB_SPIN(xb_ld(&bar[XB_TOPGEN]) == tg, bar);
            __builtin_amdgcn_fence(__ATOMIC_ACQUIRE, "agent");
            xb_add(&bar[XB_XGEN(b.x)], 1u);
            asm volatile("s_waitcnt vmcnt(0)" ::: "memory");
        } else {
            XB_SPIN(xb_ld(&bar[XB_XGEN(b.x)]) == gen, bar);
            __builtin_amdgcn_fence(__ATOMIC_ACQUIRE, "agent");
            asm volatile("s_waitcnt vmcnt(0)" ::: "memory");
        }
    }
    __syncthreads();
}

__device__ __forceinline__ unsigned char* opq(unsigned char* q) { asm volatile("" : "+s"(q)); return q; }
__global__ void __launch_bounds__(512, 2) mega_fwd(Params p) {
    extern __shared__ __attribute__((aligned(16))) unsigned char smem[];
    LAS unsigned char* lds = (LAS unsigned char*)smem;
    cg::grid_group grid = cg::this_grid();
    const int tid = threadIdx.x, wid = tid >> 6, lane = tid & 63, G = gridDim.x, blk = blockIdx.x;
    unsigned char* ws = p.ws;
#ifndef PHMASK
#define PHMASK 0x3ff
#endif
#define IN(k) (((PHMASK >> (k)) & 1) && p.ph_lo <= (k) && (k) < p.ph_hi)
#define SEAM(k) do { if (IN(k) && IN((k) + 1)) { if (p.coop == 2) grid.sync(); else xcd_barrier(xbar); } } while (0)
    volatile LAS unsigned* xst = (volatile LAS unsigned*)(lds + 160000);
    if (tid < 2) xst[tid] = 0u;
    __syncthreads();
    const XcdBarrier xbar = xcd_barrier_post((unsigned*)ws, xst);

    if (IN(0)) { unsigned char* ws = opq(p.ws);
        LAS float* scr = (LAS float*)(lds + wid * 16640);
        const int gw = blk * 8 + wid, NGW = G * 8;
        constexpr int I_IN = 32 * 256, I_BG = 32, I_P = 32 * 32;
        const int NIT = I_IN + I_BG + (G == 256 ? 0 : 3 * I_P);
        for (int it = gw; it < NIT; it += NGW) {
            int r = it;
            if (r < I_IN) { const int kb = r >> 8, nb = r & 255; const int n0 = nb < 192 ? 64 * nb : 12320 + 64 * (nb - 192); const int drow = nb < 192 ? n0 : n0 - 32;
                transpose64(p.w_in, 16416, (bf16_t*)(ws + WS_W1T), DM, 64 * kb, n0, drow, scr, lane); continue; }
            r -= I_IN;
            if (r < I_BG) { transpose_item(p.w_in, DM, 16416, (bf16_t*)(ws + WS_W1T), 16384, scr, r, 384, lane); continue; }
            r -= I_BG;
            if (r < I_P) { transpose64(p.w_proj_a, DM, (bf16_t*)(ws + WS_WPT), DM, 64 * (r >> 5), 64 * (r & 31), 64 * (r & 31), scr, lane); continue; } r -= I_P;
            if (r < I_P) { transpose64(p.w_proj_b, DM, (bf16_t*)(ws + WS_WPT), DM, 64 * (r >> 5), 64 * (r & 31), DM + 64 * (r & 31), scr, lane); continue; } r -= I_P;
            transpose64(p.w_o, DM, (bf16_t*)(ws + WS_WOT), DM, 64 * (r >> 5), 64 * (r & 31), 64 * (r & 31), scr, lane);
        }
        bf16_t* xb = (bf16_t*)(ws + WS_XB);
#pragma unroll 4
        for (size_t q = (size_t)blk * 512 + tid; q < (size_t)MPAD * DM / 8; q += (size_t)G * 512) {
            const size_t e = q * 8; const int row = (int)(e / DM);
            u32x4 o = {0u, 0u, 0u, 0u};
            if (row < MT) { const float* src = row < MP ? p.x_prompt + e : p.x_sample + (e - (size_t)MP * DM); const f32x4 a = *(const f32x4*)src, c2 = *(const f32x4*)(src + 4);
                o.x = pk2(a[0], a[1]); o.y = pk2(a[2], a[3]); o.z = pk2(c2[0], c2[1]); o.w = pk2(c2[2], c2[3]); }
            *(u32x4*)(xb + e) = o;
        }
        bf16_t* w1 = (bf16_t*)(ws + WS_W1T);
        for (size_t q = (size_t)blk * 512 + tid; q < (size_t)224 * DM / 8; q += (size_t)G * 512) *(u32x4*)(w1 + (size_t)16416 * DM + q * 8) = (u32x4){0u, 0u, 0u, 0u};
    }
    SEAM(0);
    if (IN(1)) { unsigned char* ws = opq(p.ws);
        pg8::Gemm g{(const bf16_t*)(ws + WS_XB), (const bf16_t*)(ws + WS_W1T), MPAD, N1, DM};
        pg8::Sched S; S.init(33, 65, G, blk, 0, 0, 0, 32);
        Epi1 E{ws, p.a_log, p.dt_bias};
        pg8::gemm_phase<Epi1>(lds, g, S, E);
        if (G == 256) { const int rem = (33 * 65) % 256;
            if (blk >= rem) { LAS float* scr = (LAS float*)(lds + wid * 16640); const int nw = (256 - rem) * 8;
                for (int t = (blk - rem) * 8 + wid; t < 3 * 1024; t += nw) { const int m = t >> 10, r = t & 1023;
                    if (m == 0) transpose64(p.w_proj_a, DM, (bf16_t*)(ws + WS_WPT), DM, 64 * (r >> 5), 64 * (r & 31), 64 * (r & 31), scr, lane);
                    else if (m == 1) transpose64(p.w_proj_b, DM, (bf16_t*)(ws + WS_WPT), DM, 64 * (r >> 5), 64 * (r & 31), DM + 64 * (r & 31), scr, lane);
                    else transpose64(p.w_o, DM, (bf16_t*)(ws + WS_WOT), DM, 64 * (r >> 5), 64 * (r & 31), 64 * (r & 31), scr, lane); } } }
    }
    SEAM(1);
    if (IN(2)) { unsigned char* ws = opq(p.ws);
        { int k = 0; for (int it = blk; it < 2048; it += G, ++k) prescan_item(p, lds, it, (G == 256 && k < 8) ? blk * 64 + k * 8 : -1); }
    }
    SEAM(2);
    if (IN(3)) { unsigned char* ws = opq(p.ws);
        const bool split = G > 64;
        if (blk < 64) { for (int bh = blk; bh < 64; bh += (split ? 64 : G)) scan_bh(p, lds, bh); }
        if (!split || blk >= 64) {
            const int oi = split ? blk - 64 : blk, on = split ? G - 64 : G;
            const bf16_t* qkv = (const bf16_t*)(ws + WS_QKV);
            for (int q = oi * 512 + tid; q < NBP * 3 * DQKV / 4; q += on * 512) { const int e = q * 4, col = e % DQKV, j = (e / DQKV) % 3, bb = e / (3 * DQKV);
                const u32x2 r = *(const u32x2*)(qkv + (size_t)(bb * SEQ + SEQ - 3 + j) * DQKV + col); *(f32x4*)(p.out + O_CP + e) = (f32x4){bflo(r.x), bfhi(r.x), bflo(r.y), bfhi(r.y)}; }
#pragma unroll 2
            for (int q = oi * 512 + tid; q < MS * 3 * DQKV / 4; q += on * 512) { const int e = q * 4, col = e % DQKV, j = (e / DQKV) % 3, bb = e / (3 * DQKV); f32x4 v;
                if (j < 2) v = *(const f32x4*)(p.state_conv + (size_t)(bb * 3 + j + 1) * DQKV + col);
                else { const u32x2 r = *(const u32x2*)(qkv + (size_t)(MP + bb) * DQKV + col); v = (f32x4){bflo(r.x), bfhi(r.x), bflo(r.y), bfhi(r.y)}; }
                *(f32x4*)(p.out + O_CS + e) = v; }
            const float* vstat = (const float*)(ws + WS_VSTAT); const bf16_t* VA = (const bf16_t*)(ws + WS_VA); bf16_t* U = (bf16_t*)(ws + WS_U);
            for (int row = oi * 8 + wid; row < MS; row += on * 8) { const int m = MP + row;
                const f32x2 st = lane < 32 ? *(const f32x2*)(vstat + (size_t)m * 64 + 2 * lane) : (f32x2){0.f, 0.f};
                const float s = wave_sum(st.x), s2 = wave_sum(st.y);
                const float mu = s * (1.f / DM), var = fmaxf(s2 * (1.f / DM) - mu * mu, 0.f), rs = 1.0f / sqrtf(var + LN_EPS);
#pragma unroll
                for (int k = 0; k < 8; ++k) { const int cc = (lane + 64 * k) * 4, gg = cc >> 7;
                    const u32x2 va = *(const u32x2*)(VA + (size_t)m * DM + cc); const f32x4 lg = *(const f32x4*)(p.ln_v_g + cc), lb = *(const f32x4*)(p.ln_v_b + cc);
                    f32x4 vn = {bflo(va.x), bfhi(va.x), bflo(va.y), bfhi(va.y)}; vn = (vn - mu) * rs * lg + lb;
                    *(f32x4*)(p.out + O_GV + (size_t)row * DM + cc) = vn;
                    const float w00 = p.w_s[(size_t)gg * 16384], bs0 = p.b_s[gg * 128];
                    bf16_t* up = U + (size_t)m * DM + cc; const u32x2 uw = *(const u32x2*)up;
                    *(u32x2*)up = (u32x2){pk2(bflo(uw.x) * (w00 * vn[0] + bs0), bfhi(uw.x) * (w00 * vn[1] + bs0)), pk2(bflo(uw.y) * (w00 * vn[2] + bs0), bfhi(uw.y) * (w00 * vn[3] + bs0))}; }
            }
        }
        {
            unsigned* qctr = (unsigned*)ws + 3584;
            volatile LAS int* slot = (volatile LAS int*)(lds + 160016);
            if (tid == 0) { slot[0] = (int)__hip_atomic_fetch_add(qctr, 1u, __ATOMIC_RELAXED, __HIP_MEMORY_SCOPE_AGENT); slot[1] = (int)__hip_atomic_fetch_add(qctr, 1u, __ATOMIC_RELAXED, __HIP_MEMORY_SCOPE_AGENT); }
            lds_barrier();
            int cur = slot[0], nxt = slot[1], par = 0;
            f32x4 Sr[8], Sn[8];
            if (cur < 2048) sample_prefetch(p, cur, Sr);
            lds_barrier();
            while (cur < 3072) {
                unsigned tick = 0u;
                if (tid == 0) tick = __hip_atomic_fetch_add(qctr, 1u, __ATOMIC_RELAXED, __HIP_MEMORY_SCOPE_AGENT);
                if (nxt < 2048) sample_prefetch(p, nxt, Sn);
                if (cur < 2048) sample_item(p, lds, cur, Sr); else mixerA_item(p, lds, cur - 2048);
                if (tid == 0) slot[par] = (int)tick;
                lds_barrier();
                const int nn = slot[par]; par ^= 1;
#pragma unroll
                for (int i = 0; i < 8; ++i) Sr[i] = Sn[i];
                cur = nxt; nxt = nn;
            }
        }
    }
    SEAM(3);
    if (IN(4)) { unsigned char* ws = opq(p.ws);
        pg8::Gemm g{(const bf16_t*)(ws + WS_U), (const bf16_t*)(ws + WS_WPT), 2 * MPAD, 2 * DM, DM};
        { pg8::Sched S; S.init(32, 8, G, blk, 1, 33, 8, 32); Epi4 E{ws}; pg8::gemm_phase<Epi4>(lds, g, S, E); }
        { pg8::Sched S; S.init_split(32, 8, 16, 2, G, blk, 1, 33, 8); EpiS4 E{ws}; pg8::gemm_phase<EpiS4>(lds, g, S, E); }
    }
    SEAM(4);
    if (IN(5)) { unsigned char* ws = opq(p.ws);
        {
            const float* part = (const float*)(ws + WS_PART); bf16_t* MB = (bf16_t*)(ws + WS_MB);
            for (int q = blk * 512 + tid; q < MS * DM / 4; q += G * 512) { f32x4 v = *(const f32x4*)(part + 4 * q);
#pragma unroll 8
                for (int sl = 1; sl < 32; ++sl) v += *(const f32x4*)(part + (size_t)sl * MS * DM + 4 * q);
                *(u32x2*)(MB + (size_t)MP * DM + 4 * q) = (u32x2){pk2(v[0], v[1]), pk2(v[2], v[3])}; }
        }
        pg8::Gemm g{(const bf16_t*)(ws + WS_MB), (const bf16_t*)(ws + WS_WOT), MPAD, DM, DM};
        { pg8::Sched S; S.init(32, 8, G, blk, 0, 0, 0, 32); EpiRes E{p.x_prompt, nullptr, (bf16_t*)(ws + WS_R1)}; pg8::gemm_phase<EpiRes>(lds, g, S, E); }
        xcd_barrier(xbar);
        { pg8::Sched S; S.init_split(32, 8, 16, 2, G, blk, 0, 0, 0); EpiSPart E{(float*)(ws + WS_PART), DM}; pg8::gemm_phase<EpiSPart>(lds, g, S, E); }
    }
    SEAM(5);
    if (IN(6)) { unsigned char* ws = opq(p.ws);
        const int gw = blk * 8 + wid, NGW = G * 8;
        for (int m = gw; m < MT; m += NGW) {
            if (m < MP) ln_row_b((const bf16_t*)(ws + WS_R1) + (size_t)m * DM, p.ln1_g, p.ln1_b, nullptr, (bf16_t*)(ws + WS_X1B) + (size_t)m * DM, lane);
            else ln_row((const float*)(ws + WS_PART) + (size_t)(m - MP) * DM, p.ln1_g, p.ln1_b, (float*)(ws + WS_X1) + (size_t)m * DM, (bf16_t*)(ws + WS_X1B) + (size_t)m * DM, lane, 16, (size_t)MS * DM, p.x_sample + (size_t)(m - MP) * DM);
        }
        LAS float* scr = (LAS float*)(lds + wid * 16640);
        if (G != 256) for (int it = gw; it < 8192; it += NGW) {
            if (it < 4096) transpose64(p.w_up, DFF, (bf16_t*)(ws + WS_WUPT), DM, 64 * (it >> 7), 64 * (it & 127), 64 * (it & 127), scr, lane);
            else { const int r = it - 4096; transpose64(p.w_down, DM, (bf16_t*)(ws + WS_WDNT), DFF, 64 * (r >> 5), 64 * (r & 31), 64 * (r & 31), scr, lane); }
        }
    }
    SEAM(6);
    if (IN(7)) { unsigned char* ws = opq(p.ws);
        pg8::Gemm g{(const bf16_t*)(ws + WS_X1B), (const bf16_t*)(ws + WS_WUPT), MPAD, DFF, DM};
        { pg8::Sched S; S.init(32, 32, G, blk, 0, 0, 0, 32); Epi7 E{(bf16_t*)(ws + WS_H)}; pg8::gemm_phase<Epi7>(lds, g, S, E); }
        { pg8::Sched S; S.init_split(32, 32, 8, 4, G, blk, 0, 0, 0); EpiSPart E{(float*)(ws + WS_PART), DFF}; pg8::gemm_phase<EpiSPart>(lds, g, S, E); }
    }
    SEAM(7);
    if (IN(8)) { unsigned char* ws = opq(p.ws);
        {
            const float* part = (const float*)(ws + WS_PART); bf16_t* H = (bf16_t*)(ws + WS_H);
            for (int q = blk * 512 + tid; q < MS * DFF / 4; q += G * 512) { f32x4 v = *(const f32x4*)(part + 4 * q);
#pragma unroll
                for (int sl = 1; sl < 8; ++sl) v += *(const f32x4*)(part + (size_t)sl * MS * DFF + 4 * q);
#pragma unroll
                for (int e = 0; e < 4; ++e) { const float a = fmaxf(v[e], 0.f); v[e] = a * a; }
                *(u32x2*)(H + (size_t)MP * DFF + 4 * q) = (u32x2){pk2(v[0], v[1]), pk2(v[2], v[3])}; }
        }
        pg8::Gemm g{(const bf16_t*)(ws + WS_H), (const bf16_t*)(ws + WS_WDNT), MPAD, DM, DFF};
        { pg8::Sched S; S.init(32, 8, G, blk, 0, 0, 0, 128); EpiRes E{nullptr, (const bf16_t*)(ws + WS_X1B), (bf16_t*)(ws + WS_R2)}; pg8::gemm_phase<EpiRes>(lds, g, S, E); }
        xcd_barrier(xbar);
        { pg8::Sched S; S.init_split(32, 8, 32, 4, G, blk, 0, 0, 0); EpiSPart E{(float*)(ws + WS_PART), DM}; pg8::gemm_phase<EpiSPart>(lds, g, S, E); }
    }
    SEAM(8);
    if (IN(9)) { unsigned char* ws = opq(p.ws);
        const int gw = blk * 8 + wid, NGW = G * 8;
        for (int m = gw; m < MT; m += NGW) {
            if (m < MP) ln_row_b((const bf16_t*)(ws + WS_R2) + (size_t)m * DM, p.ln2_g, p.ln2_b, p.out + (size_t)m * DM, nullptr, lane);
            else ln_row((const float*)(ws + WS_PART) + (size_t)(m - MP) * DM, p.ln2_g, p.ln2_b, p.out + (size_t)m * DM, nullptr, lane, 32, (size_t)MS * DM, (const float*)(ws + WS_X1) + (size_t)m * DM);
        }
    }
#undef IN
#undef SEAM
}

extern "C" void kernel_launch(void* const* d_in, const int* in_sizes, int n_in, void* d_out, int out_size, void* d_ws, size_t ws_size, hipStream_t stream) {
    static int grid = 0;
    if (grid == 0) {
        int dev = 0, cus = 0, per_cu = 0;
        if (n_in != 22 || ws_size < WS_END) { fprintf(stderr, "kernel_launch: unexpected inputs (n_in %d, ws %zu)\n", n_in, ws_size); grid = -1; return; }
        hipGetDevice(&dev);
        hipDeviceGetAttribute(&cus, hipDeviceAttributeMultiprocessorCount, dev);
        if (hipFuncSetAttribute((const void*)mega_fwd, hipFuncAttributeMaxDynamicSharedMemorySize, LDS_BYTES) != hipSuccess) { fprintf(stderr, "kernel_launch: hipFuncSetAttribute failed\n"); grid = -1; return; }
        if (hipOccupancyMaxActiveBlocksPerMultiprocessor(&per_cu, (const void*)mega_fwd, 512, LDS_BYTES) != hipSuccess || per_cu < 1) { fprintf(stderr, "kernel_launch: occupancy query says %d\n", per_cu); per_cu = 1; }
        (void)hipGetLastError();
        grid = cus;
    }
    if (grid < 0) return;
    Params p{};
    const float** pp = (const float**)&p;
    for (int i = 0; i < 22; ++i) pp[i] = (const float*)d_in[i];
    p.out = (float*)d_out; p.ws = (unsigned char*)d_ws; p.ph_lo = 0; p.ph_hi = 10; p.coop = 1; p.pad = 0;
    if (hipMemsetAsync(d_ws, 0, 16384, stream) != hipSuccess) { fprintf(stderr, "kernel_launch: memset failed\n"); return; }
    void* args[] = {&p};
    hipError_t e = hipLaunchCooperativeKernel((const void*)mega_fwd, dim3(grid), dim3(512), args, LDS_BYTES, stream);
    if (e != hipSuccess) fprintf(stderr, "cooperative launch failed: %s (grid %d)\n", hipGetErrorString(e), grid);
}
```

```cpp
#include <hip/hip_runtime.h>
#include <hip/hip_cooperative_groups.h>
#include <cstdio>
#include <cstdint>
namespace cg = cooperative_groups;

#define LAS __attribute__((address_space(3)))
typedef unsigned short bf16_t;
typedef short bf16x8 __attribute__((ext_vector_type(8)));
typedef short s16x4 __attribute__((ext_vector_type(4)));
typedef float f32x2 __attribute__((ext_vector_type(2)));
typedef float f32x4 __attribute__((ext_vector_type(4)));
typedef float f32x16 __attribute__((ext_vector_type(16)));
typedef unsigned u32x2 __attribute__((ext_vector_type(2)));
typedef unsigned u32x4 __attribute__((ext_vector_type(4)));

constexpr int DM = 2048, SEQ = 2048, NBP = 4, MP = 8192, MS = 128, MT = 8320, MPAD = 8448;
constexpr int N1 = 16640, DFF = 8192, DQKV = 6144;
constexpr float ALPHA = 1.189207115002721f, LN_EPS = 1e-5f, RMS_EPS = 1e-6f;
constexpr int LDS_BYTES = 160768;
constexpr size_t MiB = 1u << 20;
constexpr size_t WS_BG = 1 * MiB, WS_VSTAT = 3 * MiB, WS_GL = 6 * MiB;
constexpr size_t WS_WPT = 8 * MiB, WS_WOT = 24 * MiB, WS_U = 32 * MiB, WS_Z = 65 * MiB, WS_VA = 98 * MiB, WS_QKV = 131 * MiB;
constexpr size_t WS_GA = 230 * MiB, WS_GB = 263 * MiB, WS_W1T = 296 * MiB, WS_XB = 361 * MiB, WS_PS = 296 * MiB;
constexpr size_t WS_MTMP = 296 * MiB, WS_MB = 362 * MiB, WS_R1 = 395 * MiB, WS_H = 296 * MiB;
constexpr size_t WS_WUPT = 440 * MiB, WS_WDNT = 472 * MiB,
     WS_X1 = 131 * MiB, WS_X1B = 197 * MiB, WS_R2 = 230 * MiB;
constexpr size_t WS_PART = 98 * MiB;
constexpr size_t WS_END = 504 * MiB;
constexpr int PS_ITEM = 73728;
constexpr int PS_W = 0, PS_KCD = 16384, PS_QD = 32768, PS_KDT = 49152, PS_AT = 65536;
constexpr size_t O_YP = 0, O_YS = 16777216, O_CP = 17039360, O_SP = 17113088, O_GV = 18161664, O_CS = 18423808, O_SS = 20783104;

__device__ __forceinline__ unsigned pk2(float lo, float hi) { typedef __bf16 b2 __attribute__((ext_vector_type(2))); f32x2 v = {lo, hi}; b2 b = __builtin_convertvector(v, b2); return __builtin_bit_cast(unsigned, b); }
__device__ __forceinline__ float bf2f(unsigned short b) { return __uint_as_float((unsigned)b << 16); }
__device__ __forceinline__ float bflo(unsigned w) { return __uint_as_float(w << 16); }
__device__ __forceinline__ float bfhi(unsigned w) { return __uint_as_float(w & 0xffff0000u); }
__device__ __forceinline__ float sigmoidf_(float x) { return 1.0f / (1.0f + __expf(-x)); }
__device__ __forceinline__ float siluf_(float x) { return x / (1.0f + __expf(-x)); }
__device__ __forceinline__ float wave_sum(float v) {
#pragma unroll
    for (int o = 1; o < 64; o <<= 1) v += __shfl_xor(v, o);
    return v;
}
__device__ __forceinline__ void lds_barrier() { asm volatile("s_waitcnt lgkmcnt(0)\n\ts_barrier" ::: "memory"); }
__device__ __forceinline__ f32x2 gelu_pk(f32x2 v) {
    const f32x2 av = __builtin_elementwise_abs(v), d = av * 0.2316418882f + 1.0f;
    f32x2 t; t.x = __builtin_amdgcn_rcpf(d.x); t.y = __builtin_amdgcn_rcpf(d.y);
    f32x2 q = t * 0.5307027145f + (-0.7265760135f); q = q * t + 0.7107068705f; q = q * t + (-0.142248368f); q = q * t + 0.127414796f; q = q * t;
    const f32x2 s = (v * v) * (-0.72134752044f);
    f32x2 e; e.x = __builtin_amdgcn_exp2f(s.x); e.y = __builtin_amdgcn_exp2f(s.y);
    const f32x2 m = v * (q * e), r = v - m;
    f32x2 o; o.x = v.x < 0.f ? m.x : r.x; o.y = v.y < 0.f ? m.y : r.y; return o;
}
__device__ __forceinline__ f32x4 gelu4(f32x4 v) { f32x2 a = gelu_pk((f32x2){v[0], v[1]}), b = gelu_pk((f32x2){v[2], v[3]}); return (f32x4){a.x, a.y, b.x, b.y}; }

namespace pg8 {
constexpr int BM = 256, BK = 64, HALF = 128, HTB = HALF * BK * 2, STAGE_BYTES = 8 * HTB, NXCD = 8, WGM = 8;
__host__ __device__ __forceinline__ int lds_byte(int r, int c) { const int st = (r >> 4) * 2 + (c >> 5), rr = r & 15, cc = c & 31, ob = rr * 64 + cc * 2; return st * 1024 + (ob ^ (((ob >> 9) & 1) << 5)); }
__host__ __device__ __forceinline__ void stage_rc(int b, int& R, int& C) { const int st = b / 1024, sb = b % 1024, swz = sb ^ (((sb >> 9) & 1) << 5); R = (st >> 1) * 16 + swz / 64; C = (st & 1) * 32 + (swz % 64) / 2; }
__host__ __device__ __forceinline__ int perm32(int rho) { const int n = rho >> 4, i = rho & 15; return 8 * (i >> 2) + 4 * n + (i & 3); }
struct Unit { int pm, pn, k0, nt; };
struct Gemm { const bf16_t* A; const bf16_t* Bt; int M, N, K; };
struct Sched {
    int nM, nN, nwg, G, c, pairs, offM, offN, ntK;
    int split, sM, sNt, sSl, sNtK;
    __device__ void init(int nM_, int nN_, int G_, int c_, int pairs_, int offM_, int offN_, int ntK_) { nM = nM_; nN = nN_; nwg = nM * nN; G = G_; c = c_; pairs = pairs_; offM = offM_; offN = offN_; ntK = ntK_; split = 0; sM = 0; sNt = 0; sSl = 0; sNtK = 0; }
    __device__ void init_split(int sM_, int nN_, int slices, int ntk_slice, int G_, int c_, int pairs_, int offM_, int offN_) { init(1, nN_, G_, c_, pairs_, offM_, offN_, ntk_slice); split = 1; sM = sM_; sNt = nN_; sSl = slices; sNtK = ntk_slice; nwg = nN_ * slices * (pairs_ ? 2 : 1); }
    __device__ bool next(int i, Unit& u) const {
        if (split) {
            const int L = i * G + c; if (L >= nwg) return false;
            const int sl = L % sSl, r = L / sSl, pn = r % sNt, which = r / sNt;
            u.pm = sM + which * offM; u.pn = pn + which * offN; u.k0 = sl * sNtK; u.nt = sNtK; return true;
        }
        const int j = pairs ? (i >> 1) : i, which = pairs ? (i & 1) : 0;
        const long L = (long)j * G + c; if (L >= nwg) return false;
        int wgid = (int)L; { const int q = nwg / NXCD, r = nwg % NXCD, xcd = wgid % NXCD, off = wgid / NXCD; wgid = (xcd < r ? xcd * (q + 1) : r * (q + 1) + (xcd - r) * q) + off; }
        const int nig = WGM * nN, gid = wgid / nig, fm = gid * WGM, gsz = (nM - fm) < WGM ? (nM - fm) : WGM;
        u.pm = fm + ((wgid % nig) % gsz) + which * offM; u.pn = (wgid % nig) / gsz + which * offN; u.k0 = 0; u.nt = ntK; return true;
    }
};

template <class Epi>
__device__ __forceinline__ void gemm_phase(LAS unsigned char* lds, const Gemm g, const Sched& S, const Epi& E) {
    const int tid = threadIdx.x, wid = __builtin_amdgcn_readfirstlane(tid >> 6), lane = tid & 63, wr = wid >> 2, wc = wid & 3, fr = lane & 15, fq = lane >> 4;
    const int K = g.K;
    unsigned voffA[2], voffB[2];
#pragma unroll
    for (int i = 0; i < 2; ++i) { int R, C; stage_rc(tid * 16 + i * 8192, R, C); const int Rb = (R & ~31) + perm32(R & 31);
        voffA[i] = (unsigned)(R * K + C) * 2u; voffB[i] = (unsigned)(Rb * K + C) * 2u; }
    const size_t kstep = (size_t)(BK * 2);
    const size_t hstep = (size_t)HALF * K * 2;
    const size_t tstep = 2 * hstep;
    const unsigned ldsw = (unsigned)wid * 1024u;
    const int aoff = lds_byte(wr * 64 + fr, fq * 8), boff = lds_byte(wc * 32 + fr, fq * 8);
#define PG8_SA(b, h) (((b) * 2 + (h)) * HTB)
#define PG8_SB(b, h) ((4 + (b) * 2 + (h)) * HTB)
#define PG8_STAGE(bufoff, gbase, voff) do { _Pragma("unroll") for (int _i = 0; _i < 2; ++_i) \
        __builtin_amdgcn_global_load_lds((const unsigned*)((const char*)(gbase) + (voff)[_i]), (LAS unsigned*)(lds + (bufoff) + ldsw + _i * 8192), 16, 0, 0); } while (0)
#define PG8_LDA(dst, b, h) do { _Pragma("unroll") for (int m = 0; m < 4; ++m) _Pragma("unroll") for (int k = 0; k < 2; ++k) dst[m][k] = *(const LAS bf16x8*)(lds + PG8_SA(b, h) + aoff + m * 2048 + k * 1024); } while (0)
#define PG8_LDB(dst, b, h) do { _Pragma("unroll") for (int n = 0; n < 2; ++n) _Pragma("unroll") for (int k = 0; k < 2; ++k) dst[n][k] = *(const LAS bf16x8*)(lds + PG8_SB(b, h) + boff + n * 2048 + k * 1024); } while (0)
#define PG8_MMA(ai, bj, At, Bt) do { __builtin_amdgcn_s_setprio(1); _Pragma("unroll") for (int m = 0; m < 4; ++m) _Pragma("unroll") for (int n = 0; n < 2; ++n) _Pragma("unroll") for (int k = 0; k < 2; ++k) \
        acc[ai][bj][m][n] = __builtin_amdgcn_mfma_f32_16x16x32_bf16(Bt[n][k], At[m][k], acc[ai][bj][m][n], 0, 0, 0); __builtin_amdgcn_s_setprio(0); } while (0)
#define PG8_WAIT_V(n) asm volatile("s_waitcnt vmcnt(" #n ")" ::: "memory")
#define PG8_WAIT_L(n) asm volatile("s_waitcnt lgkmcnt(" #n ")" ::: "memory")
#define PG8_BAR __builtin_amdgcn_s_barrier()
#define PG8_SCHED __builtin_amdgcn_sched_barrier(0)
    Unit cur, nxt; int ui = 0;
    if (!S.next(0, cur)) return;
    f32x4 acc[2][2][4][2];
#pragma unroll
    for (int a = 0; a < 2; ++a)
#pragma unroll
        for (int b = 0; b < 2; ++b)
#pragma unroll
            for (int m = 0; m < 4; ++m)
#pragma unroll
                for (int n = 0; n < 2; ++n) acc[a][b][m][n] = (f32x4){0.f, 0.f, 0.f, 0.f};
    bf16x8 At[4][2], B0[2][2], B1[2][2];
    const char* cA = (const char*)g.A + (size_t)cur.pm * tstep + (size_t)cur.k0 * kstep; const char* cB = (const char*)g.Bt + (size_t)cur.pn * tstep + (size_t)cur.k0 * kstep;
    PG8_STAGE(PG8_SB(0, 0), cB, voffB); PG8_STAGE(PG8_SB(0, 1), cB + hstep, voffB); PG8_STAGE(PG8_SA(0, 0), cA, voffA); PG8_STAGE(PG8_SA(0, 1), cA + hstep, voffA);
    if (wr == 1) PG8_BAR;
    PG8_WAIT_V(2); PG8_BAR;
    PG8_STAGE(PG8_SB(1, 0), cB + kstep, voffB); PG8_STAGE(PG8_SA(1, 0), cA + kstep, voffA); PG8_STAGE(PG8_SB(1, 1), cB + hstep + kstep, voffB);
    PG8_WAIT_V(6); PG8_BAR;
    for (;;) {
        const bool has_next = S.next(ui + 1, nxt);
        const char* nA = has_next ? (const char*)g.A + (size_t)nxt.pm * tstep + (size_t)nxt.k0 * kstep : cA; const char* nB = has_next ? (const char*)g.Bt + (size_t)nxt.pn * tstep + (size_t)nxt.k0 * kstep : cB;
        const int nt = cur.nt;
        for (int t = 0; t < nt; t += 2) {
            const bool last = (t == nt - 2);
            const char* a1 = cA + (size_t)(t + 1) * kstep;
            const char* a2 = last ? nA : cA + (size_t)(t + 2) * kstep; const char* b2 = last ? nB : cB + (size_t)(t + 2) * kstep;
            const char* a3 = a2 + kstep; const char* b3 = b2 + kstep;
            PG8_LDB(B0, 0, 0); PG8_LDB(B1, 0, 1); PG8_SCHED; PG8_LDA(At, 0, 0); PG8_STAGE(PG8_SA(1, 1), a1 + hstep, voffA);
            PG8_WAIT_V(8); PG8_WAIT_L(0); PG8_BAR; PG8_MMA(0, 0, At, B0); PG8_MMA(0, 1, At, B1); PG8_BAR; PG8_SCHED;
            PG8_LDA(At, 0, 1); PG8_STAGE(PG8_SB(0, 0), b2, voffB); PG8_STAGE(PG8_SB(0, 1), b2 + hstep, voffB); PG8_STAGE(PG8_SA(0, 0), a2, voffA);
            PG8_WAIT_V(8); PG8_WAIT_L(0); PG8_BAR; PG8_MMA(1, 0, At, B0); PG8_MMA(1, 1, At, B1); PG8_BAR; PG8_SCHED;
            PG8_LDB(B0, 1, 0); PG8_LDB(B1, 1, 1); PG8_SCHED; PG8_LDA(At, 1, 0); PG8_STAGE(PG8_SA(0, 1), a2 + hstep, voffA);
            PG8_WAIT_V(8); PG8_WAIT_L(0); PG8_BAR; PG8_MMA(0, 0, At, B0); PG8_MMA(0, 1, At, B1); PG8_BAR; PG8_SCHED;
            PG8_LDA(At, 1, 1); PG8_STAGE(PG8_SB(1, 0), b3, voffB); PG8_STAGE(PG8_SB(1, 1), b3 + hstep, voffB); PG8_STAGE(PG8_SA(1, 0), a3, voffA);
            PG8_WAIT_V(8); PG8_WAIT_L(0); PG8_BAR; PG8_MMA(1, 0, At, B0); PG8_MMA(1, 1, At, B1); PG8_BAR; PG8_SCHED;
        }
        if (wr == 0) PG8_BAR;
        E(acc, cur, wr, wc, fr, fq);
        if (!has_next) break;
#pragma unroll
        for (int a = 0; a < 2; ++a)
#pragma unroll
            for (int b = 0; b < 2; ++b)
#pragma unroll
                for (int m = 0; m < 4; ++m)
#pragma unroll
                    for (int n = 0; n < 2; ++n) acc[a][b][m][n] = (f32x4){0.f, 0.f, 0.f, 0.f};
        cur = nxt; cA = nA; cB = nB; ++ui;
        if (wr == 1) PG8_BAR;
    }
    PG8_WAIT_V(0);
    PG8_BAR;
#undef PG8_SA
#undef PG8_SB
#undef PG8_STAGE
#undef PG8_LDA
#undef PG8_LDB
#undef PG8_MMA
#undef PG8_WAIT_V
#undef PG8_WAIT_L
#undef PG8_BAR
#undef PG8_SCHED
}
}
using pg8::Unit;
typedef f32x4 Acc[2][2][4][2];

struct Params {
    const float *x_prompt, *x_sample, *state_conv, *state_ssm, *w_in, *w_s, *b_s, *ln_v_g, *ln_v_b, *w_conv, *a_log, *dt_bias, *w_onorm,
                *w_proj_a, *w_proj_b, *w_o, *ln1_g, *ln1_b, *w_up, *w_down, *ln2_g, *ln2_b;
    float* out; unsigned char* ws; int ph_lo, ph_hi, coop, pad;
};

__device__ __forceinline__ void store8bf(bf16_t* p, f32x4 v0, f32x4 v1) { u32x4 w; w.x = pk2(v0[0], v0[1]); w.y = pk2(v0[2], v0[3]); w.z = pk2(v1[0], v1[1]); w.w = pk2(v1[2], v1[3]); *(u32x4*)p = w; }

struct Epi1 {
    unsigned char* ws; const float* a_log; const float* dt_bias;
    __device__ __forceinline__ void operator()(const Acc& acc, const Unit& u, int wr, int wc, int fr, int fq) const {
        const int pn = u.pn; const int row0 = u.pm * 256 + wr * 64 + fr; const int cl = wc * 32 + 8 * fq;
        if (pn < 64) {
            int act, ld, cb; size_t boff;
            if (pn < 8) { boff = WS_U; act = 1; ld = DM; cb = pn * 256; }
            else if (pn < 16) { boff = WS_VA; act = 1; ld = DM; cb = (pn - 8) * 256; }
            else if (pn < 40) { boff = WS_QKV; act = 0; ld = DQKV; cb = (pn - 16) * 256; }
            else if (pn < 48) { boff = WS_Z; act = 2; ld = DM; cb = (pn - 40) * 256; }
            else if (pn < 56) { boff = WS_GA; act = 3; ld = DM; cb = (pn - 48) * 256; }
            else { boff = WS_GB; act = 3; ld = DM; cb = (pn - 56) * 256; }
            const bool stats = (pn >= 8 && pn < 16);
            bf16_t* base = (bf16_t*)(ws + boff);
            float* vstat = (float*)(ws + WS_VSTAT) + ((pn - 8) * 4 + wc) * 2;
            const unsigned off0 = (unsigned)(row0 * ld + cb + cl);
#pragma unroll
            for (int ai = 0; ai < 2; ++ai)
#pragma unroll
                for (int m = 0; m < 4; ++m) {
                    const unsigned off = off0 + (unsigned)((ai * 128 + m * 16) * ld); float s = 0.f, s2 = 0.f;
#pragma unroll
                    for (int bj = 0; bj < 2; ++bj) { f32x4 v0 = acc[ai][bj][m][0], v1 = acc[ai][bj][m][1];
                        if (act == 1) { v0 = gelu4(v0); v1 = gelu4(v1); }
                        else if (act >= 2) {
#pragma unroll
                            for (int e = 0; e < 4; ++e) { const float t0 = sigmoidf_(v0[e]), t1 = sigmoidf_(v1[e]); v0[e] = act == 2 ? v0[e] * t0 : t0; v1[e] = act == 2 ? v1[e] * t1 : t1; } }
                        if (stats) {
#pragma unroll
                            for (int e = 0; e < 4; ++e) { s += v0[e] + v1[e]; s2 += v0[e] * v0[e] + v1[e] * v1[e]; } }
                        store8bf(base + off + bj * 128, v0, v1); }
                    if (stats) { s += __shfl_xor(s, 16); s += __shfl_xor(s, 32); s2 += __shfl_xor(s2, 16); s2 += __shfl_xor(s2, 32);
                        if (fq == 0) { float* sp = vstat + (unsigned)((row0 + ai * 128 + m * 16) * 64); sp[0] = s; sp[1] = s2; } }
                    __builtin_amdgcn_sched_barrier(0);
                }
        } else if (wc == 0) {
            float* bg = (float*)(ws + WS_BG);
            const unsigned boff0 = (unsigned)(row0 * 32 + 8 * fq);
            if (fq < 2) {
#pragma unroll
                for (int ai = 0; ai < 2; ++ai)
#pragma unroll
                    for (int m = 0; m < 4; ++m) {
#pragma unroll
                        for (int n = 0; n < 2; ++n) { const f32x4 v = acc[ai][0][m][n]; f32x4 o;
#pragma unroll
                            for (int e = 0; e < 4; ++e) o[e] = sigmoidf_(v[e]);
                            *(f32x4*)(bg + boff0 + (unsigned)((ai * 128 + m * 16) * 32 + 4 * n)) = o; }
                        __builtin_amdgcn_sched_barrier(0); }
            } else {
                const int h0 = 8 * (fq - 2);
#pragma unroll
                for (int n = 0; n < 2; ++n) {
                    f32x4 na = *(const f32x4*)(a_log + h0 + 4 * n); const f32x4 db = *(const f32x4*)(dt_bias + h0 + 4 * n);
#pragma unroll
                    for (int e = 0; e < 4; ++e) na[e] = -__expf(na[e]);
#pragma unroll
                    for (int ai = 0; ai < 2; ++ai)
#pragma unroll
                        for (int m = 0; m < 4; ++m) { const f32x4 v = acc[ai][0][m][n]; f32x4 o;
#pragma unroll
                            for (int e = 0; e < 4; ++e) { const float xx = v[e] + db[e]; const float sp = xx > 20.f ? xx : __logf(1.0f + __expf(xx)); o[e] = na[e] * sp; }
                            *(f32x4*)(bg + boff0 + (unsigned)((ai * 128 + m * 16) * 32 + 4 * n)) = o;
                            __builtin_amdgcn_sched_barrier(0); }
                }
            }
        }
    }
};
struct Epi4 {
    unsigned char* ws;
    __device__ __forceinline__ void operator()(const Acc& acc, const Unit& u, int wr, int wc, int fr, int fq) const {
        const int which = u.pm >= 33 ? 1 : 0; const int pm = u.pm - 33 * which, pn = u.pn - 8 * which;
        const bf16_t* gate = (const bf16_t*)(ws + (which ? WS_GB : WS_GA)); bf16_t* mt = (bf16_t*)(ws + WS_MTMP); bf16_t* mb = (bf16_t*)(ws + WS_MB);
        const int row0 = pm * 256 + wr * 64 + fr, col0 = pn * 256 + wc * 32 + 8 * fq;
#pragma unroll
        for (int ai = 0; ai < 2; ++ai)
#pragma unroll
            for (int m = 0; m < 4; ++m) { const size_t off = (size_t)(row0 + ai * 128 + m * 16) * DM + col0;
#pragma unroll
                for (int bj = 0; bj < 2; ++bj) { const u32x4 gw = *(const u32x4*)(gate + off + bj * 128);
                    f32x4 g0 = {bflo(gw.x), bfhi(gw.x), bflo(gw.y), bfhi(gw.y)}, g1 = {bflo(gw.z), bfhi(gw.z), bflo(gw.w), bfhi(gw.w)};
                    f32x4 v0 = acc[ai][bj][m][0] * g0, v1 = acc[ai][bj][m][1] * g1;
                    if (which == 0) store8bf(mt + off + bj * 128, v0, v1);
                    else { const u32x4 tw = *(const u32x4*)(mt + off + bj * 128); v0 += (f32x4){bflo(tw.x), bfhi(tw.x), bflo(tw.y), bfhi(tw.y)}; v1 += (f32x4){bflo(tw.z), bfhi(tw.z), bflo(tw.w), bfhi(tw.w)}; store8bf(mb + off + bj * 128, v0, v1); } } }
    }
};
struct EpiRes {
    __device__ __forceinline__ void done(const Unit&) const {}
    const float* resf; const bf16_t* resb; bf16_t* out;
    __device__ __forceinline__ void operator()(const Acc& acc, const Unit& u, int wr, int wc, int fr, int fq) const {
        const int row0 = u.pm * 256 + wr * 64 + fr, col0 = u.pn * 256 + wc * 32 + 8 * fq;
#pragma unroll
        for (int ai = 0; ai < 2; ++ai)
#pragma unroll
            for (int m = 0; m < 4; ++m) { const size_t off = (size_t)(row0 + ai * 128 + m * 16) * DM + col0;
#pragma unroll
                for (int bj = 0; bj < 2; ++bj) { f32x4 r0, r1;
                    if (resf) { r0 = *(const f32x4*)(resf + off + bj * 128); r1 = *(const f32x4*)(resf + off + bj * 128 + 4); }
                    else { const u32x4 w = *(const u32x4*)(resb + off + bj * 128); r0 = (f32x4){bflo(w.x), bfhi(w.x), bflo(w.y), bfhi(w.y)}; r1 = (f32x4){bflo(w.z), bfhi(w.z), bflo(w.w), bfhi(w.w)}; }
                    store8bf(out + off + bj * 128, r0 * ALPHA + acc[ai][bj][m][0], r1 * ALPHA + acc[ai][bj][m][1]); } }
    }
};
struct Epi7 {
    bf16_t* H;
    __device__ __forceinline__ void operator()(const Acc& acc, const Unit& u, int wr, int wc, int fr, int fq) const {
        const int row0 = u.pm * 256 + wr * 64 + fr, col0 = u.pn * 256 + wc * 32 + 8 * fq;
#pragma unroll
        for (int ai = 0; ai < 2; ++ai)
#pragma unroll
            for (int m = 0; m < 4; ++m) { const size_t off = (size_t)(row0 + ai * 128 + m * 16) * DFF + col0;
#pragma unroll
                for (int bj = 0; bj < 2; ++bj) { f32x4 v0 = acc[ai][bj][m][0], v1 = acc[ai][bj][m][1];
#pragma unroll
                    for (int e = 0; e < 4; ++e) { const float a = fmaxf(v0[e], 0.f), b = fmaxf(v1[e], 0.f); v0[e] = a * a; v1[e] = b * b; }
                    store8bf(H + off + bj * 128, v0, v1); } }
    }
};

struct EpiSPart {
    float* part; int ld;
    __device__ __forceinline__ void operator()(const Acc& acc, const Unit& u, int wr, int wc, int fr, int fq) const {
        const int r0 = wr * 64 + fr, col0 = u.pn * 256 + wc * 32 + 8 * fq; float* base = part + (size_t)(u.k0 / u.nt) * 128 * ld;
#pragma unroll
        for (int m = 0; m < 4; ++m) { float* op = base + (size_t)(r0 + m * 16) * ld + col0;
#pragma unroll
            for (int bj = 0; bj < 2; ++bj) { *(f32x4*)(op + bj * 128) = acc[0][bj][m][0]; *(f32x4*)(op + bj * 128 + 4) = acc[0][bj][m][1]; } }
    }
};
struct EpiS4 {
    unsigned char* ws;
    __device__ __forceinline__ void operator()(const Acc& acc, const Unit& u, int wr, int wc, int fr, int fq) const {
        const int which = u.pm >= 33 ? 1 : 0; const int pn = u.pn - 8 * which;
        const bf16_t* gate = (const bf16_t*)(ws + (which ? WS_GB : WS_GA)); float* base = (float*)(ws + WS_PART) + (size_t)(which * 16 + u.k0 / u.nt) * 128 * DM;
        const int r0 = wr * 64 + fr, col0 = pn * 256 + wc * 32 + 8 * fq;
#pragma unroll
        for (int m = 0; m < 4; ++m) { const int r = r0 + m * 16;
#pragma unroll
            for (int bj = 0; bj < 2; ++bj) { const u32x4 gw = *(const u32x4*)(gate + (size_t)(MP + r) * DM + col0 + bj * 128);
                const f32x4 g0 = {bflo(gw.x), bfhi(gw.x), bflo(gw.y), bfhi(gw.y)}, g1 = {bflo(gw.z), bfhi(gw.z), bflo(gw.w), bfhi(gw.w)};
                float* op = base + (size_t)r * DM + col0 + bj * 128; *(f32x4*)op = acc[0][bj][m][0] * g0; *(f32x4*)(op + 4) = acc[0][bj][m][1] * g1; } }
    }
};

__device__ __forceinline__ void transpose_item(const float* W, int K, int N, bf16_t* WT, int dst_row0, LAS float* scr, int kb, int nb, int lane) {
    const int k0 = 64 * kb, n0 = 32 * nb;
#pragma unroll 8
    for (int i = 0; i < 32; ++i) { const int kk = 2 * i + (lane >> 5); scr[kk * 33 + (lane & 31)] = W[(size_t)(k0 + kk) * N + n0 + (lane & 31)]; }
    asm volatile("s_waitcnt lgkmcnt(0)" ::: "memory");
    const int c = lane & 7;
#pragma unroll
    for (int j = 0; j < 4; ++j) { const int n = (lane >> 3) + 8 * j; const LAS float* s = scr + (8 * c) * 33 + n;
        u32x4 o; o.x = pk2(s[0 * 33], s[1 * 33]); o.y = pk2(s[2 * 33], s[3 * 33]); o.z = pk2(s[4 * 33], s[5 * 33]); o.w = pk2(s[6 * 33], s[7 * 33]);
        *(u32x4*)(WT + (size_t)(dst_row0 + n) * K + k0 + 8 * c) = o; }
    asm volatile("s_waitcnt lgkmcnt(0)" ::: "memory");
}
__device__ __forceinline__ void transpose_item_fast(const float* W, int K, int N, bf16_t* WT, int dst_row0, LAS float* scr, int kb, int nb, int lane) {
    const int k0 = 64 * kb, n0 = 32 * nb;
    float v[32];
    const float* src = W + (size_t)(k0 + (lane >> 5)) * N + n0 + (lane & 31);
#pragma unroll
    for (int i = 0; i < 32; ++i) v[i] = src[(size_t)(2 * i) * N];
#pragma unroll
    for (int i = 0; i < 32; ++i) scr[(2 * i + (lane >> 5)) * 33 + (lane & 31)] = v[i];
    asm volatile("s_waitcnt lgkmcnt(0)" ::: "memory");
    const int c = lane & 7;
#pragma unroll
    for (int j = 0; j < 4; ++j) { const int n = (lane >> 3) + 8 * j; const LAS float* s = scr + (8 * c) * 33 + n;
        u32x4 o; o.x = pk2(s[0 * 33], s[1 * 33]); o.y = pk2(s[2 * 33], s[3 * 33]); o.z = pk2(s[4 * 33], s[5 * 33]); o.w = pk2(s[6 * 33], s[7 * 33]);
        *(u32x4*)(WT + (size_t)(dst_row0 + n) * K + k0 + 8 * c) = o; }
    asm volatile("s_waitcnt lgkmcnt(0)" ::: "memory");
}
__device__ __forceinline__ void transpose64(const float* W, int N, bf16_t* WT, int K, int k0, int n0, int dst_row0, LAS float* scr, int lane) {
    f32x4 v[16];
    const float* src = W + (size_t)(k0 + (lane >> 4)) * N + n0 + (lane & 15) * 4;
#pragma unroll
    for (int t = 0; t < 16; ++t) v[t] = *(const f32x4*)(src + (size_t)(4 * t) * N);
#pragma unroll
    for (int t = 0; t < 16; ++t) { LAS float* d = scr + (4 * t + (lane >> 4)) * 65 + (lane & 15) * 4; d[0] = v[t][0]; d[1] = v[t][1]; d[2] = v[t][2]; d[3] = v[t][3]; }
    asm volatile("s_waitcnt lgkmcnt(0)" ::: "memory");
    const int c = lane & 7;
#pragma unroll
    for (int j = 0; j < 8; ++j) { const int n = (lane >> 3) + 8 * j; const LAS float* s = scr + (8 * c) * 65 + n;
        u32x4 o; o.x = pk2(s[0 * 65], s[1 * 65]); o.y = pk2(s[2 * 65], s[3 * 65]); o.z = pk2(s[4 * 65], s[5 * 65]); o.w = pk2(s[6 * 65], s[7 * 65]);
        *(u32x4*)(WT + (size_t)(dst_row0 + n) * K + k0 + 8 * c) = o; }
    asm volatile("s_waitcnt lgkmcnt(0)" ::: "memory");
}
__device__ __forceinline__ void ln_row(const float* src, const float* g, const float* b, float* dstf, bf16_t* dstb, int lane, int nparts = 0, size_t pstride = 0, const float* res = nullptr) {
    f32x4 v[8]; float s = 0.f;
    if (nparts == 0) {
#pragma unroll
        for (int j = 0; j < 8; ++j) v[j] = *(const f32x4*)(src + (lane + 64 * j) * 4);
    } else {
#pragma unroll
        for (int j = 0; j < 8; ++j) v[j] = *(const f32x4*)(res + (lane + 64 * j) * 4) * ALPHA;
        for (int sl = 0; sl < nparts; ++sl) {
#pragma unroll
            for (int j = 0; j < 8; ++j) v[j] += *(const f32x4*)(src + (size_t)sl * pstride + (lane + 64 * j) * 4);
        }
    }
#pragma unroll
    for (int j = 0; j < 8; ++j) s += (v[j][0] + v[j][1]) + (v[j][2] + v[j][3]);
    const float mean = wave_sum(s) * (1.f / DM); float s2 = 0.f;
#pragma unroll
    for (int j = 0; j < 8; ++j) { v[j] = v[j] - mean; s2 += (v[j][0] * v[j][0] + v[j][1] * v[j][1]) + (v[j][2] * v[j][2] + v[j][3] * v[j][3]); }
    const float rstd = 1.0f / sqrtf(wave_sum(s2) * (1.f / DM) + LN_EPS);
#pragma unroll
    for (int j = 0; j < 8; ++j) { const int c = (lane + 64 * j) * 4; const f32x4 gg = *(const f32x4*)(g + c), bb = *(const f32x4*)(b + c); const f32x4 y = v[j] * rstd * gg + bb;
        if (dstf) *(f32x4*)(dstf + c) = y;
        if (dstb) { u32x2 w; w.x = pk2(y[0], y[1]); w.y = pk2(y[2], y[3]); *(u32x2*)(dstb + c) = w; } }
}

__device__ __forceinline__ void ln_row_b(const bf16_t* src, const float* g, const float* b, float* dstf, bf16_t* dstb, int lane) {
    float v[4][8]; float s = 0.f;
#pragma unroll
    for (int j = 0; j < 4; ++j) { const u32x4 w = *(const u32x4*)(src + (lane + 64 * j) * 8);
        v[j][0] = bflo(w.x); v[j][1] = bfhi(w.x); v[j][2] = bflo(w.y); v[j][3] = bfhi(w.y); v[j][4] = bflo(w.z); v[j][5] = bfhi(w.z); v[j][6] = bflo(w.w); v[j][7] = bfhi(w.w);
#pragma unroll
        for (int e = 0; e < 8; ++e) s += v[j][e]; }
    const float mean = wave_sum(s) * (1.f / DM); float s2 = 0.f;
#pragma unroll
    for (int j = 0; j < 4; ++j)
#pragma unroll
        for (int e = 0; e < 8; ++e) { v[j][e] -= mean; s2 += v[j][e] * v[j][e]; }
    const float rstd = 1.0f / sqrtf(wave_sum(s2) * (1.f / DM) + LN_EPS);
#pragma unroll
    for (int j = 0; j < 4; ++j) { const int c = (lane + 64 * j) * 8; const f32x4 g0 = *(const f32x4*)(g + c), g1 = *(const f32x4*)(g + c + 4), b0 = *(const f32x4*)(b + c), b1 = *(const f32x4*)(b + c + 4);
        const f32x4 y0 = (f32x4){v[j][0], v[j][1], v[j][2], v[j][3]} * rstd * g0 + b0, y1 = (f32x4){v[j][4], v[j][5], v[j][6], v[j][7]} * rstd * g1 + b1;
        if (dstf) { *(f32x4*)(dstf + c) = y0; *(f32x4*)(dstf + c + 4) = y1; }
        if (dstb) store8bf(dstb + c, y0, y1); }
}

__device__ __forceinline__ void prescan_item(const Params& p, LAS unsigned char* lds, int it, int cvt_base) {
    const int tid = threadIdx.x, wid = tid >> 6, lane = tid & 63;
    const int bh = it >> 5, n = it & 31, b = bh >> 4, h = bh & 15, t0 = n * 64, mrow0 = b * SEQ + t0;
    LAS bf16_t* Kb = (LAS bf16_t*)(lds);
    LAS bf16_t* Qb = (LAS bf16_t*)(lds + 17408);
    LAS float* NfT = (LAS float*)(lds + 34816);
    LAS bf16_t* KdT = (LAS bf16_t*)(lds + 52224);
    LAS bf16_t* VbT = (LAS bf16_t*)(lds + 70656);
    LAS bf16_t* KbgT = (LAS bf16_t*)(lds + 89088);
    LAS bf16_t* Tb = (LAS bf16_t*)(lds + 107520);
    LAS float* sm_beta = (LAS float*)(lds + 116736);
    LAS float* sm_gc = sm_beta + 64;
    LAS float* Wc = (LAS float*)(lds + 117248);
    LAS float* OH = (LAS float*)(lds + 123392);
    unsigned char* ps = p.ws + WS_PS + (size_t)it * PS_ITEM;
    const float* bg = (const float*)(p.ws + WS_BG);
    const bf16_t* qkv = (const bf16_t*)(p.ws + WS_QKV);
    const int ri = tid >> 3, c0 = (tid & 7) * 16;
    u32x4 raw[3][4][2];
    {
        const unsigned char* qb = (const unsigned char*)qkv;
#pragma unroll
        for (int j = 0; j < 4; ++j) {
            const int tt = t0 + ri - 3 + j, ttc = tt < 0 ? 0 : tt;
            const unsigned off = (unsigned)(((b * SEQ + ttc) * DQKV + h * 128 + c0) * 2);
#pragma unroll
            for (int sec = 0; sec < 2; ++sec) {
                u32x4 a0 = *(const u32x4*)(qb + (size_t)(off + sec * 4096u)), a1 = *(const u32x4*)(qb + (size_t)(off + sec * 4096u + 16u));
                if (tt < 0) { a0 = (u32x4){0u, 0u, 0u, 0u}; a1 = (u32x4){0u, 0u, 0u, 0u}; }
                raw[sec][j][0] = a0; raw[sec][j][1] = a1;
            }
        }
    }
#pragma unroll
    for (int k = 0; k < 3; ++k) { const int idx = tid + 512 * k, j = idx / 384, rem = idx % 384; Wc[idx] = p.w_conv[(size_t)j * DQKV + (rem >> 7) * DM + h * 128 + (rem & 127)]; }
    if (tid >= 384) OH[tid - 384] = (tid == 384 + 64) ? 1.f : 0.f;
    if (wid == 0) {
        const float be = bg[(size_t)(mrow0 + lane) * 32 + h]; float g = bg[(size_t)(mrow0 + lane) * 32 + 16 + h];
#pragma unroll
        for (int o = 1; o < 64; o <<= 1) { const float t = __shfl_up(g, o); if (lane >= o) g += t; }
        sm_beta[lane] = be; sm_gc[lane] = g;
        if (lane == 63) ((float*)(p.ws + WS_GL))[it] = __expf(g);
    }
    lds_barrier();
    {
        const int i = ri;
        const int isw = i ^ ((tid & 7) << 3);
        const float gci = sm_gc[i], bei = sm_beta[i], gcl = sm_gc[63];
        const float eg = __expf(gci), ekd = __expf(gcl - gci);
#pragma unroll
        for (int sec = 0; sec < 3; ++sec) {
            float vals[16];
            asm volatile("" ::: "memory"); __builtin_amdgcn_sched_barrier(0);
            if (sec == 1) {
                const unsigned char* qb = (const unsigned char*)qkv;
#pragma unroll
                for (int j = 0; j < 4; ++j) { const int tt = t0 + ri - 3 + j, ttc = tt < 0 ? 0 : tt; const unsigned off = (unsigned)(((b * SEQ + ttc) * DQKV + h * 128 + c0) * 2) + 8192u;
                    u32x4 a0 = *(const u32x4*)(qb + (size_t)off), a1 = *(const u32x4*)(qb + (size_t)(off + 16u));
                    if (tt < 0) { a0 = (u32x4){0u, 0u, 0u, 0u}; a1 = (u32x4){0u, 0u, 0u, 0u}; }
                    raw[2][j][0] = a0; raw[2][j][1] = a1; }
                asm volatile("" ::: "memory"); __builtin_amdgcn_sched_barrier(0);
            }
#pragma unroll
            for (int e = 0; e < 16; ++e) vals[e] = 0.f;
#pragma unroll
            for (int j = 0; j < 4; ++j) {
                const LAS float* wp = Wc + (j * 3 + sec) * 128 + c0;
                const f32x4 w0 = *(const LAS f32x4*)wp, w1 = *(const LAS f32x4*)(wp + 4), w2 = *(const LAS f32x4*)(wp + 8), w3 = *(const LAS f32x4*)(wp + 12);
                const u32x4 r0 = raw[sec][j][0], r1 = raw[sec][j][1];
                vals[0] += bflo(r0.x) * w0[0]; vals[1] += bfhi(r0.x) * w0[1]; vals[2] += bflo(r0.y) * w0[2]; vals[3] += bfhi(r0.y) * w0[3];
                vals[4] += bflo(r0.z) * w1[0]; vals[5] += bfhi(r0.z) * w1[1]; vals[6] += bflo(r0.w) * w1[2]; vals[7] += bfhi(r0.w) * w1[3];
                vals[8] += bflo(r1.x) * w2[0]; vals[9] += bfhi(r1.x) * w2[1]; vals[10] += bflo(r1.y) * w2[2]; vals[11] += bfhi(r1.y) * w2[3];
                vals[12] += bflo(r1.z) * w3[0]; vals[13] += bfhi(r1.z) * w3[1]; vals[14] += bflo(r1.w) * w3[2]; vals[15] += bfhi(r1.w) * w3[3];
            }
#pragma unroll
            for (int e = 0; e < 16; ++e) vals[e] = siluf_(vals[e]);
            if (sec < 2) {
                float sq = 0.f;
#pragma unroll
                for (int e = 0; e < 16; ++e) sq += vals[e] * vals[e];
                sq += __shfl_xor(sq, 1); sq += __shfl_xor(sq, 2); sq += __shfl_xor(sq, 4);
                const float rn = (1.0f / sqrtf(sq + RMS_EPS)) * (sec == 0 ? 0.08838834764831845f : 1.0f);
#pragma unroll
                for (int e = 0; e < 16; ++e) vals[e] *= rn;
                unsigned w8[8];
#pragma unroll
                for (int e = 0; e < 8; ++e) w8[e] = pk2(vals[2 * e], vals[2 * e + 1]);
                LAS bf16_t* dst = (sec == 0 ? Qb : Kb) + i * 136 + c0;
                *(LAS u32x4*)dst = (u32x4){w8[0], w8[1], w8[2], w8[3]}; *(LAS u32x4*)(dst + 8) = (u32x4){w8[4], w8[5], w8[6], w8[7]};
                asm volatile("" ::: "memory"); __builtin_amdgcn_sched_barrier(0);
                if (sec == 0) {
#pragma unroll
                    for (int e = 0; e < 8; ++e) w8[e] = pk2(vals[2 * e] * eg, vals[2 * e + 1] * eg);
                    bf16_t* qdp = (bf16_t*)(ps + PS_QD) + i * 128 + c0;
                    *(u32x4*)qdp = (u32x4){w8[0], w8[1], w8[2], w8[3]}; *(u32x4*)(qdp + 8) = (u32x4){w8[4], w8[5], w8[6], w8[7]};
                } else {
#pragma unroll
                    for (int e = 0; e < 16; ++e) KdT[(c0 + e) * 72 + isw] = (bf16_t)(pk2(vals[e] * ekd, 0.f) & 0xffffu);
                    asm volatile("" ::: "memory"); __builtin_amdgcn_sched_barrier(0);
                    const float bk = bei * eg;
#pragma unroll
                    for (int e = 0; e < 16; ++e) KbgT[(c0 + e) * 72 + isw] = (bf16_t)(pk2(bk * vals[e], 0.f) & 0xffffu);
                }
            } else {
#pragma unroll
                for (int e = 0; e < 16; ++e) VbT[(c0 + e) * 72 + isw] = (bf16_t)(pk2(bei * vals[e], 0.f) & 0xffffu);
            }
        }
    }
    lds_barrier();
    {
        const int mat = wid >> 2, mi = wid & 3, fr = lane & 15, fq = lane >> 4;
        LAS bf16_t* Asrc = mat ? Qb : Kb;
        bf16x8 af[4];
#pragma unroll
        for (int s = 0; s < 4; ++s) af[s] = *(const LAS bf16x8*)(Asrc + (16 * mi + fr) * 136 + 32 * s + 8 * fq);
#pragma unroll
        for (int nj = 0; nj < 4; ++nj) {
            f32x4 acc = {0.f, 0.f, 0.f, 0.f};
            if (nj <= mi) {
#pragma unroll
                for (int s = 0; s < 4; ++s) { const bf16x8 bfr = *(const LAS bf16x8*)(Kb + (16 * nj + fr) * 136 + 32 * s + 8 * fq); acc = __builtin_amdgcn_mfma_f32_16x16x32_bf16(af[s], bfr, acc, 0, 0, 0); }
            }
            const int jj = 16 * nj + fr; const float gcj = sm_gc[jj];
            if (mat == 0) { f32x4 o;
#pragma unroll
                for (int j = 0; j < 4; ++j) { const int i = 16 * mi + 4 * fq + j; const float dec = __expf(fminf(sm_gc[i] - gcj, 0.f)); o[j] = (i > jj) ? sm_beta[i] * acc[j] * dec : 0.f; }
                *(LAS f32x4*)(NfT + jj * 68 + 16 * mi + 4 * fq) = o;
            } else {
#pragma unroll
                for (int j = 0; j < 4; ++j) { const int i = 16 * mi + 4 * fq + j; const float dec = __expf(fminf(sm_gc[i] - gcj, 0.f));
                    ((bf16_t*)(ps + PS_AT))[i * 64 + jj] = (bf16_t)(pk2((i >= jj) ? acc[j] * dec : 0.f, 0.f) & 0xffffu); }
            }
        }
    }
    lds_barrier();
    if (tid < 128) {
        const int c = tid >> 1, half = tid & 1; f32x2 r2[16];
        const LAS float* ohp = OH + 64 - c + 4 * half;
#pragma unroll
        for (int li = 0; li < 8; ++li) { r2[2 * li] = (f32x2){ohp[8 * li], ohp[8 * li + 1]}; r2[2 * li + 1] = (f32x2){ohp[8 * li + 2], ohp[8 * li + 3]}; }
        const LAS float* nb = NfT + half * 4;
#pragma unroll
        for (int j = 0; j < 63; ++j) {
            const int jc = j >> 2, lj = jc >> 1, ej = j & 3;
            const float xm = (ej & 2) ? ((ej & 1) ? r2[2 * lj + 1].y : r2[2 * lj + 1].x) : ((ej & 1) ? r2[2 * lj].y : r2[2 * lj].x);
            const float xo = __shfl_xor(xm, 1);
            const float xj = ((jc & 1) == half) ? xm : xo;
            const f32x2 xj2 = {xj, xj};
#pragma unroll
            for (int li = lj; li < 8; ++li) {
                f32x4 nv = *(const LAS f32x4*)(nb + j * 68 + 8 * li);
                if (li == lj) {
                    const int rowb = 4 * (2 * li + half);
#pragma unroll
                    for (int e = 0; e < 4; ++e) nv[e] = (rowb + e > j) ? nv[e] : 0.f;
                }
                r2[2 * li] = r2[2 * li] - (f32x2){nv[0], nv[1]} * xj2; r2[2 * li + 1] = r2[2 * li + 1] - (f32x2){nv[2], nv[3]} * xj2;
            }
            asm volatile("" ::: "memory"); __builtin_amdgcn_sched_barrier(0);
        }
#pragma unroll
        for (int li = 0; li < 8; ++li) { const int rb = 4 * (2 * li + half);
            Tb[(rb) * 72 + c] = (bf16_t)(pk2(r2[2 * li].x, 0.f) & 0xffffu); Tb[(rb + 1) * 72 + c] = (bf16_t)(pk2(r2[2 * li].y, 0.f) & 0xffffu);
            Tb[(rb + 2) * 72 + c] = (bf16_t)(pk2(r2[2 * li + 1].x, 0.f) & 0xffffu); Tb[(rb + 3) * 72 + c] = (bf16_t)(pk2(r2[2 * li + 1].y, 0.f) & 0xffffu); }
    } else if (tid >= 256) {
        const int t2 = tid - 256; bf16_t* kd = (bf16_t*)(ps + PS_KDT);
#pragma unroll
        for (int k = 0; k < 4; ++k) { const int q = t2 + 256 * k, row = q >> 3, cc = q & 7; *(u32x4*)(kd + row * 64 + cc * 8) = *(const LAS u32x4*)(KdT + row * 72 + (cc ^ ((row >> 4) & 7)) * 8); }
        if (cvt_base >= 0) {
            LAS float* scr = (LAS float*)(lds + 124928 + (wid - 4) * 8448);
#pragma unroll 1
            for (int r = 0; r < 2; ++r) { const int t = cvt_base + (wid - 4) * 2 + r;
                if (t < 8192) transpose_item_fast(p.w_up, DM, DFF, (bf16_t*)(p.ws + WS_WUPT), 32 * (t & 255), scr, t >> 8, t & 255, lane);
                else { const int u = t - 8192; transpose_item_fast(p.w_down, DFF, DM, (bf16_t*)(p.ws + WS_WDNT), 32 * (u & 63), scr, u >> 6, u & 63, lane); } }
        }
    }
    lds_barrier();
    {
        const int fr = lane & 15, fq = lane >> 4;
        float* wout = (float*)(ps + PS_W); bf16_t* kout = (bf16_t*)(ps + PS_KCD);
        bf16x8 tf[4][2];
#pragma unroll
        for (int mi = 0; mi < 4; ++mi)
#pragma unroll
            for (int s = 0; s < 2; ++s) tf[mi][s] = *(const LAS bf16x8*)(Tb + (16 * mi + fr) * 72 + 32 * s + 8 * fq);
#pragma unroll
        for (int t = 0; t < 2; ++t) {
            const int ni = wid * 2 + t;
            const bf16x8 b0 = *(const LAS bf16x8*)(VbT + (16 * ni + fr) * 72 + 8 * (fq ^ (ni & 7))), b1 = *(const LAS bf16x8*)(VbT + (16 * ni + fr) * 72 + 8 * ((4 + fq) ^ (ni & 7)));
#pragma unroll
            for (int mi = 0; mi < 4; ++mi) {
                f32x4 acc = {0.f, 0.f, 0.f, 0.f};
                acc = __builtin_amdgcn_mfma_f32_16x16x32_bf16(tf[mi][0], b0, acc, 0, 0, 0);
                acc = __builtin_amdgcn_mfma_f32_16x16x32_bf16(tf[mi][1], b1, acc, 0, 0, 0);
                if (ni < 8) {
                    const int e = 16 * ni + fr; const unsigned wb = (unsigned)((e >> 5) * 1024 + (fq >> 1) * 128 + (fq & 1) * 32 + (e & 31));
                    unsigned* w32 = (unsigned*)wout + wb + (unsigned)((mi >> 1) * 512 + (mi & 1) * 256);
                    w32[0] = pk2(acc[0], acc[1]); w32[64] = pk2(acc[2], acc[3]);
                } else {
                    const unsigned kb_ = (unsigned)(4 * fq * 128 + 16 * (ni - 8) + fr);
#pragma unroll
                    for (int j = 0; j < 4; ++j) kout[kb_ + (unsigned)((16 * mi + j) * 128)] = (bf16_t)(pk2(-acc[j], 0.f) & 0xffffu);
                }
                asm volatile("" ::: "memory"); __builtin_amdgcn_sched_barrier(0);
            }
        }
    }
    lds_barrier();
}

__device__ __forceinline__ bf16x8 packs(const f32x16& x, int s) {
    u32x4 w; w.x = pk2(x[8 * s], x[8 * s + 1]); w.y = pk2(x[8 * s + 2], x[8 * s + 3]); w.z = pk2(x[8 * s + 4], x[8 * s + 5]); w.w = pk2(x[8 * s + 6], x[8 * s + 7]); return __builtin_bit_cast(bf16x8, w);
}
__device__ __forceinline__ bf16x8 ldA2(const LAS bf16_t* p) { const u32x2 a = *(const LAS u32x2*)p, b = *(const LAS u32x2*)(p + 8); u32x4 w = {a.x, a.y, b.x, b.y}; return __builtin_bit_cast(bf16x8, w); }
#define MFMA32(a, b, c) __builtin_amdgcn_mfma_f32_32x32x16_bf16((a), (b), (c), 0, 0, 0)
__device__ __forceinline__ int crow(int reg, int hh) { return (reg & 3) + 8 * (reg >> 2) + 4 * hh; }

__device__ __forceinline__ void scan_stage(const unsigned char* src, LAS unsigned char* bb, int t2) {
    constexpr int O_KCD = 0, O_QD = 16896, O_KDT = 33792, O_AT = 51200;
#pragma unroll
    for (int half = 0; half < 2; ++half) {
        u32x4 stg[7];
#pragma unroll
        for (int k = 0; k < 7; ++k) stg[k] = *(const u32x4*)(src + (size_t)(t2 + 256 * (7 * half + k)) * 16);
#pragma unroll
        for (int k = 0; k < 7; ++k) { const int kk = 7 * half + k, q = t2 + 256 * kk; LAS unsigned char* d_;
            if (kk < 4) d_ = bb + O_KCD + (q >> 4) * 264 + (q & 15) * 16; else if (kk < 8) d_ = bb + O_QD + ((q - 1024) >> 4) * 264 + (q & 15) * 16;
            else if (kk < 12) d_ = bb + O_KDT + ((q - 2048) >> 3) * 136 + (q & 7) * 16; else d_ = bb + O_AT + ((q - 3072) >> 3) * 136 + (q & 7) * 16;
            *(LAS u32x2*)d_ = (u32x2){stg[k].x, stg[k].y}; *(LAS u32x2*)(d_ + 8) = (u32x2){stg[k].z, stg[k].w}; }
    }
}
__device__ __forceinline__ void scan_onorm(const Params& p, const LAS bf16_t* Ob, bf16_t* zrow0, int h, int t2) {
    const int oi = t2 >> 2, oq = t2 & 3; u32x4 ov[4];
#pragma unroll
    for (int k = 0; k < 4; ++k) ov[k] = *(const LAS u32x4*)(Ob + oi * 136 + oq * 32 + 8 * k);
    float ov_f[32];
#pragma unroll
    for (int k = 0; k < 4; ++k) { ov_f[8 * k] = bflo(ov[k].x); ov_f[8 * k + 1] = bfhi(ov[k].x); ov_f[8 * k + 2] = bflo(ov[k].y); ov_f[8 * k + 3] = bfhi(ov[k].y);
        ov_f[8 * k + 4] = bflo(ov[k].z); ov_f[8 * k + 5] = bfhi(ov[k].z); ov_f[8 * k + 6] = bflo(ov[k].w); ov_f[8 * k + 7] = bfhi(ov[k].w); }
    float ss = 0.f;
#pragma unroll
    for (int e = 0; e < 32; ++e) ss += ov_f[e] * ov_f[e];
    ss += __shfl_xor(ss, 1); ss += __shfl_xor(ss, 2);
    const float rstd = 1.0f / sqrtf(ss * (1.f / 128.f) + RMS_EPS);
    bf16_t* zp = zrow0 + (size_t)oi * DM + h * 128 + oq * 32; const float* wn = p.w_onorm + oq * 32;
#pragma unroll
    for (int k = 0; k < 4; ++k) { const u32x4 zw = *(const u32x4*)(zp + 8 * k); const f32x4 w0 = *(const f32x4*)(wn + 8 * k), w1 = *(const f32x4*)(wn + 8 * k + 4);
        u32x4 o; o.x = pk2(ov_f[8 * k] * rstd * w0[0] * bflo(zw.x), ov_f[8 * k + 1] * rstd * w0[1] * bfhi(zw.x));
        o.y = pk2(ov_f[8 * k + 2] * rstd * w0[2] * bflo(zw.y), ov_f[8 * k + 3] * rstd * w0[3] * bfhi(zw.y));
        o.z = pk2(ov_f[8 * k + 4] * rstd * w1[0] * bflo(zw.z), ov_f[8 * k + 5] * rstd * w1[1] * bfhi(zw.z));
        o.w = pk2(ov_f[8 * k + 6] * rstd * w1[2] * bflo(zw.w), ov_f[8 * k + 7] * rstd * w1[3] * bfhi(zw.w));
        *(u32x4*)(zp + 8 * k) = o; }
}
__device__ __forceinline__ void scan_bh(const Params& p, LAS unsigned char* lds, int bh) {
    const int tid = threadIdx.x, wid = __builtin_amdgcn_readfirstlane(tid >> 6), lane = tid & 63, r = lane & 31, hh = lane >> 5;
    const int b = bh >> 4, h = bh & 15;
    constexpr int BUFB = 59904, O_KCD = 0, O_QD = 16896, O_KDT = 33792, O_AT = 51200, OBUFB = 17408;
    LAS unsigned char* Obase = lds + 2 * BUFB;
    const unsigned char* psb = p.ws + WS_PS + (size_t)(bh * 32) * PS_ITEM;
    const float* gl = (const float*)(p.ws + WS_GL) + bh * 32;
    bf16_t* Zb = (bf16_t*)(p.ws + WS_Z) + (size_t)(b * SEQ) * DM;
    if (wid >= 4) scan_stage(psb + PS_KCD, lds, tid - 256);
    lds_barrier();
    if (wid < 4) {
        f32x16 S[4], Vn[2], O[2];
#pragma unroll
        for (int d = 0; d < 4; ++d)
#pragma unroll
            for (int i = 0; i < 16; ++i) S[d][i] = 0.f;
        const int e0 = 32 * wid + r;
        { const unsigned* wsrc = (const unsigned*)(psb + PS_W) + wid * 1024 + lane;
#pragma unroll
            for (int mi = 0; mi < 2; ++mi)
#pragma unroll
                for (int k = 0; k < 8; ++k) { const unsigned u = wsrc[(mi * 8 + k) * 64]; Vn[mi][2 * k] = bflo(u); Vn[mi][2 * k + 1] = bfhi(u); } }
        const float glv = gl[lane & 31];
        for (int n = 0; n < 32; ++n) {
            LAS unsigned char* bb = lds + (n & 1) * BUFB;
            unsigned Wp[16];
            if (n + 1 < 32) { const unsigned* wsrc = (const unsigned*)(psb + (size_t)(n + 1) * PS_ITEM + PS_W) + wid * 1024 + lane;
#pragma unroll
                for (int k = 0; k < 16; ++k) Wp[k] = wsrc[k * 64]; }
            const LAS bf16_t* kcd = (const LAS bf16_t*)(bb + O_KCD); const LAS bf16_t* qdl = (const LAS bf16_t*)(bb + O_QD);
            const LAS bf16_t* kdt = (const LAS bf16_t*)(bb + O_KDT); const LAS bf16_t* att = (const LAS bf16_t*)(bb + O_AT);
            LAS bf16_t* Obuf = (LAS bf16_t*)(Obase + (n & 1) * OBUFB);
#pragma unroll
            for (int mi = 0; mi < 2; ++mi)
#pragma unroll
                for (int i = 0; i < 16; ++i) O[mi][i] = 0.f;
#pragma unroll
            for (int s = 0; s < 8; ++s) {
                bf16x8 ac[4];
#pragma unroll
                for (int mi = 0; mi < 2; ++mi) { ac[mi] = ldA2(kcd + (32 * mi + r) * 132 + 16 * s + 4 * hh); ac[2 + mi] = ldA2(qdl + (32 * mi + r) * 132 + 16 * s + 4 * hh); }
                const bf16x8 sf = packs(S[s >> 1], s & 1);
#pragma unroll
                for (int mi = 0; mi < 2; ++mi) { Vn[mi] = MFMA32(ac[mi], sf, Vn[mi]); O[mi] = MFMA32(ac[2 + mi], sf, O[mi]); }
                __builtin_amdgcn_sched_barrier(0);
            }
            bf16x8 vf[4];
#pragma unroll
            for (int s = 0; s < 4; ++s) vf[s] = packs(Vn[s >> 1], s & 1);
            if (n + 1 < 32) {
#pragma unroll
                for (int mi = 0; mi < 2; ++mi)
#pragma unroll
                    for (int k = 0; k < 8; ++k) { Vn[mi][2 * k] = bflo(Wp[mi * 8 + k]); Vn[mi][2 * k + 1] = bfhi(Wp[mi * 8 + k]); } }
#pragma unroll
            for (int s = 0; s < 2; ++s) O[0] = MFMA32(ldA2(att + (r) * 68 + 16 * s + 4 * hh), vf[s], O[0]);
#pragma unroll
            for (int s = 0; s < 4; ++s) O[1] = MFMA32(ldA2(att + (32 + r) * 68 + 16 * s + 4 * hh), vf[s], O[1]);
            const float g_l = __builtin_bit_cast(float, __builtin_amdgcn_readlane(__builtin_bit_cast(int, glv), n));
#pragma unroll
            for (int d = 0; d < 4; ++d) { S[d] = S[d] * g_l;
#pragma unroll
                for (int s = 0; s < 4; ++s) S[d] = MFMA32(ldA2(kdt + (32 * d + r) * 68 + 16 * s + 4 * hh), vf[s], S[d]); }
#pragma unroll
            for (int mi = 0; mi < 2; ++mi)
#pragma unroll
                for (int i = 0; i < 16; ++i) Obuf[(32 * mi + crow(i, hh)) * 136 + e0] = (bf16_t)(pk2(O[mi][i], 0.f) & 0xffffu);
            lds_barrier();
        }
        float* so = p.out + O_SP + (size_t)bh * 16384;
#pragma unroll
        for (int d = 0; d < 4; ++d)
#pragma unroll
            for (int i = 0; i < 16; ++i) so[(32 * d + crow(i, hh)) * 128 + e0] = S[d][i];
    } else {
        const int t2 = tid - 256, oi = t2 >> 2, oq = t2 & 3;
        u32x4 stg[8], stgb[6], zr[4];
#define SCAN_LD_A(item) do { const unsigned char* s_ = psb + (size_t)(item) * PS_ITEM + PS_KCD; _Pragma("unroll") for (int k = 0; k < 8; ++k) stg[k] = *(const u32x4*)(s_ + (size_t)(t2 + 256 * k) * 16); } while (0)
#define SCAN_LD_B(item) do { const unsigned char* s_ = psb + (size_t)(item) * PS_ITEM + PS_KCD; _Pragma("unroll") for (int k = 0; k < 6; ++k) stgb[k] = *(const u32x4*)(s_ + (size_t)(t2 + 256 * (8 + k)) * 16); } while (0)
#define SCAN_ST_A(bufi) do { LAS unsigned char* bb_ = lds + (bufi) * BUFB; _Pragma("unroll") for (int k = 0; k < 8; ++k) { const int q = t2 + 256 * k; LAS unsigned char* d_; \
            if (k < 4) d_ = bb_ + O_KCD + (q >> 4) * 264 + (q & 15) * 16; else d_ = bb_ + O_QD + ((q - 1024) >> 4) * 264 + (q & 15) * 16; \
            *(LAS u32x2*)d_ = (u32x2){stg[k].x, stg[k].y}; *(LAS u32x2*)(d_ + 8) = (u32x2){stg[k].z, stg[k].w}; } } while (0)
#define SCAN_ST_B(bufi) do { LAS unsigned char* bb_ = lds + (bufi) * BUFB; _Pragma("unroll") for (int k = 0; k < 6; ++k) { const int q = t2 + 256 * (8 + k); LAS unsigned char* d_; \
            if (k < 4) d_ = bb_ + O_KDT + ((q - 2048) >> 3) * 136 + (q & 7) * 16; else d_ = bb_ + O_AT + ((q - 3072) >> 3) * 136 + (q & 7) * 16; \
            *(LAS u32x2*)d_ = (u32x2){stgb[k].x, stgb[k].y}; *(LAS u32x2*)(d_ + 8) = (u32x2){stgb[k].z, stgb[k].w}; } } while (0)
#define SCAN_ZLD(chunk) do { const bf16_t* zp_ = Zb + (size_t)((chunk) * 64 + oi) * DM + h * 128 + oq * 32; _Pragma("unroll") for (int k = 0; k < 4; ++k) zr[k] = *(const u32x4*)(zp_ + 8 * k); } while (0)
#define SCAN_NORM(obuf, chunk) do { const LAS bf16_t* Ob_ = (const LAS bf16_t*)(obuf); u32x4 ov[4]; SCAN_ZLD(chunk); \
            _Pragma("unroll") for (int k = 0; k < 4; ++k) ov[k] = *(const LAS u32x4*)(Ob_ + oi * 136 + oq * 32 + 8 * k); \
            float ss = 0.f; \
            _Pragma("unroll") for (int k = 0; k < 4; ++k) { const float a0 = bflo(ov[k].x), a1 = bfhi(ov[k].x), a2 = bflo(ov[k].y), a3 = bfhi(ov[k].y), a4 = bflo(ov[k].z), a5 = bfhi(ov[k].z), a6 = bflo(ov[k].w), a7 = bfhi(ov[k].w); \
                ss += (a0 * a0 + a1 * a1) + (a2 * a2 + a3 * a3) + (a4 * a4 + a5 * a5) + (a6 * a6 + a7 * a7); } \
            ss += __shfl_xor(ss, 1); ss += __shfl_xor(ss, 2); \
            const float rstd = 1.0f / sqrtf(ss * (1.f / 128.f) + RMS_EPS); \
            bf16_t* zp_ = Zb + (size_t)((chunk) * 64 + oi) * DM + h * 128 + oq * 32; const float* wn = p.w_onorm + oq * 32; \
            _Pragma("unroll") for (int k = 0; k < 4; ++k) { const u32x4 zw = zr[k]; const f32x4 w0 = *(const f32x4*)(wn + 8 * k) * rstd, w1 = *(const f32x4*)(wn + 8 * k + 4) * rstd; \
                u32x4 o; o.x = pk2(bflo(ov[k].x) * w0[0] * bflo(zw.x), bfhi(ov[k].x) * w0[1] * bfhi(zw.x)); \
                o.y = pk2(bflo(ov[k].y) * w0[2] * bflo(zw.y), bfhi(ov[k].y) * w0[3] * bfhi(zw.y)); \
                o.z = pk2(bflo(ov[k].z) * w1[0] * bflo(zw.z), bfhi(ov[k].z) * w1[1] * bfhi(zw.z)); \
                o.w = pk2(bflo(ov[k].w) * w1[2] * bflo(zw.w), bfhi(ov[k].w) * w1[3] * bfhi(zw.w)); \
                *(u32x4*)(zp_ + 8 * k) = o; asm volatile("" ::: "memory"); } } while (0)
        SCAN_LD_A(1); SCAN_LD_B(1);
        for (int n = 0; n < 32; ++n) {
            if (n + 1 < 32) { SCAN_ST_A((n + 1) & 1); SCAN_ST_B((n + 1) & 1); }
            if (n + 2 < 32) { SCAN_LD_A(n + 2); SCAN_LD_B(n + 2); }
            if (n >= 1) SCAN_NORM(Obase + ((n - 1) & 1) * OBUFB, n - 1);
            lds_barrier();
        }
        SCAN_NORM(Obase + OBUFB, 31);
#undef SCAN_LD_A
#undef SCAN_LD_B
#undef SCAN_ST_A
#undef SCAN_ST_B
#undef SCAN_ZLD
#undef SCAN_NORM
    }
    lds_barrier();
}

__device__ __forceinline__ void sample_prefetch(const Params& p, int it, f32x4 (&Sn)[8]) {
    const int tid = threadIdx.x; const float* S0 = p.state_ssm + (size_t)it * 16384 + (tid >> 5) * 1024 + (tid & 31) * 4;
#pragma unroll
    for (int i = 0; i < 8; ++i) Sn[i] = *(const f32x4*)(S0 + i * 128);
}
__device__ __forceinline__ void sample_item(const Params& p, LAS unsigned char* lds, int it, const f32x4 (&Sr)[8]) {
    const int tid = threadIdx.x, wid = tid >> 6, lane = tid & 63;
    const int b = it >> 4, h = it & 15, m = MP + b;
    const int e4 = (tid & 31) * 4, dg = tid >> 5;
    LAS float* vq = (LAS float*)lds;
    LAS float* red = vq + 384;
    LAS float* vnew = vq + 400;
    LAS float* part = vq + 1024;
    const bf16_t* qkv = (const bf16_t*)(p.ws + WS_QKV); const float* bg = (const float*)(p.ws + WS_BG); bf16_t* Zb = (bf16_t*)(p.ws + WS_Z);
    if (tid < 384) { const int sec = tid >> 7, c = tid & 127, col = sec * DM + h * 128 + c;
        float a = bf2f(qkv[(size_t)m * DQKV + col]) * p.w_conv[3 * DQKV + col];
#pragma unroll
        for (int j = 0; j < 3; ++j) a += p.state_conv[(size_t)(b * 3 + j) * DQKV + col] * p.w_conv[j * DQKV + col];
        vq[sec * 128 + c] = siluf_(a); }
    lds_barrier();
    if (wid < 2) { const float a = vq[wid * 128 + lane], c2 = vq[wid * 128 + 64 + lane]; const float s = wave_sum(a * a + c2 * c2); if (lane == 0) red[wid] = s; }
    lds_barrier();
    if (tid < 256) { const int sec = tid >> 7; const float rs = 1.0f / sqrtf(red[sec] + RMS_EPS) * (sec == 0 ? 0.08838834764831845f : 1.0f); vq[tid] *= rs; }
    lds_barrier();
    if (wid == 0) { const float s = wave_sum(vq[lane] * vq[128 + lane] + vq[64 + lane] * vq[192 + lane]); if (lane == 0) red[2] = s; }
    {
        f32x4 ks = {0.f, 0.f, 0.f, 0.f}, qs = {0.f, 0.f, 0.f, 0.f};
#pragma unroll
        for (int i = 0; i < 8; ++i) { const float kk = vq[128 + dg * 8 + i], qq = vq[dg * 8 + i]; ks += Sr[i] * kk; qs += Sr[i] * qq; }
        *(LAS f32x4*)(part + dg * 128 + e4) = ks; *(LAS f32x4*)(part + 2048 + dg * 128 + e4) = qs;
    }
    lds_barrier();
    const float beta = bg[(size_t)m * 32 + h], eg = __expf(bg[(size_t)m * 32 + 16 + h]);
    float o = 0.f;
    if (tid < 128) { float kS = 0.f, qS = 0.f;
#pragma unroll
        for (int d = 0; d < 16; ++d) { kS += part[d * 128 + tid]; qS += part[2048 + d * 128 + tid]; }
        const float vn = beta * (vq[256 + tid] - eg * kS); o = eg * qS + red[2] * vn; vnew[tid] = vn;
        const float s = wave_sum(o * o); if (lane == 0) red[4 + wid] = s; }
    lds_barrier();
    if (tid < 128) { const float rstd = 1.0f / sqrtf((red[4] + red[5]) * (1.f / 128.f) + RMS_EPS); bf16_t* zp = Zb + (size_t)m * DM + h * 128 + tid;
        *zp = (bf16_t)(pk2(o * rstd * p.w_onorm[tid] * bf2f(*zp), 0.f) & 0xffffu); }
    {
        float* So = p.out + O_SS + (size_t)it * 16384; const f32x4 vn4 = *(const LAS f32x4*)(vnew + e4);
#pragma unroll
        for (int i = 0; i < 8; ++i) { const float kk = vq[128 + dg * 8 + i]; *(f32x4*)(So + (dg * 8 + i) * 128 + e4) = Sr[i] * eg + vn4 * kk; }
    }
    lds_barrier();
}

__device__ __forceinline__ void mixerA_item(const Params& p, LAS unsigned char* lds, int it) {
    const int tid = threadIdx.x, wid = tid >> 6, lane = tid & 63, fr = lane & 15, fq = lane >> 4;
    const int b = it >> 8, c = (it >> 4) & 15, g = it & 15, m0 = b * SEQ + c * 128;
    LAS bf16_t* Wt = (LAS bf16_t*)lds;
    LAS bf16_t* VnT = (LAS bf16_t*)(lds + 34816);
    LAS float* st = (LAS float*)(lds + 68608);
    const float* vstat = (const float*)(p.ws + WS_VSTAT); const bf16_t* VA = (const bf16_t*)(p.ws + WS_VA); bf16_t* U = (bf16_t*)(p.ws + WS_U);
    if (tid < 128) { const float* sp = vstat + (size_t)(m0 + tid) * 64; float s = 0.f, s2 = 0.f;
#pragma unroll
        for (int k = 0; k < 16; ++k) { const f32x4 v = *(const f32x4*)(sp + 4 * k); s += v[0] + v[2]; s2 += v[1] + v[3]; }
        const float mu = s * (1.f / DM), var = fmaxf(s2 * (1.f / DM) - mu * mu, 0.f); st[2 * tid] = mu; st[2 * tid + 1] = 1.0f / sqrtf(var + LN_EPS); }
    {
        const float* ws_ = p.w_s + (size_t)g * 16384;
#pragma unroll
        for (int k = 0; k < 8; ++k) { const int idx = tid + 512 * k, t = idx >> 5, s4 = (idx & 31) * 4; f32x4 w = *(const f32x4*)(ws_ + t * 128 + s4);
#pragma unroll
            for (int e = 0; e < 4; ++e) if (s4 + e > t) w[e] = 0.f;
            *(LAS u32x2*)(Wt + t * 136 + s4) = (u32x2){pk2(w[0], w[1]), pk2(w[2], w[3])}; }
    }
    lds_barrier();
#pragma unroll
    for (int k = 0; k < 4; ++k) {
        const int q = tid + 512 * k, l = q & 63, grp = q >> 6, s = (grp >> 2) * 16 + (l >> 2), dc = (grp & 3) * 4 + (l & 3);
        const u32x4 raw = *(const u32x4*)(VA + (size_t)(m0 + s) * DM + g * 128 + dc * 8);
        const float mu = st[2 * s], rs = st[2 * s + 1];
        const float* gp = p.ln_v_g + g * 128 + dc * 8; const float* bp = p.ln_v_b + g * 128 + dc * 8;
        const f32x4 g0 = *(const f32x4*)gp, g1 = *(const f32x4*)(gp + 4), b0 = *(const f32x4*)bp, b1 = *(const f32x4*)(bp + 4);
        float v[8] = {bflo(raw.x), bfhi(raw.x), bflo(raw.y), bfhi(raw.y), bflo(raw.z), bfhi(raw.z), bflo(raw.w), bfhi(raw.w)};
#pragma unroll
        for (int e = 0; e < 8; ++e) { const float gg = e < 4 ? g0[e & 3] : g1[e & 3], bb = e < 4 ? b0[e & 3] : b1[e & 3]; const float y = (v[e] - mu) * rs * gg + bb;
            VnT[(dc * 8 + e) * 132 + s] = (bf16_t)(pk2(y, 0.f) & 0xffffu); }
    }
    lds_barrier();
    {
        bf16x8 wf[4];
        const int nks = ((16 * wid + 15) >> 5) + 1;
#pragma unroll
        for (int s = 0; s < 4; ++s) wf[s] = *(const LAS bf16x8*)(Wt + (16 * wid + fr) * 136 + 32 * s + 8 * fq);
        const int t = 16 * wid + fr; const float bs = p.b_s[g * 128 + t];
#pragma unroll
        for (int mb = 0; mb < 8; ++mb) {
            f32x4 acc = {0.f, 0.f, 0.f, 0.f};
#pragma unroll
            for (int s = 0; s < 4; ++s) if (s < nks) {
                const LAS bf16_t* vp = VnT + (16 * mb + fr) * 132 + 32 * s + 8 * fq; const u32x2 a0 = *(const LAS u32x2*)vp, a1 = *(const LAS u32x2*)(vp + 4);
                u32x4 aw = {a0.x, a0.y, a1.x, a1.y};
                acc = __builtin_amdgcn_mfma_f32_16x16x32_bf16(__builtin_bit_cast(bf16x8, aw), wf[s], acc, 0, 0, 0); }
            bf16_t* up = U + (size_t)(m0 + t) * DM + g * 128 + 16 * mb + 4 * fq; const u32x2 uw = *(const u32x2*)up;
            u32x2 o; o.x = pk2(bflo(uw.x) * (acc[0] + bs), bfhi(uw.x) * (acc[1] + bs)); o.y = pk2(bflo(uw.y) * (acc[2] + bs), bfhi(uw.y) * (acc[3] + bs));
            *(u32x2*)up = o;
        }
    }
    lds_barrier();
}

#define XB_TMO      128
#define XB_XCNT(j)  (256  + 64 * (j))
#define XB_XSUB(j)  (1280 + 64 * (j))
#define XB_XGEN(j)  (2304 + 64 * (j))
#define XB_TOP      3328
#define XB_TOPGEN   3392
#define XCD_BAR_WORDS 3456
#define XB_SPIN_CAP (1u << 18)
__device__ __forceinline__ unsigned xb_ld(unsigned* p)              { return __hip_atomic_load(p, __ATOMIC_RELAXED, __HIP_MEMORY_SCOPE_AGENT); }
__device__ __forceinline__ unsigned xb_add(unsigned* p, unsigned v) { return __hip_atomic_fetch_add(p, v, __ATOMIC_RELAXED, __HIP_MEMORY_SCOPE_AGENT); }
__device__ __forceinline__ unsigned xb_xcc_id() { return (unsigned)__builtin_amdgcn_s_getreg((3 << 11) | 20) & 0xFu; }
#define XB_SPIN(cond, bar) do { unsigned _sp = 0; while (cond) { __builtin_amdgcn_s_sleep(1); \
    if ((++_sp & 255u) == 0u) { if (xb_ld(&(bar)[XB_TMO])) break; if (_sp > XB_SPIN_CAP) { atomicAdd(&(bar)[XB_TMO], 1u); break; } } } } while (0)
struct XcdBarrier { unsigned* bar; unsigned x; volatile LAS unsigned* st; };
__device__ __forceinline__ XcdBarrier xcd_barrier_post(unsigned* bar, volatile LAS unsigned* st) {
    XcdBarrier b; b.bar = bar; b.x = xb_xcc_id(); b.st = st;
    if (threadIdx.x == 0) (void)xb_add(&bar[XB_XCNT(b.x)], 1u);
    return b;
}
__device__ __forceinline__ void xcd_barrier_complete(unsigned* bar, unsigned x, unsigned& nloc, unsigned& nx) {
    const unsigned G = gridDim.x * gridDim.y * gridDim.z;
    unsigned sum, cnt, mine, sp = 0u;
    for (;;) {
        sum = 0u; cnt = 0u; mine = 0u;
#pragma unroll
        for (unsigned j = 0; j < 16; ++j) { const unsigned c = xb_ld(&bar[XB_XCNT(j)]); sum += c; cnt += (c > 0u) ? 1u : 0u; mine = (j == x) ? c : mine; }
        if (sum == G) break;
        __builtin_amdgcn_s_sleep(1);
        if ((++sp & 255u) == 0u) { if (xb_ld(&bar[XB_TMO])) break; if (sp > XB_SPIN_CAP) { atomicAdd(&bar[XB_TMO], 1u); break; } }
    }
    nloc = mine > 0u ? mine : 1u; nx = cnt > 0u ? cnt : 1u;
}
__device__ __forceinline__ void xcd_barrier(const XcdBarrier& b) {
    asm volatile("s_waitcnt vmcnt(0)" ::: "memory");
    __syncthreads();
    if (threadIdx.x == 0) {
        unsigned* bar = b.bar;
        __builtin_amdgcn_s_waitcnt(0);
        unsigned nloc = b.st[0], nx = b.st[1];
        if (nloc == 0u) { xcd_barrier_complete(bar, b.x, nloc, nx); b.st[0] = nloc; b.st[1] = nx; }
        const unsigned old = xb_add(&bar[XB_XSUB(b.x)], 1u);
        const unsigned gen = old / nloc;
        if (old + 1u == (gen + 1u) * nloc) {
            __builtin_amdgcn_fence(__ATOMIC_RELEASE, "agent");
            asm volatile("s_waitcnt vmcnt(0)" ::: "memory");
            const unsigned og = xb_add(&bar[XB_TOP], 1u);
            const unsigned tg = og / nx;
            if (og + 1u == (tg + 1u) * nx) xb_add(&bar[XB_TOPGEN], 1u);
            else XB_SPIN(xb_ld(&bar[XB_TOPGEN]) == tg, bar);
            __builtin_amdgcn_fence(__ATOMIC_ACQUIRE, "agent");
            xb_add(&bar[XB_XGEN(b.x)], 1u);
            asm volatile("s_waitcnt vmcnt(0)" ::: "memory");
        } else {
            XB_SPIN(xb_ld(&bar[XB_XGEN(b.x)]) == gen, bar);
            __builtin_amdgcn_fence(__ATOMIC_ACQUIRE, "agent");
            asm volatile("s_waitcnt vmcnt(0)" ::: "memory");
        }
    }
    __syncthreads();
}

__device__ __forceinline__ unsigned char* opq(unsigned char* q) { asm volatile("" : "+s"(q)); return q; }
__global__ void __launch_bounds__(512, 2) mega_fwd(Params p) {
    extern __shared__ __attribute__((aligned(16))) unsigned char smem[];
    LAS unsigned char* lds = (LAS unsigned char*)smem;
    cg::grid_group grid = cg::this_grid();
    const int tid = threadIdx.x, wid = tid >> 6, lane = tid & 63, G = gridDim.x, blk = blockIdx.x;
    unsigned char* ws = p.ws;
#ifndef PHMASK
#define PHMASK 0x3ff
#endif
#define IN(k) (((PHMASK >> (k)) & 1) && p.ph_lo <= (k) && (k) < p.ph_hi)
#define SEAM(k) do { if (IN(k) && IN((k) + 1)) { if (p.coop == 2) grid.sync(); else xcd_barrier(xbar); } } while (0)
    volatile LAS unsigned* xst = (volatile LAS unsigned*)(lds + 160000);
    if (tid < 2) xst[tid] = 0u;
    __syncthreads();
    const XcdBarrier xbar = xcd_barrier_post((unsigned*)ws, xst);

    if (IN(0)) { unsigned char* ws = opq(p.ws);
        LAS float* scr = (LAS float*)(lds + wid * 16640);
        const int gw = blk * 8 + wid, NGW = G * 8;
        constexpr int I_IN = 32 * 256, I_BG = 32, I_P = 32 * 32;
        const int NIT = I_IN + I_BG + (G == 256 ? 0 : 3 * I_P);
        for (int it = gw; it < NIT; it += NGW) {
            int r = it;
            if (r < I_IN) { const int kb = r >> 8, nb = r & 255; const int n0 = nb < 192 ? 64 * nb : 12320 + 64 * (nb - 192); const int drow = nb < 192 ? n0 : n0 - 32;
                transpose64(p.w_in, 16416, (bf16_t*)(ws + WS_W1T), DM, 64 * kb, n0, drow, scr, lane); continue; }
            r -= I_IN;
            if (r < I_BG) { transpose_item(p.w_in, DM, 16416, (bf16_t*)(ws + WS_W1T), 16384, scr, r, 384, lane); continue; }
            r -= I_BG;
            if (r < I_P) { transpose64(p.w_proj_a, DM, (bf16_t*)(ws + WS_WPT), DM, 64 * (r >> 5), 64 * (r & 31), 64 * (r & 31), scr, lane); continue; } r -= I_P;
            if (r < I_P) { transpose64(p.w_proj_b, DM, (bf16_t*)(ws + WS_WPT), DM, 64 * (r >> 5), 64 * (r & 31), DM + 64 * (r & 31), scr, lane); continue; } r -= I_P;
            transpose64(p.w_o, DM, (bf16_t*)(ws + WS_WOT), DM, 64 * (r >> 5), 64 * (r & 31), 64 * (r & 31), scr, lane);
        }
        bf16_t* xb = (bf16_t*)(ws + WS_XB);
#pragma unroll 4
        for (size_t q = (size_t)blk * 512 + tid; q < (size_t)MPAD * DM / 8; q += (size_t)G * 512) {
            const size_t e = q * 8; const int row = (int)(e / DM);
            u32x4 o = {0u, 0u, 0u, 0u};
            if (row < MT) { const float* src = row < MP ? p.x_prompt + e : p.x_sample + (e - (size_t)MP * DM); const f32x4 a = *(const f32x4*)src, c2 = *(const f32x4*)(src + 4);
                o.x = pk2(a[0], a[1]); o.y = pk2(a[2], a[3]); o.z = pk2(c2[0], c2[1]); o.w = pk2(c2[2], c2[3]); }
            *(u32x4*)(xb + e) = o;
        }
        bf16_t* w1 = (bf16_t*)(ws + WS_W1T);
        for (size_t q = (size_t)blk * 512 + tid; q < (size_t)224 * DM / 8; q += (size_t)G * 512) *(u32x4*)(w1 + (size_t)16416 * DM + q * 8) = (u32x4){0u, 0u, 0u, 0u};
    }
    SEAM(0);
    if (IN(1)) { unsigned char* ws = opq(p.ws);
        pg8::Gemm g{(const bf16_t*)(ws + WS_XB), (const bf16_t*)(ws + WS_W1T), MPAD, N1, DM};
        pg8::Sched S; S.init(33, 65, G, blk, 0, 0, 0, 32);
        Epi1 E{ws, p.a_log, p.dt_bias};
        pg8::gemm_phase<Epi1>(lds, g, S, E);
        if (G == 256) { const int rem = (33 * 65) % 256;
            if (blk >= rem) { LAS float* scr = (LAS float*)(lds + wid * 16640); const int nw = (256 - rem) * 8;
                for (int t = (blk - rem) * 8 + wid; t < 3 * 1024; t += nw) { const int m = t >> 10, r = t & 1023;
                    if (m == 0) transpose64(p.w_proj_a, DM, (bf16_t*)(ws + WS_WPT), DM, 64 * (r >> 5), 64 * (r & 31), 64 * (r & 31), scr, lane);
                    else if (m == 1) transpose64(p.w_proj_b, DM, (bf16_t*)(ws + WS_WPT), DM, 64 * (r >> 5), 64 * (r & 31), DM + 64 * (r & 31), scr, lane);
                    else transpose64(p.w_o, DM, (bf16_t*)(ws + WS_WOT), DM, 64 * (r >> 5), 64 * (r & 31), 64 * (r & 31), scr, lane); } } }
    }
    SEAM(1);
    if (IN(2)) { unsigned char* ws = opq(p.ws);
        { int k = 0; for (int it = blk; it < 2048; it += G, ++k) prescan_item(p, lds, it, (G == 256 && k < 8) ? blk * 64 + k * 8 : -1); }
    }
    SEAM(2);
    if (IN(3)) { unsigned char* ws = opq(p.ws);
        const bool split = G > 64;
        if (blk < 64) { for (int bh = blk; bh < 64; bh += (split ? 64 : G)) scan_bh(p, lds, bh); }
        if (!split || blk >= 64) {
            const int oi = split ? blk - 64 : blk, on = split ? G - 64 : G;
            const bf16_t* qkv = (const bf16_t*)(ws + WS_QKV);
            for (int q = oi * 512 + tid; q < NBP * 3 * DQKV / 4; q += on * 512) { const int e = q * 4, col = e % DQKV, j = (e / DQKV) % 3, bb = e / (3 * DQKV);
                const u32x2 r = *(const u32x2*)(qkv + (size_t)(bb * SEQ + SEQ - 3 + j) * DQKV + col); *(f32x4*)(p.out + O_CP + e) = (f32x4){bflo(r.x), bfhi(r.x), bflo(r.y), bfhi(r.y)}; }
#pragma unroll 2
            for (int q = oi * 512 + tid; q < MS * 3 * DQKV / 4; q += on * 512) { const int e = q * 4, col = e % DQKV, j = (e / DQKV) % 3, bb = e / (3 * DQKV); f32x4 v;
                if (j < 2) v = *(const f32x4*)(p.state_conv + (size_t)(bb * 3 + j + 1) * DQKV + col);
                else { const u32x2 r = *(const u32x2*)(qkv + (size_t)(MP + bb) * DQKV + col); v = (f32x4){bflo(r.x), bfhi(r.x), bflo(r.y), bfhi(r.y)}; }
                *(f32x4*)(p.out + O_CS + e) = v; }
            const float* vstat = (const float*)(ws + WS_VSTAT); const bf16_t* VA = (const bf16_t*)(ws + WS_VA); bf16_t* U = (bf16_t*)(ws + WS_U);
            for (int row = oi * 8 + wid; row < MS; row += on * 8) { const int m = MP + row;
                const f32x2 st = lane < 32 ? *(const f32x2*)(vstat + (size_t)m * 64 + 2 * lane) : (f32x2){0.f, 0.f};
                const float s = wave_sum(st.x), s2 = wave_sum(st.y);
                const float mu = s * (1.f / DM), var = fmaxf(s2 * (1.f / DM) - mu * mu, 0.f), rs = 1.0f / sqrtf(var + LN_EPS);
#pragma unroll
                for (int k = 0; k < 8; ++k) { const int cc = (lane + 64 * k) * 4, gg = cc >> 7;
                    const u32x2 va = *(const u32x2*)(VA + (size_t)m * DM + cc); const f32x4 lg = *(const f32x4*)(p.ln_v_g + cc), lb = *(const f32x4*)(p.ln_v_b + cc);
                    f32x4 vn = {bflo(va.x), bfhi(va.x), bflo(va.y), bfhi(va.y)}; vn = (vn - mu) * rs * lg + lb;
                    *(f32x4*)(p.out + O_GV + (size_t)row * DM + cc) = vn;
                    const float w00 = p.w_s[(size_t)gg * 16384], bs0 = p.b_s[gg * 128];
                    bf16_t* up = U + (size_t)m * DM + cc; const u32x2 uw = *(const u32x2*)up;
                    *(u32x2*)up = (u32x2){pk2(bflo(uw.x) * (w00 * vn[0] + bs0), bfhi(uw.x) * (w00 * vn[1] + bs0)), pk2(bflo(uw.y) * (w00 * vn[2] + bs0), bfhi(uw.y) * (w00 * vn[3] + bs0))}; }
            }
        }
        {
            unsigned* qctr = (unsigned*)ws + 3584;
            volatile LAS int* slot = (volatile LAS int*)(lds + 160016);
            if (tid == 0) { slot[0] = (int)__hip_atomic_fetch_add(qctr, 1u, __ATOMIC_RELAXED, __HIP_MEMORY_SCOPE_AGENT); slot[1] = (int)__hip_atomic_fetch_add(qctr, 1u, __ATOMIC_RELAXED, __HIP_MEMORY_SCOPE_AGENT); }
            lds_barrier();
            int cur = slot[0], nxt = slot[1], par = 0;
            f32x4 Sr[8], Sn[8];
            if (cur < 2048) sample_prefetch(p, cur, Sr);
            lds_barrier();
            while (cur < 3072) {
                unsigned tick = 0u;
                if (tid == 0) tick = __hip_atomic_fetch_add(qctr, 1u, __ATOMIC_RELAXED, __HIP_MEMORY_SCOPE_AGENT);
                if (nxt < 2048) sample_prefetch(p, nxt, Sn);
                if (cur < 2048) sample_item(p, lds, cur, Sr); else mixerA_item(p, lds, cur - 2048);
                if (tid == 0) slot[par] = (int)tick;
                lds_barrier();
                const int nn = slot[par]; par ^= 1;
#pragma unroll
                for (int i = 0; i < 8; ++i) Sr[i] = Sn[i];
                cur = nxt; nxt = nn;
            }
        }
    }
    SEAM(3);
    if (IN(4)) { unsigned char* ws = opq(p.ws);
        pg8::Gemm g{(const bf16_t*)(ws + WS_U), (const bf16_t*)(ws + WS_WPT), 2 * MPAD, 2 * DM, DM};
        { pg8::Sched S; S.init(32, 8, G, blk, 1, 33, 8, 32); Epi4 E{ws}; pg8::gemm_phase<Epi4>(lds, g, S, E); }
        { pg8::Sched S; S.init_split(32, 8, 16, 2, G, blk, 1, 33, 8); EpiS4 E{ws}; pg8::gemm_phase<EpiS4>(lds, g, S, E); }
    }
    SEAM(4);
    if (IN(5)) { unsigned char* ws = opq(p.ws);
        {
            const float* part = (const float*)(ws + WS_PART); bf16_t* MB = (bf16_t*)(ws + WS_MB);
            for (int q = blk * 512 + tid; q < MS * DM / 4; q += G * 512) { f32x4 v = *(const f32x4*)(part + 4 * q);
#pragma unroll 8
                for (int sl = 1; sl < 32; ++sl) v += *(const f32x4*)(part + (size_t)sl * MS * DM + 4 * q);
                *(u32x2*)(MB + (size_t)MP * DM + 4 * q) = (u32x2){pk2(v[0], v[1]), pk2(v[2], v[3])}; }
        }
        pg8::Gemm g{(const bf16_t*)(ws + WS_MB), (const bf16_t*)(ws + WS_WOT), MPAD, DM, DM};
        { pg8::Sched S; S.init(32, 8, G, blk, 0, 0, 0, 32); EpiRes E{p.x_prompt, nullptr, (bf16_t*)(ws + WS_R1)}; pg8::gemm_phase<EpiRes>(lds, g, S, E); }
        xcd_barrier(xbar);
        { pg8::Sched S; S.init_split(32, 8, 16, 2, G, blk, 0, 0, 0); EpiSPart E{(float*)(ws + WS_PART), DM}; pg8::gemm_phase<EpiSPart>(lds, g, S, E); }
        if (G == 256) {
            const int gw2 = (blk & 127) * 8 + wid, nrow = blk >= 128 ? 5 : 3, base = blk >= 128 ? 0 : 5120;
            for (int j = 0; j < nrow; ++j) { const int m = base + gw2 + 1024 * j;
                ln_row_b((const bf16_t*)(ws + WS_R1) + (size_t)m * DM, p.ln1_g, p.ln1_b, nullptr, (bf16_t*)(ws + WS_X1B) + (size_t)m * DM, lane); }
        }
    }
    SEAM(5);
    if (IN(6)) { unsigned char* ws = opq(p.ws);
        const int gw = blk * 8 + wid, NGW = G * 8;
        for (int m = (G == 256 ? MP + gw : gw); m < MT; m += NGW) {
            if (m < MP) { if (G != 256) ln_row_b((const bf16_t*)(ws + WS_R1) + (size_t)m * DM, p.ln1_g, p.ln1_b, nullptr, (bf16_t*)(ws + WS_X1B) + (size_t)m * DM, lane); }
            else ln_row((const float*)(ws + WS_PART) + (size_t)(m - MP) * DM, p.ln1_g, p.ln1_b, (float*)(ws + WS_X1) + (size_t)m * DM, (bf16_t*)(ws + WS_X1B) + (size_t)m * DM, lane, 16, (size_t)MS * DM, p.x_sample + (size_t)(m - MP) * DM);
        }
        LAS float* scr = (LAS float*)(lds + wid * 16640);
        if (G != 256) for (int it = gw; it < 8192; it += NGW) {
            if (it < 4096) transpose64(p.w_up, DFF, (bf16_t*)(ws + WS_WUPT), DM, 64 * (it >> 7), 64 * (it & 127), 64 * (it & 127), scr, lane);
            else { const int r = it - 4096; transpose64(p.w_down, DM, (bf16_t*)(ws + WS_WDNT), DFF, 64 * (r >> 5), 64 * (r & 31), 64 * (r & 31), scr, lane); }
        }
    }
    SEAM(6);
    if (IN(7)) { unsigned char* ws = opq(p.ws);
        pg8::Gemm g{(const bf16_t*)(ws + WS_X1B), (const bf16_t*)(ws + WS_WUPT), MPAD, DFF, DM};
        { pg8::Sched S; S.init(32, 32, G, blk, 0, 0, 0, 32); Epi7 E{(bf16_t*)(ws + WS_H)}; pg8::gemm_phase<Epi7>(lds, g, S, E); }
        { pg8::Sched S; S.init_split(32, 32, 8, 4, G, blk, 0, 0, 0); EpiSPart E{(float*)(ws + WS_PART), DFF}; pg8::gemm_phase<EpiSPart>(lds, g, S, E); }
    }
    SEAM(7);
    if (IN(8)) { unsigned char* ws = opq(p.ws);
        {
            const float* part = (const float*)(ws + WS_PART); bf16_t* H = (bf16_t*)(ws + WS_H);
            for (int q = blk * 512 + tid; q < MS * DFF / 4; q += G * 512) { f32x4 v = *(const f32x4*)(part + 4 * q);
#pragma unroll
                for (int sl = 1; sl < 8; ++sl) v += *(const f32x4*)(part + (size_t)sl * MS * DFF + 4 * q);
#pragma unroll
                for (int e = 0; e < 4; ++e) { const float a = fmaxf(v[e], 0.f); v[e] = a * a; }
                *(u32x2*)(H + (size_t)MP * DFF + 4 * q) = (u32x2){pk2(v[0], v[1]), pk2(v[2], v[3])}; }
        }
        pg8::Gemm g{(const bf16_t*)(ws + WS_H), (const bf16_t*)(ws + WS_WDNT), MPAD, DM, DFF};
        { pg8::Sched S; S.init(32, 8, G, blk, 0, 0, 0, 128); EpiRes E{nullptr, (const bf16_t*)(ws + WS_X1B), (bf16_t*)(ws + WS_R2)}; pg8::gemm_phase<EpiRes>(lds, g, S, E); }
        xcd_barrier(xbar);
        { pg8::Sched S; S.init_split(32, 8, 32, 4, G, blk, 0, 0, 0); EpiSPart E{(float*)(ws + WS_PART), DM}; pg8::gemm_phase<EpiSPart>(lds, g, S, E); }
    }
    SEAM(8);
    if (IN(9)) { unsigned char* ws = opq(p.ws);
        const int gw = blk * 8 + wid, NGW = G * 8;
        for (int m = gw; m < MT; m += NGW) {
            if (m < MP) ln_row_b((const bf16_t*)(ws + WS_R2) + (size_t)m * DM, p.ln2_g, p.ln2_b, p.out + (size_t)m * DM, nullptr, lane);
            else ln_row((const float*)(ws + WS_PART) + (size_t)(m - MP) * DM, p.ln2_g, p.ln2_b, p.out + (size_t)m * DM, nullptr, lane, 32, (size_t)MS * DM, (const float*)(ws + WS_X1) + (size_t)m * DM);
        }
    }
#undef IN
#undef SEAM
}

extern "C" void kernel_launch(void* const* d_in, const int* in_sizes, int n_in, void* d_out, int out_size, void* d_ws, size_t ws_size, hipStream_t stream) {
    static int grid = 0;
    if (grid == 0) {
        int dev = 0, cus = 0, per_cu = 0;
        if (n_in != 22 || ws_size < WS_END) { fprintf(stderr, "kernel_launch: unexpected inputs (n_in %d, ws %zu)\n", n_in, ws_size); grid = -1; return; }
        hipGetDevice(&dev);
        hipDeviceGetAttribute(&cus, hipDeviceAttributeMultiprocessorCount, dev);
        if (hipFuncSetAttribute((const void*)mega_fwd, hipFuncAttributeMaxDynamicSharedMemorySize, LDS_BYTES) != hipSuccess) { fprintf(stderr, "kernel_launch: hipFuncSetAttribute failed\n"); grid = -1; return; }
        if (hipOccupancyMaxActiveBlocksPerMultiprocessor(&per_cu, (const void*)mega_fwd, 512, LDS_BYTES) != hipSuccess || per_cu < 1) { fprintf(stderr, "kernel_launch: occupancy query says %d\n", per_cu); per_cu = 1; }
        (void)hipGetLastError();
        grid = cus;
    }
    if (grid < 0) return;
    Params p{};
    const float** pp = (const float**)&p;
    for (int i = 0; i < 22; ++i) pp[i] = (const float*)d_in[i];
    p.out = (float*)d_out; p.ws = (unsigned char*)d_ws; p.ph_lo = 0; p.ph_hi = 10; p.coop = 1; p.pad = 0;
    if (hipMemsetAsync(d_ws, 0, 16384, stream) != hipSuccess) { fprintf(stderr, "kernel_launch: memset failed\n"); return; }
    void* args[] = {&p};
    hipError_t e = hipLaunchCooperativeKernel((const void*)mega_fwd, dim3(grid), dim3(512), args, LDS_BYTES, stream);
    if (e != hipSuccess) fprintf(stderr, "cooperative launch failed: %s (grid %d)\n", hipGetErrorString(e), grid);
}
```

```cpp
#include <hip/hip_runtime.h>
#include <hip/hip_cooperative_groups.h>
#include <cstdio>
#include <cstdint>
namespace cg = cooperative_groups;

#define LAS __attribute__((address_space(3)))
typedef unsigned short bf16_t;
typedef short bf16x8 __attribute__((ext_vector_type(8)));
typedef short s16x4 __attribute__((ext_vector_type(4)));
typedef float f32x2 __attribute__((ext_vector_type(2)));
typedef float f32x4 __attribute__((ext_vector_type(4)));
typedef float f32x16 __attribute__((ext_vector_type(16)));
typedef unsigned u32x2 __attribute__((ext_vector_type(2)));
typedef unsigned u32x4 __attribute__((ext_vector_type(4)));

constexpr int DM = 2048, SEQ = 2048, NBP = 4, MP = 8192, MS = 128, MT = 8320, MPAD = 8448;
constexpr int N1 = 16640, DFF = 8192, DQKV = 6144;
constexpr float ALPHA = 1.189207115002721f, LN_EPS = 1e-5f, RMS_EPS = 1e-6f;
constexpr int LDS_BYTES = 160768;
constexpr size_t MiB = 1u << 20;
constexpr size_t WS_BG = 1 * MiB, WS_VSTAT = 3 * MiB, WS_GL = 6 * MiB;
constexpr size_t WS_WPT = 8 * MiB, WS_WOT = 24 * MiB, WS_U = 32 * MiB, WS_Z = 65 * MiB, WS_VA = 98 * MiB, WS_QKV = 131 * MiB;
constexpr size_t WS_GA = 230 * MiB, WS_GB = 263 * MiB, WS_W1T = 296 * MiB, WS_XB = 361 * MiB, WS_PS = 296 * MiB;
constexpr size_t WS_MTMP = 296 * MiB, WS_MB = 362 * MiB, WS_R1 = 395 * MiB, WS_H = 296 * MiB;
constexpr size_t WS_WUPT = 440 * MiB, WS_WDNT = 472 * MiB,
     WS_X1 = 131 * MiB, WS_X1B = 197 * MiB, WS_R2 = 230 * MiB;
constexpr size_t WS_PART = 98 * MiB;
constexpr size_t WS_END = 504 * MiB;
constexpr int PS_ITEM = 73728;
constexpr int PS_W = 0, PS_KCD = 16384, PS_QD = 32768, PS_KDT = 49152, PS_AT = 65536;
constexpr size_t O_YP = 0, O_YS = 16777216, O_CP = 17039360, O_SP = 17113088, O_GV = 18161664, O_CS = 18423808, O_SS = 20783104;

__device__ __forceinline__ unsigned pk2(float lo, float hi) { typedef __bf16 b2 __attribute__((ext_vector_type(2))); f32x2 v = {lo, hi}; b2 b = __builtin_convertvector(v, b2); return __builtin_bit_cast(unsigned, b); }
__device__ __forceinline__ float bf2f(unsigned short b) { return __uint_as_float((unsigned)b << 16); }
__device__ __forceinline__ float bflo(unsigned w) { return __uint_as_float(w << 16); }
__device__ __forceinline__ float bfhi(unsigned w) { return __uint_as_float(w & 0xffff0000u); }
__device__ __forceinline__ float sigmoidf_(float x) { return 1.0f / (1.0f + __expf(-x)); }
__device__ __forceinline__ float siluf_(float x) { return x / (1.0f + __expf(-x)); }
__device__ __forceinline__ float wave_sum(float v) {
#pragma unroll
    for (int o = 1; o < 64; o <<= 1) v += __shfl_xor(v, o);
    return v;
}
__device__ __forceinline__ void lds_barrier() { asm volatile("s_waitcnt lgkmcnt(0)\n\ts_barrier" ::: "memory"); }
__device__ __forceinline__ f32x2 gelu_pk(f32x2 v) {
    const f32x2 av = __builtin_elementwise_abs(v), d = av * 0.2316418882f + 1.0f;
    f32x2 t; t.x = __builtin_amdgcn_rcpf(d.x); t.y = __builtin_amdgcn_rcpf(d.y);
    f32x2 q = t * 0.5307027145f + (-0.7265760135f); q = q * t + 0.7107068705f; q = q * t + (-0.142248368f); q = q * t + 0.127414796f; q = q * t;
    const f32x2 s = (v * v) * (-0.72134752044f);
    f32x2 e; e.x = __builtin_amdgcn_exp2f(s.x); e.y = __builtin_amdgcn_exp2f(s.y);
    const f32x2 m = v * (q * e), r = v - m;
    f32x2 o; o.x = v.x < 0.f ? m.x : r.x; o.y = v.y < 0.f ? m.y : r.y; return o;
}
__device__ __forceinline__ f32x4 gelu4(f32x4 v) { f32x2 a = gelu_pk((f32x2){v[0], v[1]}), b = gelu_pk((f32x2){v[2], v[3]}); return (f32x4){a.x, a.y, b.x, b.y}; }

namespace pg8 {
constexpr int BM = 256, BK = 64, HALF = 128, HTB = HALF * BK * 2, STAGE_BYTES = 8 * HTB, NXCD = 8, WGM = 8;
__host__ __device__ __forceinline__ int lds_byte(int r, int c) { const int st = (r >> 4) * 2 + (c >> 5), rr = r & 15, cc = c & 31, ob = rr * 64 + cc * 2; return st * 1024 + (ob ^ (((ob >> 9) & 1) << 5)); }
__host__ __device__ __forceinline__ void stage_rc(int b, int& R, int& C) { const int st = b / 1024, sb = b % 1024, swz = sb ^ (((sb >> 9) & 1) << 5); R = (st >> 1) * 16 + swz / 64; C = (st & 1) * 32 + (swz % 64) / 2; }
__host__ __device__ __forceinline__ int perm32(int rho) { const int n = rho >> 4, i = rho & 15; return 8 * (i >> 2) + 4 * n + (i & 3); }
struct Unit { int pm, pn, k0, nt; };
struct Gemm { const bf16_t* A; const bf16_t* Bt; int M, N, K; };
struct Sched {
    int nM, nN, nwg, G, c, pairs, offM, offN, ntK;
    int split, sM, sNt, sSl, sNtK;
    __device__ void init(int nM_, int nN_, int G_, int c_, int pairs_, int offM_, int offN_, int ntK_) { nM = nM_; nN = nN_; nwg = nM * nN; G = G_; c = c_; pairs = pairs_; offM = offM_; offN = offN_; ntK = ntK_; split = 0; sM = 0; sNt = 0; sSl = 0; sNtK = 0; }
    __device__ void init_split(int sM_, int nN_, int slices, int ntk_slice, int G_, int c_, int pairs_, int offM_, int offN_) { init(1, nN_, G_, c_, pairs_, offM_, offN_, ntk_slice); split = 1; sM = sM_; sNt = nN_; sSl = slices; sNtK = ntk_slice; nwg = nN_ * slices * (pairs_ ? 2 : 1); }
    __device__ bool next(int i, Unit& u) const {
        if (split) {
            const int L = i * G + c; if (L >= nwg) return false;
            const int sl = L % sSl, r = L / sSl, pn = r % sNt, which = r / sNt;
            u.pm = sM + which * offM; u.pn = pn + which * offN; u.k0 = sl * sNtK; u.nt = sNtK; return true;
        }
        const int j = pairs ? (i >> 1) : i, which = pairs ? (i & 1) : 0;
        const long L = (long)j * G + c; if (L >= nwg) return false;
        int wgid = (int)L; { const int q = nwg / NXCD, r = nwg % NXCD, xcd = wgid % NXCD, off = wgid / NXCD; wgid = (xcd < r ? xcd * (q + 1) : r * (q + 1) + (xcd - r) * q) + off; }
        const int nig = WGM * nN, gid = wgid / nig, fm = gid * WGM, gsz = (nM - fm) < WGM ? (nM - fm) : WGM;
        u.pm = fm + ((wgid % nig) % gsz) + which * offM; u.pn = (wgid % nig) / gsz + which * offN; u.k0 = 0; u.nt = ntK; return true;
    }
};

template <class Epi>
__device__ __forceinline__ void gemm_phase(LAS unsigned char* lds, const Gemm g, const Sched& S, const Epi& E) {
    const int tid = threadIdx.x, wid = __builtin_amdgcn_readfirstlane(tid >> 6), lane = tid & 63, wr = wid >> 2, wc = wid & 3, fr = lane & 15, fq = lane >> 4;
    const int K = g.K;
    unsigned voffA[2], voffB[2];
#pragma unroll
    for (int i = 0; i < 2; ++i) { int R, C; stage_rc(tid * 16 + i * 8192, R, C); const int Rb = (R & ~31) + perm32(R & 31);
        voffA[i] = (unsigned)(R * K + C) * 2u; voffB[i] = (unsigned)(Rb * K + C) * 2u; }
    const size_t kstep = (size_t)(BK * 2);
    const size_t hstep = (size_t)HALF * K * 2;
    const size_t tstep = 2 * hstep;
    const unsigned ldsw = (unsigned)wid * 1024u;
    const int aoff = lds_byte(wr * 64 + fr, fq * 8), boff = lds_byte(wc * 32 + fr, fq * 8);
#define PG8_SA(b, h) (((b) * 2 + (h)) * HTB)
#define PG8_SB(b, h) ((4 + (b) * 2 + (h)) * HTB)
#define PG8_STAGE(bufoff, gbase, voff) do { _Pragma("unroll") for (int _i = 0; _i < 2; ++_i) \
        __builtin_amdgcn_global_load_lds((const unsigned*)((const char*)(gbase) + (voff)[_i]), (LAS unsigned*)(lds + (bufoff) + ldsw + _i * 8192), 16, 0, 0); } while (0)
#define PG8_LDA(dst, b, h) do { _Pragma("unroll") for (int m = 0; m < 4; ++m) _Pragma("unroll") for (int k = 0; k < 2; ++k) dst[m][k] = *(const LAS bf16x8*)(lds + PG8_SA(b, h) + aoff + m * 2048 + k * 1024); } while (0)
#define PG8_LDB(dst, b, h) do { _Pragma("unroll") for (int n = 0; n < 2; ++n) _Pragma("unroll") for (int k = 0; k < 2; ++k) dst[n][k] = *(const LAS bf16x8*)(lds + PG8_SB(b, h) + boff + n * 2048 + k * 1024); } while (0)
#define PG8_MMA(ai, bj, At, Bt) do { __builtin_amdgcn_s_setprio(1); _Pragma("unroll") for (int m = 0; m < 4; ++m) _Pragma("unroll") for (int n = 0; n < 2; ++n) _Pragma("unroll") for (int k = 0; k < 2; ++k) \
        acc[ai][bj][m][n] = __builtin_amdgcn_mfma_f32_16x16x32_bf16(Bt[n][k], At[m][k], acc[ai][bj][m][n], 0, 0, 0); __builtin_amdgcn_s_setprio(0); } while (0)
#define PG8_WAIT_V(n) asm volatile("s_waitcnt vmcnt(" #n ")" ::: "memory")
#define PG8_WAIT_L(n) asm volatile("s_waitcnt lgkmcnt(" #n ")" ::: "memory")
#define PG8_BAR __builtin_amdgcn_s_barrier()
#define PG8_SCHED __builtin_amdgcn_sched_barrier(0)
    Unit cur, nxt; int ui = 0;
    if (!S.next(0, cur)) return;
    f32x4 acc[2][2][4][2];
#pragma unroll
    for (int a = 0; a < 2; ++a)
#pragma unroll
        for (int b = 0; b < 2; ++b)
#pragma unroll
            for (int m = 0; m < 4; ++m)
#pragma unroll
                for (int n = 0; n < 2; ++n) acc[a][b][m][n] = (f32x4){0.f, 0.f, 0.f, 0.f};
    bf16x8 At[4][2], B0[2][2], B1[2][2];
    const char* cA = (const char*)g.A + (size_t)cur.pm * tstep + (size_t)cur.k0 * kstep; const char* cB = (const char*)g.Bt + (size_t)cur.pn * tstep + (size_t)cur.k0 * kstep;
    PG8_STAGE(PG8_SB(0, 0), cB, voffB); PG8_STAGE(PG8_SB(0, 1), cB + hstep, voffB); PG8_STAGE(PG8_SA(0, 0), cA, voffA); PG8_STAGE(PG8_SA(0, 1), cA + hstep, voffA);
    if (wr == 1) PG8_BAR;
    PG8_WAIT_V(2); PG8_BAR;
    PG8_STAGE(PG8_SB(1, 0), cB + kstep, voffB); PG8_STAGE(PG8_SA(1, 0), cA + kstep, voffA); PG8_STAGE(PG8_SB(1, 1), cB + hstep + kstep, voffB);
    PG8_WAIT_V(6); PG8_BAR;
    for (;;) {
        const bool has_next = S.next(ui + 1, nxt);
        const char* nA = has_next ? (const char*)g.A + (size_t)nxt.pm * tstep + (size_t)nxt.k0 * kstep : cA; const char* nB = has_next ? (const char*)g.Bt + (size_t)nxt.pn * tstep + (size_t)nxt.k0 * kstep : cB;
        const int nt = cur.nt;
        for (int t = 0; t < nt; t += 2) {
            const bool last = (t == nt - 2);
            const char* a1 = cA + (size_t)(t + 1) * kstep;
            const char* a2 = last ? nA : cA + (size_t)(t + 2) * kstep; const char* b2 = last ? nB : cB + (size_t)(t + 2) * kstep;
            const char* a3 = a2 + kstep; const char* b3 = b2 + kstep;
            PG8_LDB(B0, 0, 0); PG8_LDB(B1, 0, 1); PG8_SCHED; PG8_LDA(At, 0, 0); PG8_STAGE(PG8_SA(1, 1), a1 + hstep, voffA);
            PG8_WAIT_V(8); PG8_WAIT_L(0); PG8_BAR; PG8_MMA(0, 0, At, B0); PG8_MMA(0, 1, At, B1); PG8_BAR; PG8_SCHED;
            PG8_LDA(At, 0, 1); PG8_STAGE(PG8_SB(0, 0), b2, voffB); PG8_STAGE(PG8_SB(0, 1), b2 + hstep, voffB); PG8_STAGE(PG8_SA(0, 0), a2, voffA);
            PG8_WAIT_V(8); PG8_WAIT_L(0); PG8_BAR; PG8_MMA(1, 0, At, B0); PG8_MMA(1, 1, At, B1); PG8_BAR; PG8_SCHED;
            PG8_LDB(B0, 1, 0); PG8_LDB(B1, 1, 1); PG8_SCHED; PG8_LDA(At, 1, 0); PG8_STAGE(PG8_SA(0, 1), a2 + hstep, voffA);
            PG8_WAIT_V(8); PG8_WAIT_L(0); PG8_BAR; PG8_MMA(0, 0, At, B0); PG8_MMA(0, 1, At, B1); PG8_BAR; PG8_SCHED;
            PG8_LDA(At, 1, 1); PG8_STAGE(PG8_SB(1, 0), b3, voffB); PG8_STAGE(PG8_SB(1, 1), b3 + hstep, voffB); PG8_STAGE(PG8_SA(1, 0), a3, voffA);
            PG8_WAIT_V(8); PG8_WAIT_L(0); PG8_BAR; PG8_MMA(1, 0, At, B0); PG8_MMA(1, 1, At, B1); PG8_BAR; PG8_SCHED;
        }
        if (wr == 0) PG8_BAR;
        E(acc, cur, wr, wc, fr, fq);
        if (!has_next) break;
#pragma unroll
        for (int a = 0; a < 2; ++a)
#pragma unroll
            for (int b = 0; b < 2; ++b)
#pragma unroll
                for (int m = 0; m < 4; ++m)
#pragma unroll
                    for (int n = 0; n < 2; ++n) acc[a][b][m][n] = (f32x4){0.f, 0.f, 0.f, 0.f};
        cur = nxt; cA = nA; cB = nB; ++ui;
        if (wr == 1) PG8_BAR;
    }
    PG8_WAIT_V(0);
    PG8_BAR;
#undef PG8_SA
#undef PG8_SB
#undef PG8_STAGE
#undef PG8_LDA
#undef PG8_LDB
#undef PG8_MMA
#undef PG8_WAIT_V
#undef PG8_WAIT_L
#undef PG8_BAR
#undef PG8_SCHED
}
}
using pg8::Unit;
typedef f32x4 Acc[2][2][4][2];

struct Params {
    const float *x_prompt, *x_sample, *state_conv, *state_ssm, *w_in, *w_s, *b_s, *ln_v_g, *ln_v_b, *w_conv, *a_log, *dt_bias, *w_onorm,
                *w_proj_a, *w_proj_b, *w_o, *ln1_g, *ln1_b, *w_up, *w_down, *ln2_g, *ln2_b;
    float* out; unsigned char* ws; int ph_lo, ph_hi, coop, pad;
};

__device__ __forceinline__ void store8bf(bf16_t* p, f32x4 v0, f32x4 v1) { u32x4 w; w.x = pk2(v0[0], v0[1]); w.y = pk2(v0[2], v0[3]); w.z = pk2(v1[0], v1[1]); w.w = pk2(v1[2], v1[3]); *(u32x4*)p = w; }

struct Epi1 {
    unsigned char* ws; const float* a_log; const float* dt_bias;
    __device__ __forceinline__ void operator()(const Acc& acc, const Unit& u, int wr, int wc, int fr, int fq) const {
        const int pn = u.pn; const int row0 = u.pm * 256 + wr * 64 + fr; const int cl = wc * 32 + 8 * fq;
        if (pn < 64) {
            int act, ld, cb; size_t boff;
            if (pn < 8) { boff = WS_U; act = 1; ld = DM; cb = pn * 256; }
            else if (pn < 16) { boff = WS_VA; act = 1; ld = DM; cb = (pn - 8) * 256; }
            else if (pn < 40) { boff = WS_QKV; act = 0; ld = DQKV; cb = (pn - 16) * 256; }
            else if (pn < 48) { boff = WS_Z; act = 2; ld = DM; cb = (pn - 40) * 256; }
            else if (pn < 56) { boff = WS_GA; act = 3; ld = DM; cb = (pn - 48) * 256; }
            else { boff = WS_GB; act = 3; ld = DM; cb = (pn - 56) * 256; }
            const bool stats = (pn >= 8 && pn < 16);
            bf16_t* base = (bf16_t*)(ws + boff);
            float* vstat = (float*)(ws + WS_VSTAT) + ((pn - 8) * 4 + wc) * 2;
            const unsigned off0 = (unsigned)(row0 * ld + cb + cl);
#pragma unroll
            for (int ai = 0; ai < 2; ++ai)
#pragma unroll
                for (int m = 0; m < 4; ++m) {
                    const unsigned off = off0 + (unsigned)((ai * 128 + m * 16) * ld); float s = 0.f, s2 = 0.f;
#pragma unroll
                    for (int bj = 0; bj < 2; ++bj) { f32x4 v0 = acc[ai][bj][m][0], v1 = acc[ai][bj][m][1];
                        if (act == 1) { v0 = gelu4(v0); v1 = gelu4(v1); }
                        else if (act >= 2) {
#pragma unroll
                            for (int e = 0; e < 4; ++e) { const float t0 = sigmoidf_(v0[e]), t1 = sigmoidf_(v1[e]); v0[e] = act == 2 ? v0[e] * t0 : t0; v1[e] = act == 2 ? v1[e] * t1 : t1; } }
                        if (stats) {
#pragma unroll
                            for (int e = 0; e < 4; ++e) { s += v0[e] + v1[e]; s2 += v0[e] * v0[e] + v1[e] * v1[e]; } }
                        store8bf(base + off + bj * 128, v0, v1); }
                    if (stats) { s += __shfl_xor(s, 16); s += __shfl_xor(s, 32); s2 += __shfl_xor(s2, 16); s2 += __shfl_xor(s2, 32);
                        if (fq == 0) { float* sp = vstat + (unsigned)((row0 + ai * 128 + m * 16) * 64); sp[0] = s; sp[1] = s2; } }
                    __builtin_amdgcn_sched_barrier(0);
                }
        } else if (wc == 0) {
            float* bg = (float*)(ws + WS_BG);
            const unsigned boff0 = (unsigned)(row0 * 32 + 8 * fq);
            if (fq < 2) {
#pragma unroll
                for (int ai = 0; ai < 2; ++ai)
#pragma unroll
                    for (int m = 0; m < 4; ++m) {
#pragma unroll
                        for (int n = 0; n < 2; ++n) { const f32x4 v = acc[ai][0][m][n]; f32x4 o;
#pragma unroll
                            for (int e = 0; e < 4; ++e) o[e] = sigmoidf_(v[e]);
                            *(f32x4*)(bg + boff0 + (unsigned)((ai * 128 + m * 16) * 32 + 4 * n)) = o; }
                        __builtin_amdgcn_sched_barrier(0); }
            } else {
                const int h0 = 8 * (fq - 2);
#pragma unroll
                for (int n = 0; n < 2; ++n) {
                    f32x4 na = *(const f32x4*)(a_log + h0 + 4 * n); const f32x4 db = *(const f32x4*)(dt_bias + h0 + 4 * n);
#pragma unroll
                    for (int e = 0; e < 4; ++e) na[e] = -__expf(na[e]);
#pragma unroll
                    for (int ai = 0; ai < 2; ++ai)
#pragma unroll
                        for (int m = 0; m < 4; ++m) { const f32x4 v = acc[ai][0][m][n]; f32x4 o;
#pragma unroll
                            for (int e = 0; e < 4; ++e) { const float xx = v[e] + db[e]; const float sp = xx > 20.f ? xx : __logf(1.0f + __expf(xx)); o[e] = na[e] * sp; }
                            *(f32x4*)(bg + boff0 + (unsigned)((ai * 128 + m * 16) * 32 + 4 * n)) = o;
                            __builtin_amdgcn_sched_barrier(0); }
                }
            }
        }
    }
};
struct Epi4 {
    unsigned char* ws;
    __device__ __forceinline__ void operator()(const Acc& acc, const Unit& u, int wr, int wc, int fr, int fq) const {
        const int which = u.pm >= 33 ? 1 : 0; const int pm = u.pm - 33 * which, pn = u.pn - 8 * which;
        const bf16_t* gate = (const bf16_t*)(ws + (which ? WS_GB : WS_GA)); bf16_t* mt = (bf16_t*)(ws + WS_MTMP); bf16_t* mb = (bf16_t*)(ws + WS_MB);
        const int row0 = pm * 256 + wr * 64 + fr, col0 = pn * 256 + wc * 32 + 8 * fq;
#pragma unroll
        for (int ai = 0; ai < 2; ++ai)
#pragma unroll
            for (int m = 0; m < 4; ++m) { const size_t off = (size_t)(row0 + ai * 128 + m * 16) * DM + col0;
#pragma unroll
                for (int bj = 0; bj < 2; ++bj) { const u32x4 gw = *(const u32x4*)(gate + off + bj * 128);
                    f32x4 g0 = {bflo(gw.x), bfhi(gw.x), bflo(gw.y), bfhi(gw.y)}, g1 = {bflo(gw.z), bfhi(gw.z), bflo(gw.w), bfhi(gw.w)};
                    f32x4 v0 = acc[ai][bj][m][0] * g0, v1 = acc[ai][bj][m][1] * g1;
                    if (which == 0) store8bf(mt + off + bj * 128, v0, v1);
                    else { const u32x4 tw = *(const u32x4*)(mt + off + bj * 128); v0 += (f32x4){bflo(tw.x), bfhi(tw.x), bflo(tw.y), bfhi(tw.y)}; v1 += (f32x4){bflo(tw.z), bfhi(tw.z), bflo(tw.w), bfhi(tw.w)}; store8bf(mb + off + bj * 128, v0, v1); } } }
    }
};
struct EpiRes {
    __device__ __forceinline__ void done(const Unit&) const {}
    const float* resf; const bf16_t* resb; bf16_t* out;
    __device__ __forceinline__ void operator()(const Acc& acc, const Unit& u, int wr, int wc, int fr, int fq) const {
        const int row0 = u.pm * 256 + wr * 64 + fr, col0 = u.pn * 256 + wc * 32 + 8 * fq;
#pragma unroll
        for (int ai = 0; ai < 2; ++ai)
#pragma unroll
            for (int m = 0; m < 4; ++m) { const size_t off = (size_t)(row0 + ai * 128 + m * 16) * DM + col0;
#pragma unroll
                for (int bj = 0; bj < 2; ++bj) { f32x4 r0, r1;
                    if (resf) { r0 = *(const f32x4*)(resf + off + bj * 128); r1 = *(const f32x4*)(resf + off + bj * 128 + 4); }
                    else { const u32x4 w = *(const u32x4*)(resb + off + bj * 128); r0 = (f32x4){bflo(w.x), bfhi(w.x), bflo(w.y), bfhi(w.y)}; r1 = (f32x4){bflo(w.z), bfhi(w.z), bflo(w.w), bfhi(w.w)}; }
                    store8bf(out + off + bj * 128, r0 * ALPHA + acc[ai][bj][m][0], r1 * ALPHA + acc[ai][bj][m][1]); } }
    }
};
struct Epi7 {
    bf16_t* H;
    __device__ __forceinline__ void operator()(const Acc& acc, const Unit& u, int wr, int wc, int fr, int fq) const {
        const int row0 = u.pm * 256 + wr * 64 + fr, col0 = u.pn * 256 + wc * 32 + 8 * fq;
#pragma unroll
        for (int ai = 0; ai < 2; ++ai)
#pragma unroll
            for (int m = 0; m < 4; ++m) { const size_t off = (size_t)(row0 + ai * 128 + m * 16) * DFF + col0;
#pragma unroll
                for (int bj = 0; bj < 2; ++bj) { f32x4 v0 = acc[ai][bj][m][0], v1 = acc[ai][bj][m][1];
#pragma unroll
                    for (int e = 0; e < 4; ++e) { const float a = fmaxf(v0[e], 0.f), b = fmaxf(v1[e], 0.f); v0[e] = a * a; v1[e] = b * b; }
                    store8bf(H + off + bj * 128, v0, v1); } }
    }
};

struct EpiSPart {
    float* part; int ld;
    __device__ __forceinline__ void operator()(const Acc& acc, const Unit& u, int wr, int wc, int fr, int fq) const {
        const int r0 = wr * 64 + fr, col0 = u.pn * 256 + wc * 32 + 8 * fq; float* base = part + (size_t)(u.k0 / u.nt) * 128 * ld;
#pragma unroll
        for (int m = 0; m < 4; ++m) { float* op = base + (size_t)(r0 + m * 16) * ld + col0;
#pragma unroll
            for (int bj = 0; bj < 2; ++bj) { *(f32x4*)(op + bj * 128) = acc[0][bj][m][0]; *(f32x4*)(op + bj * 128 + 4) = acc[0][bj][m][1]; } }
    }
};
struct EpiS4 {
    unsigned char* ws;
    __device__ __forceinline__ void operator()(const Acc& acc, const Unit& u, int wr, int wc, int fr, int fq) const {
        const int which = u.pm >= 33 ? 1 : 0; const int pn = u.pn - 8 * which;
        const bf16_t* gate = (const bf16_t*)(ws + (which ? WS_GB : WS_GA)); float* base = (float*)(ws + WS_PART) + (size_t)(which * 16 + u.k0 / u.nt) * 128 * DM;
        const int r0 = wr * 64 + fr, col0 = pn * 256 + wc * 32 + 8 * fq;
#pragma unroll
        for (int m = 0; m < 4; ++m) { const int r = r0 + m * 16;
#pragma unroll
            for (int bj = 0; bj < 2; ++bj) { const u32x4 gw = *(const u32x4*)(gate + (size_t)(MP + r) * DM + col0 + bj * 128);
                const f32x4 g0 = {bflo(gw.x), bfhi(gw.x), bflo(gw.y), bfhi(gw.y)}, g1 = {bflo(gw.z), bfhi(gw.z), bflo(gw.w), bfhi(gw.w)};
                float* op = base + (size_t)r * DM + col0 + bj * 128; *(f32x4*)op = acc[0][bj][m][0] * g0; *(f32x4*)(op + 4) = acc[0][bj][m][1] * g1; } }
    }
};

__device__ __forceinline__ void transpose_item(const float* W, int K, int N, bf16_t* WT, int dst_row0, LAS float* scr, int kb, int nb, int lane) {
    const int k0 = 64 * kb, n0 = 32 * nb;
#pragma unroll 8
    for (int i = 0; i < 32; ++i) { const int kk = 2 * i + (lane >> 5); scr[kk * 33 + (lane & 31)] = W[(size_t)(k0 + kk) * N + n0 + (lane & 31)]; }
    asm volatile("s_waitcnt lgkmcnt(0)" ::: "memory");
    const int c = lane & 7;
#pragma unroll
    for (int j = 0; j < 4; ++j) { const int n = (lane >> 3) + 8 * j; const LAS float* s = scr + (8 * c) * 33 + n;
        u32x4 o; o.x = pk2(s[0 * 33], s[1 * 33]); o.y = pk2(s[2 * 33], s[3 * 33]); o.z = pk2(s[4 * 33], s[5 * 33]); o.w = pk2(s[6 * 33], s[7 * 33]);
        *(u32x4*)(WT + (size_t)(dst_row0 + n) * K + k0 + 8 * c) = o; }
    asm volatile("s_waitcnt lgkmcnt(0)" ::: "memory");
}
__device__ __forceinline__ void transpose_item_fast(const float* W, int K, int N, bf16_t* WT, int dst_row0, LAS float* scr, int kb, int nb, int lane) {
    const int k0 = 64 * kb, n0 = 32 * nb;
    float v[32];
    const float* src = W + (size_t)(k0 + (lane >> 5)) * N + n0 + (lane & 31);
#pragma unroll
    for (int i = 0; i < 32; ++i) v[i] = src[(size_t)(2 * i) * N];
#pragma unroll
    for (int i = 0; i < 32; ++i) scr[(2 * i + (lane >> 5)) * 33 + (lane & 31)] = v[i];
    asm volatile("s_waitcnt lgkmcnt(0)" ::: "memory");
    const int c = lane & 7;
#pragma unroll
    for (int j = 0; j < 4; ++j) { const int n = (lane >> 3) + 8 * j; const LAS float* s = scr + (8 * c) * 33 + n;
        u32x4 o; o.x = pk2(s[0 * 33], s[1 * 33]); o.y = pk2(s[2 * 33], s[3 * 33]); o.z = pk2(s[4 * 33], s[5 * 33]); o.w = pk2(s[6 * 33], s[7 * 33]);
        *(u32x4*)(WT + (size_t)(dst_row0 + n) * K + k0 + 8 * c) = o; }
    asm volatile("s_waitcnt lgkmcnt(0)" ::: "memory");
}
__device__ __forceinline__ void transpose64(const float* W, int N, bf16_t* WT, int K, int k0, int n0, int dst_row0, LAS float* scr, int lane) {
    f32x4 v[16];
    const float* src = W + (size_t)(k0 + (lane >> 4)) * N + n0 + (lane & 15) * 4;
#pragma unroll
    for (int t = 0; t < 16; ++t) v[t] = *(const f32x4*)(src + (size_t)(4 * t) * N);
#pragma unroll
    for (int t = 0; t < 16; ++t) { LAS float* d = scr + (4 * t + (lane >> 4)) * 65 + (lane & 15) * 4; d[0] = v[t][0]; d[1] = v[t][1]; d[2] = v[t][2]; d[3] = v[t][3]; }
    asm volatile("s_waitcnt lgkmcnt(0)" ::: "memory");
    const int c = lane & 7;
#pragma unroll
    for (int j = 0; j < 8; ++j) { const int n = (lane >> 3) + 8 * j; const LAS float* s = scr + (8 * c) * 65 + n;
        u32x4 o; o.x = pk2(s[0 * 65], s[1 * 65]); o.y = pk2(s[2 * 65], s[3 * 65]); o.z = pk2(s[4 * 65], s[5 * 65]); o.w = pk2(s[6 * 65], s[7 * 65]);
        *(u32x4*)(WT + (size_t)(dst_row0 + n) * K + k0 + 8 * c) = o; }
    asm volatile("s_waitcnt lgkmcnt(0)" ::: "memory");
}
__device__ __forceinline__ void ln_row(const float* src, const float* g, const float* b, float* dstf, bf16_t* dstb, int lane, int nparts = 0, size_t pstride = 0, const float* res = nullptr) {
    f32x4 v[8]; float s = 0.f;
    if (nparts == 0) {
#pragma unroll
        for (int j = 0; j < 8; ++j) v[j] = *(const f32x4*)(src + (lane + 64 * j) * 4);
    } else {
#pragma unroll
        for (int j = 0; j < 8; ++j) v[j] = *(const f32x4*)(res + (lane + 64 * j) * 4) * ALPHA;
        for (int sl = 0; sl < nparts; ++sl) {
#pragma unroll
            for (int j = 0; j < 8; ++j) v[j] += *(const f32x4*)(src + (size_t)sl * pstride + (lane + 64 * j) * 4);
        }
    }
#pragma unroll
    for (int j = 0; j < 8; ++j) s += (v[j][0] + v[j][1]) + (v[j][2] + v[j][3]);
    const float mean = wave_sum(s) * (1.f / DM); float s2 = 0.f;
#pragma unroll
    for (int j = 0; j < 8; ++j) { v[j] = v[j] - mean; s2 += (v[j][0] * v[j][0] + v[j][1] * v[j][1]) + (v[j][2] * v[j][2] + v[j][3] * v[j][3]); }
    const float rstd = 1.0f / sqrtf(wave_sum(s2) * (1.f / DM) + LN_EPS);
#pragma unroll
    for (int j = 0; j < 8; ++j) { const int c = (lane + 64 * j) * 4; const f32x4 gg = *(const f32x4*)(g + c), bb = *(const f32x4*)(b + c); const f32x4 y = v[j] * rstd * gg + bb;
        if (dstf) *(f32x4*)(dstf + c) = y;
        if (dstb) { u32x2 w; w.x = pk2(y[0], y[1]); w.y = pk2(y[2], y[3]); *(u32x2*)(dstb + c) = w; } }
}

__device__ __forceinline__ void ln_row_b(const bf16_t* src, const float* g, const float* b, float* dstf, bf16_t* dstb, int lane) {
    float v[4][8]; float s = 0.f;
#pragma unroll
    for (int j = 0; j < 4; ++j) { const u32x4 w = *(const u32x4*)(src + (lane + 64 * j) * 8);
        v[j][0] = bflo(w.x); v[j][1] = bfhi(w.x); v[j][2] = bflo(w.y); v[j][3] = bfhi(w.y); v[j][4] = bflo(w.z); v[j][5] = bfhi(w.z); v[j][6] = bflo(w.w); v[j][7] = bfhi(w.w);
#pragma unroll
        for (int e = 0; e < 8; ++e) s += v[j][e]; }
    const float mean = wave_sum(s) * (1.f / DM); float s2 = 0.f;
#pragma unroll
    for (int j = 0; j < 4; ++j)
#pragma unroll
        for (int e = 0; e < 8; ++e) { v[j][e] -= mean; s2 += v[j][e] * v[j][e]; }
    const float rstd = 1.0f / sqrtf(wave_sum(s2) * (1.f / DM) + LN_EPS);
#pragma unroll
    for (int j = 0; j < 4; ++j) { const int c = (lane + 64 * j) * 8; const f32x4 g0 = *(const f32x4*)(g + c), g1 = *(const f32x4*)(g + c + 4), b0 = *(const f32x4*)(b + c), b1 = *(const f32x4*)(b + c + 4);
        const f32x4 y0 = (f32x4){v[j][0], v[j][1], v[j][2], v[j][3]} * rstd * g0 + b0, y1 = (f32x4){v[j][4], v[j][5], v[j][6], v[j][7]} * rstd * g1 + b1;
        if (dstf) { *(f32x4*)(dstf + c) = y0; *(f32x4*)(dstf + c + 4) = y1; }
        if (dstb) store8bf(dstb + c, y0, y1); }
}

__device__ __forceinline__ void prescan_item(const Params& p, LAS unsigned char* lds, int it, int cvt_base) {
    const int tid = threadIdx.x, wid = tid >> 6, lane = tid & 63;
    const int bh = it >> 5, n = it & 31, b = bh >> 4, h = bh & 15, t0 = n * 64, mrow0 = b * SEQ + t0;
    LAS bf16_t* Kb = (LAS bf16_t*)(lds);
    LAS bf16_t* Qb = (LAS bf16_t*)(lds + 17408);
    LAS float* NfT = (LAS float*)(lds + 34816);
    LAS bf16_t* KdT = (LAS bf16_t*)(lds + 52224);
    LAS bf16_t* VbT = (LAS bf16_t*)(lds + 70656);
    LAS bf16_t* KbgT = (LAS bf16_t*)(lds + 89088);
    LAS bf16_t* Tb = (LAS bf16_t*)(lds + 107520);
    LAS float* sm_beta = (LAS float*)(lds + 116736);
    LAS float* sm_gc = sm_beta + 64;
    LAS float* Wc = (LAS float*)(lds + 117248);
    LAS float* OH = (LAS float*)(lds + 123392);
    unsigned char* ps = p.ws + WS_PS + (size_t)it * PS_ITEM;
    const float* bg = (const float*)(p.ws + WS_BG);
    const bf16_t* qkv = (const bf16_t*)(p.ws + WS_QKV);
    const int ri = tid >> 3, c0 = (tid & 7) * 16;
    u32x4 raw[3][4][2];
    {
        const unsigned char* qb = (const unsigned char*)qkv;
#pragma unroll
        for (int j = 0; j < 4; ++j) {
            const int tt = t0 + ri - 3 + j, ttc = tt < 0 ? 0 : tt;
            const unsigned off = (unsigned)(((b * SEQ + ttc) * DQKV + h * 128 + c0) * 2);
#pragma unroll
            for (int sec = 0; sec < 2; ++sec) {
                u32x4 a0 = *(const u32x4*)(qb + (size_t)(off + sec * 4096u)), a1 = *(const u32x4*)(qb + (size_t)(off + sec * 4096u + 16u));
                if (tt < 0) { a0 = (u32x4){0u, 0u, 0u, 0u}; a1 = (u32x4){0u, 0u, 0u, 0u}; }
                raw[sec][j][0] = a0; raw[sec][j][1] = a1;
            }
        }
    }
#pragma unroll
    for (int k = 0; k < 3; ++k) { const int idx = tid + 512 * k, j = idx / 384, rem = idx % 384; Wc[idx] = p.w_conv[(size_t)j * DQKV + (rem >> 7) * DM + h * 128 + (rem & 127)]; }
    if (tid >= 384) OH[tid - 384] = (tid == 384 + 64) ? 1.f : 0.f;
    if (wid == 0) {
        const float be = bg[(size_t)(mrow0 + lane) * 32 + h]; float g = bg[(size_t)(mrow0 + lane) * 32 + 16 + h];
#pragma unroll
        for (int o = 1; o < 64; o <<= 1) { const float t = __shfl_up(g, o); if (lane >= o) g += t; }
        sm_beta[lane] = be; sm_gc[lane] = g;
        if (lane == 63) ((float*)(p.ws + WS_GL))[it] = __expf(g);
    }
    lds_barrier();
    {
        const int i = ri;
        const int isw = i ^ ((tid & 7) << 3);
        const float gci = sm_gc[i], bei = sm_beta[i], gcl = sm_gc[63];
        const float eg = __expf(gci), ekd = __expf(gcl - gci);
#pragma unroll
        for (int sec = 0; sec < 3; ++sec) {
            float vals[16];
            asm volatile("" ::: "memory"); __builtin_amdgcn_sched_barrier(0);
            if (sec == 1) {
                const unsigned char* qb = (const unsigned char*)qkv;
#pragma unroll
                for (int j = 0; j < 4; ++j) { const int tt = t0 + ri - 3 + j, ttc = tt < 0 ? 0 : tt; const unsigned off = (unsigned)(((b * SEQ + ttc) * DQKV + h * 128 + c0) * 2) + 8192u;
                    u32x4 a0 = *(const u32x4*)(qb + (size_t)off), a1 = *(const u32x4*)(qb + (size_t)(off + 16u));
                    if (tt < 0) { a0 = (u32x4){0u, 0u, 0u, 0u}; a1 = (u32x4){0u, 0u, 0u, 0u}; }
                    raw[2][j][0] = a0; raw[2][j][1] = a1; }
                asm volatile("" ::: "memory"); __builtin_amdgcn_sched_barrier(0);
            }
#pragma unroll
            for (int e = 0; e < 16; ++e) vals[e] = 0.f;
#pragma unroll
            for (int j = 0; j < 4; ++j) {
                const LAS float* wp = Wc + (j * 3 + sec) * 128 + c0;
                const f32x4 w0 = *(const LAS f32x4*)wp, w1 = *(const LAS f32x4*)(wp + 4), w2 = *(const LAS f32x4*)(wp + 8), w3 = *(const LAS f32x4*)(wp + 12);
                const u32x4 r0 = raw[sec][j][0], r1 = raw[sec][j][1];
                vals[0] += bflo(r0.x) * w0[0]; vals[1] += bfhi(r0.x) * w0[1]; vals[2] += bflo(r0.y) * w0[2]; vals[3] += bfhi(r0.y) * w0[3];
                vals[4] += bflo(r0.z) * w1[0]; vals[5] += bfhi(r0.z) * w1[1]; vals[6] += bflo(r0.w) * w1[2]; vals[7] += bfhi(r0.w) * w1[3];
                vals[8] += bflo(r1.x) * w2[0]; vals[9] += bfhi(r1.x) * w2[1]; vals[10] += bflo(r1.y) * w2[2]; vals[11] += bfhi(r1.y) * w2[3];
                vals[12] += bflo(r1.z) * w3[0]; vals[13] += bfhi(r1.z) * w3[1]; vals[14] += bflo(r1.w) * w3[2]; vals[15] += bfhi(r1.w) * w3[3];
            }
#pragma unroll
            for (int e = 0; e < 16; ++e) vals[e] = siluf_(vals[e]);
            if (sec < 2) {
                float sq = 0.f;
#pragma unroll
                for (int e = 0; e < 16; ++e) sq += vals[e] * vals[e];
                sq += __shfl_xor(sq, 1); sq += __shfl_xor(sq, 2); sq += __shfl_xor(sq, 4);
                const float rn = (1.0f / sqrtf(sq + RMS_EPS)) * (sec == 0 ? 0.08838834764831845f : 1.0f);
#pragma unroll
                for (int e = 0; e < 16; ++e) vals[e] *= rn;
                unsigned w8[8];
#pragma unroll
                for (int e = 0; e < 8; ++e) w8[e] = pk2(vals[2 * e], vals[2 * e + 1]);
                LAS bf16_t* dst = (sec == 0 ? Qb : Kb) + i * 136 + c0;
                *(LAS u32x4*)dst = (u32x4){w8[0], w8[1], w8[2], w8[3]}; *(LAS u32x4*)(dst + 8) = (u32x4){w8[4], w8[5], w8[6], w8[7]};
                asm volatile("" ::: "memory"); __builtin_amdgcn_sched_barrier(0);
                if (sec == 0) {
#pragma unroll
                    for (int e = 0; e < 8; ++e) w8[e] = pk2(vals[2 * e] * eg, vals[2 * e + 1] * eg);
                    bf16_t* qdp = (bf16_t*)(ps + PS_QD) + i * 128 + c0;
                    *(u32x4*)qdp = (u32x4){w8[0], w8[1], w8[2], w8[3]}; *(u32x4*)(qdp + 8) = (u32x4){w8[4], w8[5], w8[6], w8[7]};
                } else {
#pragma unroll
                    for (int e = 0; e < 16; ++e) KdT[(c0 + e) * 72 + isw] = (bf16_t)(pk2(vals[e] * ekd, 0.f) & 0xffffu);
                    asm volatile("" ::: "memory"); __builtin_amdgcn_sched_barrier(0);
                    const float bk = bei * eg;
#pragma unroll
                    for (int e = 0; e < 16; ++e) KbgT[(c0 + e) * 72 + isw] = (bf16_t)(pk2(bk * vals[e], 0.f) & 0xffffu);
                }
            } else {
#pragma unroll
                for (int e = 0; e < 16; ++e) VbT[(c0 + e) * 72 + isw] = (bf16_t)(pk2(bei * vals[e], 0.f) & 0xffffu);
            }
        }
    }
    lds_barrier();
    {
        const int mat = wid >> 2, mi = wid & 3, fr = lane & 15, fq = lane >> 4;
        LAS bf16_t* Asrc = mat ? Qb : Kb;
        bf16x8 af[4];
#pragma unroll
        for (int s = 0; s < 4; ++s) af[s] = *(const LAS bf16x8*)(Asrc + (16 * mi + fr) * 136 + 32 * s + 8 * fq);
#pragma unroll
        for (int nj = 0; nj < 4; ++nj) {
            f32x4 acc = {0.f, 0.f, 0.f, 0.f};
            if (nj <= mi) {
#pragma unroll
                for (int s = 0; s < 4; ++s) { const bf16x8 bfr = *(const LAS bf16x8*)(Kb + (16 * nj + fr) * 136 + 32 * s + 8 * fq); acc = __builtin_amdgcn_mfma_f32_16x16x32_bf16(af[s], bfr, acc, 0, 0, 0); }
            }
            const int jj = 16 * nj + fr; const float gcj = sm_gc[jj];
            if (mat == 0) { f32x4 o;
#pragma unroll
                for (int j = 0; j < 4; ++j) { const int i = 16 * mi + 4 * fq + j; const float dec = __expf(fminf(sm_gc[i] - gcj, 0.f)); o[j] = (i > jj) ? sm_beta[i] * acc[j] * dec : 0.f; }
                *(LAS f32x4*)(NfT + jj * 68 + 16 * mi + 4 * fq) = o;
            } else {
#pragma unroll
                for (int j = 0; j < 4; ++j) { const int i = 16 * mi + 4 * fq + j; const float dec = __expf(fminf(sm_gc[i] - gcj, 0.f));
                    ((bf16_t*)(ps + PS_AT))[i * 64 + jj] = (bf16_t)(pk2((i >= jj) ? acc[j] * dec : 0.f, 0.f) & 0xffffu); }
            }
        }
    }
    lds_barrier();
    if (tid < 128) {
        const int c = tid >> 1, half = tid & 1; f32x2 r2[16];
        const LAS float* ohp = OH + 64 - c + 4 * half;
#pragma unroll
        for (int li = 0; li < 8; ++li) { r2[2 * li] = (f32x2){ohp[8 * li], ohp[8 * li + 1]}; r2[2 * li + 1] = (f32x2){ohp[8 * li + 2], ohp[8 * li + 3]}; }
        const LAS float* nb = NfT + half * 4;
#pragma unroll
        for (int j = 0; j < 63; ++j) {
            const int jc = j >> 2, lj = jc >> 1, ej = j & 3;
            const float xm = (ej & 2) ? ((ej & 1) ? r2[2 * lj + 1].y : r2[2 * lj + 1].x) : ((ej & 1) ? r2[2 * lj].y : r2[2 * lj].x);
            const float xo = __shfl_xor(xm, 1);
            const float xj = ((jc & 1) == half) ? xm : xo;
            const f32x2 xj2 = {xj, xj};
#pragma unroll
            for (int li = lj; li < 8; ++li) {
                f32x4 nv = *(const LAS f32x4*)(nb + j * 68 + 8 * li);
                if (li == lj) {
                    const int rowb = 4 * (2 * li + half);
#pragma unroll
                    for (int e = 0; e < 4; ++e) nv[e] = (rowb + e > j) ? nv[e] : 0.f;
                }
                r2[2 * li] = r2[2 * li] - (f32x2){nv[0], nv[1]} * xj2; r2[2 * li + 1] = r2[2 * li + 1] - (f32x2){nv[2], nv[3]} * xj2;
            }
            asm volatile("" ::: "memory"); __builtin_amdgcn_sched_barrier(0);
        }
#pragma unroll
        for (int li = 0; li < 8; ++li) { const int rb = 4 * (2 * li + half);
            Tb[(rb) * 72 + c] = (bf16_t)(pk2(r2[2 * li].x, 0.f) & 0xffffu); Tb[(rb + 1) * 72 + c] = (bf16_t)(pk2(r2[2 * li].y, 0.f) & 0xffffu);
            Tb[(rb + 2) * 72 + c] = (bf16_t)(pk2(r2[2 * li + 1].x, 0.f) & 0xffffu); Tb[(rb + 3) * 72 + c] = (bf16_t)(pk2(r2[2 * li + 1].y, 0.f) & 0xffffu); }
    } else if (tid >= 256) {
        const int t2 = tid - 256; bf16_t* kd = (bf16_t*)(ps + PS_KDT);
#pragma unroll
        for (int k = 0; k < 4; ++k) { const int q = t2 + 256 * k, row = q >> 3, cc = q & 7; *(u32x4*)(kd + row * 64 + cc * 8) = *(const LAS u32x4*)(KdT + row * 72 + (cc ^ ((row >> 4) & 7)) * 8); }
        if (cvt_base >= 0) {
            LAS float* scr = (LAS float*)(lds + 124928 + (wid - 4) * 8448);
#pragma unroll 1
            for (int r = 0; r < 2; ++r) { const int t = cvt_base + (wid - 4) * 2 + r;
                if (t < 8192) transpose_item_fast(p.w_up, DM, DFF, (bf16_t*)(p.ws + WS_WUPT), 32 * (t & 255), scr, t >> 8, t & 255, lane);
                else { const int u = t - 8192; transpose_item_fast(p.w_down, DFF, DM, (bf16_t*)(p.ws + WS_WDNT), 32 * (u & 63), scr, u >> 6, u & 63, lane); } }
        }
    }
    lds_barrier();
    {
        const int fr = lane & 15, fq = lane >> 4;
        float* wout = (float*)(ps + PS_W); bf16_t* kout = (bf16_t*)(ps + PS_KCD);
        bf16x8 tf[4][2];
#pragma unroll
        for (int mi = 0; mi < 4; ++mi)
#pragma unroll
            for (int s = 0; s < 2; ++s) tf[mi][s] = *(const LAS bf16x8*)(Tb + (16 * mi + fr) * 72 + 32 * s + 8 * fq);
#pragma unroll
        for (int t = 0; t < 2; ++t) {
            const int ni = wid * 2 + t;
            const bf16x8 b0 = *(const LAS bf16x8*)(VbT + (16 * ni + fr) * 72 + 8 * (fq ^ (ni & 7))), b1 = *(const LAS bf16x8*)(VbT + (16 * ni + fr) * 72 + 8 * ((4 + fq) ^ (ni & 7)));
#pragma unroll
            for (int mi = 0; mi < 4; ++mi) {
                f32x4 acc = {0.f, 0.f, 0.f, 0.f};
                acc = __builtin_amdgcn_mfma_f32_16x16x32_bf16(tf[mi][0], b0, acc, 0, 0, 0);
                acc = __builtin_amdgcn_mfma_f32_16x16x32_bf16(tf[mi][1], b1, acc, 0, 0, 0);
                if (ni < 8) {
                    const int e = 16 * ni + fr; const unsigned wb = (unsigned)((e >> 5) * 1024 + (fq >> 1) * 128 + (fq & 1) * 32 + (e & 31));
                    unsigned* w32 = (unsigned*)wout + wb + (unsigned)((mi >> 1) * 512 + (mi & 1) * 256);
                    w32[0] = pk2(acc[0], acc[1]); w32[64] = pk2(acc[2], acc[3]);
                } else {
                    const unsigned kb_ = (unsigned)(4 * fq * 128 + 16 * (ni - 8) + fr);
#pragma unroll
                    for (int j = 0; j < 4; ++j) kout[kb_ + (unsigned)((16 * mi + j) * 128)] = (bf16_t)(pk2(-acc[j], 0.f) & 0xffffu);
                }
                asm volatile("" ::: "memory"); __builtin_amdgcn_sched_barrier(0);
            }
        }
    }
    lds_barrier();
}

__device__ __forceinline__ bf16x8 packs(const f32x16& x, int s) {
    u32x4 w; w.x = pk2(x[8 * s], x[8 * s + 1]); w.y = pk2(x[8 * s + 2], x[8 * s + 3]); w.z = pk2(x[8 * s + 4], x[8 * s + 5]); w.w = pk2(x[8 * s + 6], x[8 * s + 7]); return __builtin_bit_cast(bf16x8, w);
}
__device__ __forceinline__ bf16x8 ldA2(const LAS bf16_t* p) { const u32x2 a = *(const LAS u32x2*)p, b = *(const LAS u32x2*)(p + 8); u32x4 w = {a.x, a.y, b.x, b.y}; return __builtin_bit_cast(bf16x8, w); }
#define MFMA32(a, b, c) __builtin_amdgcn_mfma_f32_32x32x16_bf16((a), (b), (c), 0, 0, 0)
__device__ __forceinline__ int crow(int reg, int hh) { return (reg & 3) + 8 * (reg >> 2) + 4 * hh; }

__device__ __forceinline__ void scan_stage(const unsigned char* src, LAS unsigned char* bb, int t2) {
    constexpr int O_KCD = 0, O_QD = 16896, O_KDT = 33792, O_AT = 51200;
#pragma unroll
    for (int half = 0; half < 2; ++half) {
        u32x4 stg[7];
#pragma unroll
        for (int k = 0; k < 7; ++k) stg[k] = *(const u32x4*)(src + (size_t)(t2 + 256 * (7 * half + k)) * 16);
#pragma unroll
        for (int k = 0; k < 7; ++k) { const int kk = 7 * half + k, q = t2 + 256 * kk; LAS unsigned char* d_;
            if (kk < 4) d_ = bb + O_KCD + (q >> 4) * 264 + (q & 15) * 16; else if (kk < 8) d_ = bb + O_QD + ((q - 1024) >> 4) * 264 + (q & 15) * 16;
            else if (kk < 12) d_ = bb + O_KDT + ((q - 2048) >> 3) * 136 + (q & 7) * 16; else d_ = bb + O_AT + ((q - 3072) >> 3) * 136 + (q & 7) * 16;
            *(LAS u32x2*)d_ = (u32x2){stg[k].x, stg[k].y}; *(LAS u32x2*)(d_ + 8) = (u32x2){stg[k].z, stg[k].w}; }
    }
}
__device__ __forceinline__ void scan_onorm(const Params& p, const LAS bf16_t* Ob, bf16_t* zrow0, int h, int t2) {
    const int oi = t2 >> 2, oq = t2 & 3; u32x4 ov[4];
#pragma unroll
    for (int k = 0; k < 4; ++k) ov[k] = *(const LAS u32x4*)(Ob + oi * 136 + oq * 32 + 8 * k);
    float ov_f[32];
#pragma unroll
    for (int k = 0; k < 4; ++k) { ov_f[8 * k] = bflo(ov[k].x); ov_f[8 * k + 1] = bfhi(ov[k].x); ov_f[8 * k + 2] = bflo(ov[k].y); ov_f[8 * k + 3] = bfhi(ov[k].y);
        ov_f[8 * k + 4] = bflo(ov[k].z); ov_f[8 * k + 5] = bfhi(ov[k].z); ov_f[8 * k + 6] = bflo(ov[k].w); ov_f[8 * k + 7] = bfhi(ov[k].w); }
    float ss = 0.f;
#pragma unroll
    for (int e = 0; e < 32; ++e) ss += ov_f[e] * ov_f[e];
    ss += __shfl_xor(ss, 1); ss += __shfl_xor(ss, 2);
    const float rstd = 1.0f / sqrtf(ss * (1.f / 128.f) + RMS_EPS);
    bf16_t* zp = zrow0 + (size_t)oi * DM + h * 128 + oq * 32; const float* wn = p.w_onorm + oq * 32;
#pragma unroll
    for (int k = 0; k < 4; ++k) { const u32x4 zw = *(const u32x4*)(zp + 8 * k); const f32x4 w0 = *(const f32x4*)(wn + 8 * k), w1 = *(const f32x4*)(wn + 8 * k + 4);
        u32x4 o; o.x = pk2(ov_f[8 * k] * rstd * w0[0] * bflo(zw.x), ov_f[8 * k + 1] * rstd * w0[1] * bfhi(zw.x));
        o.y = pk2(ov_f[8 * k + 2] * rstd * w0[2] * bflo(zw.y), ov_f[8 * k + 3] * rstd * w0[3] * bfhi(zw.y));
        o.z = pk2(ov_f[8 * k + 4] * rstd * w1[0] * bflo(zw.z), ov_f[8 * k + 5] * rstd * w1[1] * bfhi(zw.z));
        o.w = pk2(ov_f[8 * k + 6] * rstd * w1[2] * bflo(zw.w), ov_f[8 * k + 7] * rstd * w1[3] * bfhi(zw.w));
        *(u32x4*)(zp + 8 * k) = o; }
}
__device__ __forceinline__ void scan_bh(const Params& p, LAS unsigned char* lds, int bh) {
    const int tid = threadIdx.x, wid = __builtin_amdgcn_readfirstlane(tid >> 6), lane = tid & 63, r = lane & 31, hh = lane >> 5;
    const int b = bh >> 4, h = bh & 15;
    constexpr int BUFB = 59904, O_KCD = 0, O_QD = 16896, O_KDT = 33792, O_AT = 51200, OBUFB = 17408;
    LAS unsigned char* Obase = lds + 2 * BUFB;
    const unsigned char* psb = p.ws + WS_PS + (size_t)(bh * 32) * PS_ITEM;
    const float* gl = (const float*)(p.ws + WS_GL) + bh * 32;
    bf16_t* Zb = (bf16_t*)(p.ws + WS_Z) + (size_t)(b * SEQ) * DM;
    if (wid >= 4) scan_stage(psb + PS_KCD, lds, tid - 256);
    lds_barrier();
    if (wid < 4) {
        f32x16 S[4], Vn[2], O[2];
#pragma unroll
        for (int d = 0; d < 4; ++d)
#pragma unroll
            for (int i = 0; i < 16; ++i) S[d][i] = 0.f;
        const int e0 = 32 * wid + r;
        { const unsigned* wsrc = (const unsigned*)(psb + PS_W) + wid * 1024 + lane;
#pragma unroll
            for (int mi = 0; mi < 2; ++mi)
#pragma unroll
                for (int k = 0; k < 8; ++k) { const unsigned u = wsrc[(mi * 8 + k) * 64]; Vn[mi][2 * k] = bflo(u); Vn[mi][2 * k + 1] = bfhi(u); } }
        const float glv = gl[lane & 31];
        for (int n = 0; n < 32; ++n) {
            LAS unsigned char* bb = lds + (n & 1) * BUFB;
            unsigned Wp[16];
            if (n + 1 < 32) { const unsigned* wsrc = (const unsigned*)(psb + (size_t)(n + 1) * PS_ITEM + PS_W) + wid * 1024 + lane;
#pragma unroll
                for (int k = 0; k < 16; ++k) Wp[k] = wsrc[k * 64]; }
            const LAS bf16_t* kcd = (const LAS bf16_t*)(bb + O_KCD); const LAS bf16_t* qdl = (const LAS bf16_t*)(bb + O_QD);
            const LAS bf16_t* kdt = (const LAS bf16_t*)(bb + O_KDT); const LAS bf16_t* att = (const LAS bf16_t*)(bb + O_AT);
            LAS bf16_t* Obuf = (LAS bf16_t*)(Obase + (n & 1) * OBUFB);
#pragma unroll
            for (int mi = 0; mi < 2; ++mi)
#pragma unroll
                for (int i = 0; i < 16; ++i) O[mi][i] = 0.f;
#pragma unroll
            for (int s = 0; s < 8; ++s) {
                bf16x8 ac[4];
#pragma unroll
                for (int mi = 0; mi < 2; ++mi) { ac[mi] = ldA2(kcd + (32 * mi + r) * 132 + 16 * s + 4 * hh); ac[2 + mi] = ldA2(qdl + (32 * mi + r) * 132 + 16 * s + 4 * hh); }
                const bf16x8 sf = packs(S[s >> 1], s & 1);
#pragma unroll
                for (int mi = 0; mi < 2; ++mi) { Vn[mi] = MFMA32(ac[mi], sf, Vn[mi]); O[mi] = MFMA32(ac[2 + mi], sf, O[mi]); }
                __builtin_amdgcn_sched_barrier(0);
            }
            bf16x8 vf[4];
#pragma unroll
            for (int s = 0; s < 4; ++s) vf[s] = packs(Vn[s >> 1], s & 1);
            if (n + 1 < 32) {
#pragma unroll
                for (int mi = 0; mi < 2; ++mi)
#pragma unroll
                    for (int k = 0; k < 8; ++k) { Vn[mi][2 * k] = bflo(Wp[mi * 8 + k]); Vn[mi][2 * k + 1] = bfhi(Wp[mi * 8 + k]); } }
#pragma unroll
            for (int s = 0; s < 2; ++s) O[0] = MFMA32(ldA2(att + (r) * 68 + 16 * s + 4 * hh), vf[s], O[0]);
#pragma unroll
            for (int s = 0; s < 4; ++s) O[1] = MFMA32(ldA2(att + (32 + r) * 68 + 16 * s + 4 * hh), vf[s], O[1]);
            const float g_l = __builtin_bit_cast(float, __builtin_amdgcn_readlane(__builtin_bit_cast(int, glv), n));
#pragma unroll
            for (int d = 0; d < 4; ++d) { S[d] = S[d] * g_l;
#pragma unroll
                for (int s = 0; s < 4; ++s) S[d] = MFMA32(ldA2(kdt + (32 * d + r) * 68 + 16 * s + 4 * hh), vf[s], S[d]); }
#pragma unroll
            for (int mi = 0; mi < 2; ++mi)
#pragma unroll
                for (int i = 0; i < 16; ++i) Obuf[(32 * mi + crow(i, hh)) * 136 + e0] = (bf16_t)(pk2(O[mi][i], 0.f) & 0xffffu);
            lds_barrier();
        }
        float* so = p.out + O_SP + (size_t)bh * 16384;
#pragma unroll
        for (int d = 0; d < 4; ++d)
#pragma unroll
            for (int i = 0; i < 16; ++i) so[(32 * d + crow(i, hh)) * 128 + e0] = S[d][i];
    } else {
        const int t2 = tid - 256, oi = t2 >> 2, oq = t2 & 3;
        u32x4 stg[8], stgb[6], zr[4];
#define SCAN_LD_A(item) do { const unsigned char* s_ = psb + (size_t)(item) * PS_ITEM + PS_KCD; _Pragma("unroll") for (int k = 0; k < 8; ++k) stg[k] = *(const u32x4*)(s_ + (size_t)(t2 + 256 * k) * 16); } while (0)
#define SCAN_LD_B(item) do { const unsigned char* s_ = psb + (size_t)(item) * PS_ITEM + PS_KCD; _Pragma("unroll") for (int k = 0; k < 6; ++k) stgb[k] = *(const u32x4*)(s_ + (size_t)(t2 + 256 * (8 + k)) * 16); } while (0)
#define SCAN_ST_A(bufi) do { LAS unsigned char* bb_ = lds + (bufi) * BUFB; _Pragma("unroll") for (int k = 0; k < 8; ++k) { const int q = t2 + 256 * k; LAS unsigned char* d_; \
            if (k < 4) d_ = bb_ + O_KCD + (q >> 4) * 264 + (q & 15) * 16; else d_ = bb_ + O_QD + ((q - 1024) >> 4) * 264 + (q & 15) * 16; \
            *(LAS u32x2*)d_ = (u32x2){stg[k].x, stg[k].y}; *(LAS u32x2*)(d_ + 8) = (u32x2){stg[k].z, stg[k].w}; } } while (0)
#define SCAN_ST_B(bufi) do { LAS unsigned char* bb_ = lds + (bufi) * BUFB; _Pragma("unroll") for (int k = 0; k < 6; ++k) { const int q = t2 + 256 * (8 + k); LAS unsigned char* d_; \
            if (k < 4) d_ = bb_ + O_KDT + ((q - 2048) >> 3) * 136 + (q & 7) * 16; else d_ = bb_ + O_AT + ((q - 3072) >> 3) * 136 + (q & 7) * 16; \
            *(LAS u32x2*)d_ = (u32x2){stgb[k].x, stgb[k].y}; *(LAS u32x2*)(d_ + 8) = (u32x2){stgb[k].z, stgb[k].w}; } } while (0)
#define SCAN_ZLD(chunk) do { const bf16_t* zp_ = Zb + (size_t)((chunk) * 64 + oi) * DM + h * 128 + oq * 32; _Pragma("unroll") for (int k = 0; k < 4; ++k) zr[k] = *(const u32x4*)(zp_ + 8 * k); } while (0)
#define SCAN_NORM(obuf, chunk) do { const LAS bf16_t* Ob_ = (const LAS bf16_t*)(obuf); u32x4 ov[4]; SCAN_ZLD(chunk); \
            _Pragma("unroll") for (int k = 0; k < 4; ++k) ov[k] = *(const LAS u32x4*)(Ob_ + oi * 136 + oq * 32 + 8 * k); \
            float ss = 0.f; \
            _Pragma("unroll") for (int k = 0; k < 4; ++k) { const float a0 = bflo(ov[k].x), a1 = bfhi(ov[k].x), a2 = bflo(ov[k].y), a3 = bfhi(ov[k].y), a4 = bflo(ov[k].z), a5 = bfhi(ov[k].z), a6 = bflo(ov[k].w), a7 = bfhi(ov[k].w); \
                ss += (a0 * a0 + a1 * a1) + (a2 * a2 + a3 * a3) + (a4 * a4 + a5 * a5) + (a6 * a6 + a7 * a7); } \
            ss += __shfl_xor(ss, 1); ss += __shfl_xor(ss, 2); \
            const float rstd = 1.0f / sqrtf(ss * (1.f / 128.f) + RMS_EPS); \
            bf16_t* zp_ = Zb + (size_t)((chunk) * 64 + oi) * DM + h * 128 + oq * 32; const float* wn = p.w_onorm + oq * 32; \
            _Pragma("unroll") for (int k = 0; k < 4; ++k) { const u32x4 zw = zr[k]; const f32x4 w0 = *(const f32x4*)(wn + 8 * k) * rstd, w1 = *(const f32x4*)(wn + 8 * k + 4) * rstd; \
                u32x4 o; o.x = pk2(bflo(ov[k].x) * w0[0] * bflo(zw.x), bfhi(ov[k].x) * w0[1] * bfhi(zw.x)); \
                o.y = pk2(bflo(ov[k].y) * w0[2] * bflo(zw.y), bfhi(ov[k].y) * w0[3] * bfhi(zw.y)); \
                o.z = pk2(bflo(ov[k].z) * w1[0] * bflo(zw.z), bfhi(ov[k].z) * w1[1] * bfhi(zw.z)); \
                o.w = pk2(bflo(ov[k].w) * w1[2] * bflo(zw.w), bfhi(ov[k].w) * w1[3] * bfhi(zw.w)); \
                *(u32x4*)(zp_ + 8 * k) = o; asm volatile("" ::: "memory"); } } while (0)
        SCAN_LD_A(1); SCAN_LD_B(1);
        for (int n = 0; n < 32; ++n) {
            if (n + 1 < 32) { SCAN_ST_A((n + 1) & 1); SCAN_ST_B((n + 1) & 1); }
            if (n + 2 < 32) { SCAN_LD_A(n + 2); SCAN_LD_B(n + 2); }
            if (n >= 1) SCAN_NORM(Obase + ((n - 1) & 1) * OBUFB, n - 1);
            lds_barrier();
        }
        SCAN_NORM(Obase + OBUFB, 31);
#undef SCAN_LD_A
#undef SCAN_LD_B
#undef SCAN_ST_A
#undef SCAN_ST_B
#undef SCAN_ZLD
#undef SCAN_NORM
    }
    lds_barrier();
}

__device__ __forceinline__ void sample_prefetch(const Params& p, int it, f32x4 (&Sn)[8]) {
    const int tid = threadIdx.x; const float* S0 = p.state_ssm + (size_t)it * 16384 + (tid >> 5) * 1024 + (tid & 31) * 4;
#pragma unroll
    for (int i = 0; i < 8; ++i) Sn[i] = *(const f32x4*)(S0 + i * 128);
}
__device__ __forceinline__ void sample_item(const Params& p, LAS unsigned char* lds, int it, const f32x4 (&Sr)[8]) {
    const int tid = threadIdx.x, wid = tid >> 6, lane = tid & 63;
    const int b = it >> 4, h = it & 15, m = MP + b;
    const int e4 = (tid & 31) * 4, dg = tid >> 5;
    LAS float* vq = (LAS float*)lds;
    LAS float* red = vq + 384;
    LAS float* vnew = vq + 400;
    LAS float* part = vq + 1024;
    const bf16_t* qkv = (const bf16_t*)(p.ws + WS_QKV); const float* bg = (const float*)(p.ws + WS_BG); bf16_t* Zb = (bf16_t*)(p.ws + WS_Z);
    if (tid < 384) { const int sec = tid >> 7, c = tid & 127, col = sec * DM + h * 128 + c;
        float a = bf2f(qkv[(size_t)m * DQKV + col]) * p.w_conv[3 * DQKV + col];
#pragma unroll
        for (int j = 0; j < 3; ++j) a += p.state_conv[(size_t)(b * 3 + j) * DQKV + col] * p.w_conv[j * DQKV + col];
        vq[sec * 128 + c] = siluf_(a); }
    lds_barrier();
    if (wid < 2) { const float a = vq[wid * 128 + lane], c2 = vq[wid * 128 + 64 + lane]; const float s = wave_sum(a * a + c2 * c2); if (lane == 0) red[wid] = s; }
    lds_barrier();
    if (tid < 256) { const int sec = tid >> 7; const float rs = 1.0f / sqrtf(red[sec] + RMS_EPS) * (sec == 0 ? 0.08838834764831845f : 1.0f); vq[tid] *= rs; }
    lds_barrier();
    if (wid == 0) { const float s = wave_sum(vq[lane] * vq[128 + lane] + vq[64 + lane] * vq[192 + lane]); if (lane == 0) red[2] = s; }
    {
        f32x4 ks = {0.f, 0.f, 0.f, 0.f}, qs = {0.f, 0.f, 0.f, 0.f};
#pragma unroll
        for (int i = 0; i < 8; ++i) { const float kk = vq[128 + dg * 8 + i], qq = vq[dg * 8 + i]; ks += Sr[i] * kk; qs += Sr[i] * qq; }
        *(LAS f32x4*)(part + dg * 128 + e4) = ks; *(LAS f32x4*)(part + 2048 + dg * 128 + e4) = qs;
    }
    lds_barrier();
    const float beta = bg[(size_t)m * 32 + h], eg = __expf(bg[(size_t)m * 32 + 16 + h]);
    float o = 0.f;
    if (tid < 128) { float kS = 0.f, qS = 0.f;
#pragma unroll
        for (int d = 0; d < 16; ++d) { kS += part[d * 128 + tid]; qS += part[2048 + d * 128 + tid]; }
        const float vn = beta * (vq[256 + tid] - eg * kS); o = eg * qS + red[2] * vn; vnew[tid] = vn;
        const float s = wave_sum(o * o); if (lane == 0) red[4 + wid] = s; }
    lds_barrier();
    if (tid < 128) { const float rstd = 1.0f / sqrtf((red[4] + red[5]) * (1.f / 128.f) + RMS_EPS); bf16_t* zp = Zb + (size_t)m * DM + h * 128 + tid;
        *zp = (bf16_t)(pk2(o * rstd * p.w_onorm[tid] * bf2f(*zp), 0.f) & 0xffffu); }
    {
        float* So = p.out + O_SS + (size_t)it * 16384; const f32x4 vn4 = *(const LAS f32x4*)(vnew + e4);
#pragma unroll
        for (int i = 0; i < 8; ++i) { const float kk = vq[128 + dg * 8 + i]; *(f32x4*)(So + (dg * 8 + i) * 128 + e4) = Sr[i] * eg + vn4 * kk; }
    }
    lds_barrier();
}

__device__ __forceinline__ void mixerA_item(const Params& p, LAS unsigned char* lds, int it) {
    const int tid = threadIdx.x, wid = tid >> 6, lane = tid & 63, fr = lane & 15, fq = lane >> 4;
    const int b = it >> 8, c = (it >> 4) & 15, g = it & 15, m0 = b * SEQ + c * 128;
    LAS bf16_t* Wt = (LAS bf16_t*)lds;
    LAS bf16_t* VnT = (LAS bf16_t*)(lds + 34816);
    LAS float* st = (LAS float*)(lds + 68608);
    const float* vstat = (const float*)(p.ws + WS_VSTAT); const bf16_t* VA = (const bf16_t*)(p.ws + WS_VA); bf16_t* U = (bf16_t*)(p.ws + WS_U);
    if (tid < 128) { const float* sp = vstat + (size_t)(m0 + tid) * 64; float s = 0.f, s2 = 0.f;
#pragma unroll
        for (int k = 0; k < 16; ++k) { const f32x4 v = *(const f32x4*)(sp + 4 * k); s += v[0] + v[2]; s2 += v[1] + v[3]; }
        const float mu = s * (1.f / DM), var = fmaxf(s2 * (1.f / DM) - mu * mu, 0.f); st[2 * tid] = mu; st[2 * tid + 1] = 1.0f / sqrtf(var + LN_EPS); }
    {
        const float* ws_ = p.w_s + (size_t)g * 16384;
#pragma unroll
        for (int k = 0; k < 8; ++k) { const int idx = tid + 512 * k, t = idx >> 5, s4 = (idx & 31) * 4; f32x4 w = *(const f32x4*)(ws_ + t * 128 + s4);
#pragma unroll
            for (int e = 0; e < 4; ++e) if (s4 + e > t) w[e] = 0.f;
            *(LAS u32x2*)(Wt + t * 136 + s4) = (u32x2){pk2(w[0], w[1]), pk2(w[2], w[3])}; }
    }
    lds_barrier();
#pragma unroll
    for (int k = 0; k < 4; ++k) {
        const int q = tid + 512 * k, l = q & 63, grp = q >> 6, s = (grp >> 2) * 16 + (l >> 2), dc = (grp & 3) * 4 + (l & 3);
        const u32x4 raw = *(const u32x4*)(VA + (size_t)(m0 + s) * DM + g * 128 + dc * 8);
        const float mu = st[2 * s], rs = st[2 * s + 1];
        const float* gp = p.ln_v_g + g * 128 + dc * 8; const float* bp = p.ln_v_b + g * 128 + dc * 8;
        const f32x4 g0 = *(const f32x4*)gp, g1 = *(const f32x4*)(gp + 4), b0 = *(const f32x4*)bp, b1 = *(const f32x4*)(bp + 4);
        float v[8] = {bflo(raw.x), bfhi(raw.x), bflo(raw.y), bfhi(raw.y), bflo(raw.z), bfhi(raw.z), bflo(raw.w), bfhi(raw.w)};
#pragma unroll
        for (int e = 0; e < 8; ++e) { const float gg = e < 4 ? g0[e & 3] : g1[e & 3], bb = e < 4 ? b0[e & 3] : b1[e & 3]; const float y = (v[e] - mu) * rs * gg + bb;
            VnT[(dc * 8 + e) * 132 + s] = (bf16_t)(pk2(y, 0.f) & 0xffffu); }
    }
    lds_barrier();
    {
        bf16x8 wf[4];
        const int nks = ((16 * wid + 15) >> 5) + 1;
#pragma unroll
        for (int s = 0; s < 4; ++s) wf[s] = *(const LAS bf16x8*)(Wt + (16 * wid + fr) * 136 + 32 * s + 8 * fq);
        const int t = 16 * wid + fr; const float bs = p.b_s[g * 128 + t];
#pragma unroll
        for (int mb = 0; mb < 8; ++mb) {
            f32x4 acc = {0.f, 0.f, 0.f, 0.f};
#pragma unroll
            for (int s = 0; s < 4; ++s) if (s < nks) {
                const LAS bf16_t* vp = VnT + (16 * mb + fr) * 132 + 32 * s + 8 * fq; const u32x2 a0 = *(const LAS u32x2*)vp, a1 = *(const LAS u32x2*)(vp + 4);
                u32x4 aw = {a0.x, a0.y, a1.x, a1.y};
                acc = __builtin_amdgcn_mfma_f32_16x16x32_bf16(__builtin_bit_cast(bf16x8, aw), wf[s], acc, 0, 0, 0); }
            bf16_t* up = U + (size_t)(m0 + t) * DM + g * 128 + 16 * mb + 4 * fq; const u32x2 uw = *(const u32x2*)up;
            u32x2 o; o.x = pk2(bflo(uw.x) * (acc[0] + bs), bfhi(uw.x) * (acc[1] + bs)); o.y = pk2(bflo(uw.y) * (acc[2] + bs), bfhi(uw.y) * (acc[3] + bs));
            *(u32x2*)up = o;
        }
    }
    lds_barrier();
}

#define XB_TMO      128
#define XB_XCNT(j)  (256  + 64 * (j))
#define XB_XSUB(j)  (1280 + 64 * (j))
#define XB_XGEN(j)  (2304 + 64 * (j))
#define XB_TOP      3328
#define XB_TOPGEN   3392
#define XCD_BAR_WORDS 3456
#define XB_SPIN_CAP (1u << 18)
__device__ __forceinline__ unsigned xb_ld(unsigned* p)              { return __hip_atomic_load(p, __ATOMIC_RELAXED, __HIP_MEMORY_SCOPE_AGENT); }
__device__ __forceinline__ unsigned xb_add(unsigned* p, unsigned v) { return __hip_atomic_fetch_add(p, v, __ATOMIC_RELAXED, __HIP_MEMORY_SCOPE_AGENT); }
__device__ __forceinline__ unsigned xb_xcc_id() { return (unsigned)__builtin_amdgcn_s_getreg((3 << 11) | 20) & 0xFu; }
#define XB_SPIN(cond, bar) do { unsigned _sp = 0; while (cond) { __builtin_amdgcn_s_sleep(1); \
    if ((++_sp & 255u) == 0u) { if (xb_ld(&(bar)[XB_TMO])) break; if (_sp > XB_SPIN_CAP) { atomicAdd(&(bar)[XB_TMO], 1u); break; } } } } while (0)
struct XcdBarrier { unsigned* bar; unsigned x; volatile LAS unsigned* st; };
__device__ __forceinline__ XcdBarrier xcd_barrier_post(unsigned* bar, volatile LAS unsigned* st) {
    XcdBarrier b; b.bar = bar; b.x = xb_xcc_id(); b.st = st;
    if (threadIdx.x == 0) (void)xb_add(&bar[XB_XCNT(b.x)], 1u);
    return b;
}
__device__ __forceinline__ void xcd_barrier_complete(unsigned* bar, unsigned x, unsigned& nloc, unsigned& nx) {
    const unsigned G = gridDim.x * gridDim.y * gridDim.z;
    unsigned sum, cnt, mine, sp = 0u;
    for (;;) {
        sum = 0u; cnt = 0u; mine = 0u;
#pragma unroll
        for (unsigned j = 0; j < 16; ++j) { const unsigned c = xb_ld(&bar[XB_XCNT(j)]); sum += c; cnt += (c > 0u) ? 1u : 0u; mine = (j == x) ? c : mine; }
        if (sum == G) break;
        __builtin_amdgcn_s_sleep(1);
        if ((++sp & 255u) == 0u) { if (xb_ld(&bar[XB_TMO])) break; if (sp > XB_SPIN_CAP) { atomicAdd(&bar[XB_TMO], 1u); break; } }
    }
    nloc = mine > 0u ? mine : 1u; nx = cnt > 0u ? cnt : 1u;
}
__device__ __forceinline__ void xcd_barrier(const XcdBarrier& b) {
    asm volatile("s_waitcnt vmcnt(0)" ::: "memory");
    __syncthreads();
    if (threadIdx.x == 0) {
        unsigned* bar = b.bar;
        __builtin_amdgcn_s_waitcnt(0);
        unsigned nloc = b.st[0], nx = b.st[1];
        if (nloc == 0u) { xcd_barrier_complete(bar, b.x, nloc, nx); b.st[0] = nloc; b.st[1] = nx; }
        const unsigned old = xb_add(&bar[XB_XSUB(b.x)], 1u);
        const unsigned gen = old / nloc;
        if (old + 1u == (gen + 1u) * nloc) {
            __builtin_amdgcn_fence(__ATOMIC_RELEASE, "agent");
            asm volatile("s_waitcnt vmcnt(0)" ::: "memory");
            const unsigned og = xb_add(&bar[XB_TOP], 1u);
            const unsigned tg = og / nx;
            if (og + 1u == (tg + 1u) * nx) xb_add(&bar[XB_TOPGEN], 1u);
            else XB_SPIN(xb_ld(&bar[XB_TOPGEN]) == tg, bar);
            __builtin_amdgcn_fence(__ATOMIC_ACQUIRE, "agent");
            xb_add(&bar[XB_XGEN(b.x)], 1u);
            asm volatile("s_waitcnt vmcnt(0)" ::: "memory");
        } else {
            XB_SPIN(xb_ld(&bar[XB_XGEN(b.x)]) == gen, bar);
            __builtin_amdgcn_fence(__ATOMIC_ACQUIRE, "agent");
            asm volatile("s_waitcnt vmcnt(0)" ::: "memory");
        }
    }
    __syncthreads();
}

__device__ __forceinline__ unsigned char* opq(unsigned char* q) { asm volatile("" : "+s"(q)); return q; }
__global__ void __launch_bounds__(512, 2) mega_fwd(Params p) {
    extern __shared__ __attribute__((aligned(16))) unsigned char smem[];
    LAS unsigned char* lds = (LAS unsigned char*)smem;
    cg::grid_group grid = cg::this_grid();
    const int tid = threadIdx.x, wid = tid >> 6, lane = tid & 63, G = gridDim.x, blk = blockIdx.x;
    unsigned char* ws = p.ws;
#ifndef PHMASK
#define PHMASK 0x3ff
#endif
#define IN(k) (((PHMASK >> (k)) & 1) && p.ph_lo <= (k) && (k) < p.ph_hi)
#define SEAM(k) do { if (IN(k) && IN((k) + 1)) { if (p.coop == 2) grid.sync(); else xcd_barrier(xbar); } } while (0)
    volatile LAS unsigned* xst = (volatile LAS unsigned*)(lds + 160000);
    if (tid < 2) xst[tid] = 0u;
    __syncthreads();
    const XcdBarrier xbar = xcd_barrier_post((unsigned*)ws, xst);

    if (IN(0)) { unsigned char* ws = opq(p.ws);
        LAS float* scr = (LAS float*)(lds + wid * 16640);
        const int gw = blk * 8 + wid, NGW = G * 8;
        constexpr int I_IN = 32 * 256, I_BG = 32, I_P = 32 * 32;
        const int NIT = I_IN + I_BG + (G == 256 ? 0 : 3 * I_P);
        for (int it = gw; it < NIT; it += NGW) {
            int r = it;
            if (r < I_IN) { const int kb = r >> 8, nb = r & 255; const int n0 = nb < 192 ? 64 * nb : 12320 + 64 * (nb - 192); const int drow = nb < 192 ? n0 : n0 - 32;
                transpose64(p.w_in, 16416, (bf16_t*)(ws + WS_W1T), DM, 64 * kb, n0, drow, scr, lane); continue; }
            r -= I_IN;
            if (r < I_BG) { transpose_item(p.w_in, DM, 16416, (bf16_t*)(ws + WS_W1T), 16384, scr, r, 384, lane); continue; }
            r -= I_BG;
            if (r < I_P) { transpose64(p.w_proj_a, DM, (bf16_t*)(ws + WS_WPT), DM, 64 * (r >> 5), 64 * (r & 31), 64 * (r & 31), scr, lane); continue; } r -= I_P;
            if (r < I_P) { transpose64(p.w_proj_b, DM, (bf16_t*)(ws + WS_WPT), DM, 64 * (r >> 5), 64 * (r & 31), DM + 64 * (r & 31), scr, lane); continue; } r -= I_P;
            transpose64(p.w_o, DM, (bf16_t*)(ws + WS_WOT), DM, 64 * (r >> 5), 64 * (r & 31), 64 * (r & 31), scr, lane);
        }
        bf16_t* xb = (bf16_t*)(ws + WS_XB);
#pragma unroll 4
        for (size_t q = (size_t)blk * 512 + tid; q < (size_t)MPAD * DM / 8; q += (size_t)G * 512) {
            const size_t e = q * 8; const int row = (int)(e / DM);
            u32x4 o = {0u, 0u, 0u, 0u};
            if (row < MT) { const float* src = row < MP ? p.x_prompt + e : p.x_sample + (e - (size_t)MP * DM); const f32x4 a = *(const f32x4*)src, c2 = *(const f32x4*)(src + 4);
                o.x = pk2(a[0], a[1]); o.y = pk2(a[2], a[3]); o.z = pk2(c2[0], c2[1]); o.w = pk2(c2[2], c2[3]); }
            *(u32x4*)(xb + e) = o;
        }
        bf16_t* w1 = (bf16_t*)(ws + WS_W1T);
        for (size_t q = (size_t)blk * 512 + tid; q < (size_t)224 * DM / 8; q += (size_t)G * 512) *(u32x4*)(w1 + (size_t)16416 * DM + q * 8) = (u32x4){0u, 0u, 0u, 0u};
    }
    SEAM(0);
    if (IN(1)) { unsigned char* ws = opq(p.ws);
        pg8::Gemm g{(const bf16_t*)(ws + WS_XB), (const bf16_t*)(ws + WS_W1T), MPAD, N1, DM};
        pg8::Sched S; S.init(33, 65, G, blk, 0, 0, 0, 32);
        Epi1 E{ws, p.a_log, p.dt_bias};
        pg8::gemm_phase<Epi1>(lds, g, S, E);
        if (G == 256) { const int rem = (33 * 65) % 256;
            if (blk >= rem) { LAS float* scr = (LAS float*)(lds + wid * 16640); const int nw = (256 - rem) * 8;
                for (int t = (blk - rem) * 8 + wid; t < 3 * 1024; t += nw) { const int m = t >> 10, r = t & 1023;
                    if (m == 0) transpose64(p.w_proj_a, DM, (bf16_t*)(ws + WS_WPT), DM, 64 * (r >> 5), 64 * (r & 31), 64 * (r & 31), scr, lane);
                    else if (m == 1) transpose64(p.w_proj_b, DM, (bf16_t*)(ws + WS_WPT), DM, 64 * (r >> 5), 64 * (r & 31), DM + 64 * (r & 31), scr, lane);
                    else transpose64(p.w_o, DM, (bf16_t*)(ws + WS_WOT), DM, 64 * (r >> 5), 64 * (r & 31), 64 * (r & 31), scr, lane); } } }
    }
    SEAM(1);
    if (IN(2)) { unsigned char* ws = opq(p.ws);
        { int k = 0; for (int it = blk; it < 2048; it += G, ++k) prescan_item(p, lds, it, (G == 256 && k < 8) ? blk * 64 + k * 8 : -1); }
    }
    SEAM(2);
    if (IN(3)) { unsigned char* ws = opq(p.ws);
        const bool split = G > 64;
        if (blk < 64) { for (int bh = blk; bh < 64; bh += (split ? 64 : G)) scan_bh(p, lds, bh); }
        if (!split || blk >= 64) {
            const int oi = split ? blk - 64 : blk, on = split ? G - 64 : G;
            const bf16_t* qkv = (const bf16_t*)(ws + WS_QKV);
            for (int q = oi * 512 + tid; q < NBP * 3 * DQKV / 4; q += on * 512) { const int e = q * 4, col = e % DQKV, j = (e / DQKV) % 3, bb = e / (3 * DQKV);
                const u32x2 r = *(const u32x2*)(qkv + (size_t)(bb * SEQ + SEQ - 3 + j) * DQKV + col); *(f32x4*)(p.out + O_CP + e) = (f32x4){bflo(r.x), bfhi(r.x), bflo(r.y), bfhi(r.y)}; }
#pragma unroll 2
            for (int q = oi * 512 + tid; q < MS * 3 * DQKV / 4; q += on * 512) { const int e = q * 4, col = e % DQKV, j = (e / DQKV) % 3, bb = e / (3 * DQKV); f32x4 v;
                if (j < 2) v = *(const f32x4*)(p.state_conv + (size_t)(bb * 3 + j + 1) * DQKV + col);
                else { const u32x2 r = *(const u32x2*)(qkv + (size_t)(MP + bb) * DQKV + col); v = (f32x4){bflo(r.x), bfhi(r.x), bflo(r.y), bfhi(r.y)}; }
                *(f32x4*)(p.out + O_CS + e) = v; }
            const float* vstat = (const float*)(ws + WS_VSTAT); const bf16_t* VA = (const bf16_t*)(ws + WS_VA); bf16_t* U = (bf16_t*)(ws + WS_U);
            for (int row = oi * 8 + wid; row < MS; row += on * 8) { const int m = MP + row;
                const f32x2 st = lane < 32 ? *(const f32x2*)(vstat + (size_t)m * 64 + 2 * lane) : (f32x2){0.f, 0.f};
                const float s = wave_sum(st.x), s2 = wave_sum(st.y);
                const float mu = s * (1.f / DM), var = fmaxf(s2 * (1.f / DM) - mu * mu, 0.f), rs = 1.0f / sqrtf(var + LN_EPS);
#pragma unroll
                for (int k = 0; k < 8; ++k) { const int cc = (lane + 64 * k) * 4, gg = cc >> 7;
                    const u32x2 va = *(const u32x2*)(VA + (size_t)m * DM + cc); const f32x4 lg = *(const f32x4*)(p.ln_v_g + cc), lb = *(const f32x4*)(p.ln_v_b + cc);
                    f32x4 vn = {bflo(va.x), bfhi(va.x), bflo(va.y), bfhi(va.y)}; vn = (vn - mu) * rs * lg + lb;
                    *(f32x4*)(p.out + O_GV + (size_t)row * DM + cc) = vn;
                    const float w00 = p.w_s[(size_t)gg * 16384], bs0 = p.b_s[gg * 128];
                    bf16_t* up = U + (size_t)m * DM + cc; const u32x2 uw = *(const u32x2*)up;
                    *(u32x2*)up = (u32x2){pk2(bflo(uw.x) * (w00 * vn[0] + bs0), bfhi(uw.x) * (w00 * vn[1] + bs0)), pk2(bflo(uw.y) * (w00 * vn[2] + bs0), bfhi(uw.y) * (w00 * vn[3] + bs0))}; }
            }
        }
        {
            unsigned* qctr = (unsigned*)ws + 3584;
            volatile LAS int* slot = (volatile LAS int*)(lds + 160016);
            if (tid == 0) { slot[0] = (int)__hip_atomic_fetch_add(qctr, 1u, __ATOMIC_RELAXED, __HIP_MEMORY_SCOPE_AGENT); slot[1] = (int)__hip_atomic_fetch_add(qctr, 1u, __ATOMIC_RELAXED, __HIP_MEMORY_SCOPE_AGENT); }
            lds_barrier();
            int cur = slot[0], nxt = slot[1], par = 0;
            f32x4 Sr[8], Sn[8];
            if (cur < 2048) sample_prefetch(p, cur, Sr);
            lds_barrier();
            while (cur < 3072) {
                unsigned tick = 0u;
                if (tid == 0) tick = __hip_atomic_fetch_add(qctr, 1u, __ATOMIC_RELAXED, __HIP_MEMORY_SCOPE_AGENT);
                if (nxt < 2048) sample_prefetch(p, nxt, Sn);
                if (cur < 2048) sample_item(p, lds, cur, Sr); else mixerA_item(p, lds, cur - 2048);
                if (tid == 0) slot[par] = (int)tick;
                lds_barrier();
                const int nn = slot[par]; par ^= 1;
#pragma unroll
                for (int i = 0; i < 8; ++i) Sr[i] = Sn[i];
                cur = nxt; nxt = nn;
            }
        }
    }
    SEAM(3);
    if (IN(4)) { unsigned char* ws = opq(p.ws);
        pg8::Gemm g{(const bf16_t*)(ws + WS_U), (const bf16_t*)(ws + WS_WPT), 2 * MPAD, 2 * DM, DM};
        { pg8::Sched S; S.init(32, 8, G, blk, 1, 33, 8, 32); Epi4 E{ws}; pg8::gemm_phase<Epi4>(lds, g, S, E); }
        { pg8::Sched S; S.init_split(32, 8, 16, 2, G, blk, 1, 33, 8); EpiS4 E{ws}; pg8::gemm_phase<EpiS4>(lds, g, S, E); }
    }
    SEAM(4);
    if (IN(5)) { unsigned char* ws = opq(p.ws);
        {
            const float* part = (const float*)(ws + WS_PART); bf16_t* MB = (bf16_t*)(ws + WS_MB);
            for (int q = blk * 512 + tid; q < MS * DM / 4; q += G * 512) { f32x4 v = *(const f32x4*)(part + 4 * q);
#pragma unroll 8
                for (int sl = 1; sl < 32; ++sl) v += *(const f32x4*)(part + (size_t)sl * MS * DM + 4 * q);
                *(u32x2*)(MB + (size_t)MP * DM + 4 * q) = (u32x2){pk2(v[0], v[1]), pk2(v[2], v[3])}; }
        }
        pg8::Gemm g{(const bf16_t*)(ws + WS_MB), (const bf16_t*)(ws + WS_WOT), MPAD, DM, DM};
        { pg8::Sched S; S.init(32, 8, G, blk, 0, 0, 0, 32); EpiRes E{p.x_prompt, nullptr, (bf16_t*)(ws + WS_R1)}; pg8::gemm_phase<EpiRes>(lds, g, S, E); }
        xcd_barrier(xbar);
        { pg8::Sched S; S.init_split(32, 8, 16, 2, G, blk, 0, 0, 0); EpiSPart E{(float*)(ws + WS_PART), DM}; pg8::gemm_phase<EpiSPart>(lds, g, S, E); }
        if (G == 256) {
            const int gw2 = (blk & 127) * 8 + wid, nrow = blk >= 128 ? 5 : 3, base = blk >= 128 ? 0 : 5120;
            for (int j = 0; j < nrow; ++j) { const int m = base + gw2 + 1024 * j;
                ln_row_b((const bf16_t*)(ws + WS_R1) + (size_t)m * DM, p.ln1_g, p.ln1_b, nullptr, (bf16_t*)(ws + WS_X1B) + (size_t)m * DM, lane); }
        }
    }
    SEAM(5);
    if (IN(6)) { unsigned char* ws = opq(p.ws);
        const int gw = blk * 8 + wid, NGW = G * 8;
        for (int m = (G == 256 ? MP + gw : gw); m < MT; m += NGW) {
            if (m < MP) { if (G != 256) ln_row_b((const bf16_t*)(ws + WS_R1) + (size_t)m * DM, p.ln1_g, p.ln1_b, nullptr, (bf16_t*)(ws + WS_X1B) + (size_t)m * DM, lane); }
            else ln_row((const float*)(ws + WS_PART) + (size_t)(m - MP) * DM, p.ln1_g, p.ln1_b, (float*)(ws + WS_X1) + (size_t)m * DM, (bf16_t*)(ws + WS_X1B) + (size_t)m * DM, lane, 16, (size_t)MS * DM, p.x_sample + (size_t)(m - MP) * DM);
        }
        LAS float* scr = (LAS float*)(lds + wid * 16640);
        if (G != 256) for (int it = gw; it < 8192; it += NGW) {
            if (it < 4096) transpose64(p.w_up, DFF, (bf16_t*)(ws + WS_WUPT), DM, 64 * (it >> 7), 64 * (it & 127), 64 * (it & 127), scr, lane);
            else { const int r = it - 4096; transpose64(p.w_down, DM, (bf16_t*)(ws + WS_WDNT), DFF, 64 * (r >> 5), 64 * (r & 31), 64 * (r & 31), scr, lane); }
        }
    }
    SEAM(6);
    if (IN(7)) { unsigned char* ws = opq(p.ws);
        pg8::Gemm g{(const bf16_t*)(ws + WS_X1B), (const bf16_t*)(ws + WS_WUPT), MPAD, DFF, DM};
        { pg8::Sched S; S.init(32, 32, G, blk, 0, 0, 0, 32); Epi7 E{(bf16_t*)(ws + WS_H)}; pg8::gemm_phase<Epi7>(lds, g, S, E); }
        { pg8::Sched S; S.init_split(32, 32, 8, 4, G, blk, 0, 0, 0); EpiSPart E{(float*)(ws + WS_PART), DFF}; pg8::gemm_phase<EpiSPart>(lds, g, S, E); }
    }
    SEAM(7);
    if (IN(8)) { unsigned char* ws = opq(p.ws);
        {
            const float* part = (const float*)(ws + WS_PART); bf16_t* H = (bf16_t*)(ws + WS_H);
            for (int q = blk * 512 + tid; q < MS * DFF / 4; q += G * 512) { f32x4 v = *(const f32x4*)(part + 4 * q);
#pragma unroll
                for (int sl = 1; sl < 8; ++sl) v += *(const f32x4*)(part + (size_t)sl * MS * DFF + 4 * q);
#pragma unroll
                for (int e = 0; e < 4; ++e) { const float a = fmaxf(v[e], 0.f); v[e] = a * a; }
                *(u32x2*)(H + (size_t)MP * DFF + 4 * q) = (u32x2){pk2(v[0], v[1]), pk2(v[2], v[3])}; }
        }
        pg8::Gemm g{(const bf16_t*)(ws + WS_H), (const bf16_t*)(ws + WS_WDNT), MPAD, DM, DFF};
        { pg8::Sched S; S.init(32, 8, G, blk, 0, 0, 0, 128); EpiRes E{nullptr, (const bf16_t*)(ws + WS_X1B), (bf16_t*)(ws + WS_R2)}; pg8::gemm_phase<EpiRes>(lds, g, S, E); }
        xcd_barrier(xbar);
        if (G == 256) {
            { pg8::Sched S; S.init_split(32, 8, 16, 8, G, blk, 0, 0, 0); EpiSPart E{(float*)(ws + WS_PART), DM}; pg8::gemm_phase<EpiSPart>(lds, g, S, E); }
            const int gw2 = (blk & 127) * 8 + wid, nrow = blk >= 128 ? 5 : 3, base = blk >= 128 ? 0 : 5120;
            for (int j = 0; j < nrow; ++j) { const int m = base + gw2 + 1024 * j;
                ln_row_b((const bf16_t*)(ws + WS_R2) + (size_t)m * DM, p.ln2_g, p.ln2_b, p.out + (size_t)m * DM, nullptr, lane); }
        } else { pg8::Sched S; S.init_split(32, 8, 32, 4, G, blk, 0, 0, 0); EpiSPart E{(float*)(ws + WS_PART), DM}; pg8::gemm_phase<EpiSPart>(lds, g, S, E); }
    }
    SEAM(8);
    if (IN(9)) { unsigned char* ws = opq(p.ws);
        const int gw = blk * 8 + wid, NGW = G * 8;
        for (int m = (G == 256 ? MP + gw : gw); m < MT; m += NGW) {
            if (m < MP) ln_row_b((const bf16_t*)(ws + WS_R2) + (size_t)m * DM, p.ln2_g, p.ln2_b, p.out + (size_t)m * DM, nullptr, lane);
            else ln_row((const float*)(ws + WS_PART) + (size_t)(m - MP) * DM, p.ln2_g, p.ln2_b, p.out + (size_t)m * DM, nullptr, lane, G == 256 ? 16 : 32, (size_t)MS * DM, (const float*)(ws + WS_X1) + (size_t)m * DM);
        }
    }
#undef IN
#undef SEAM
}

extern "C" void kernel_launch(void* const* d_in, const int* in_sizes, int n_in, void* d_out, int out_size, void* d_ws, size_t ws_size, hipStream_t stream) {
    static int grid = 0;
    if (grid == 0) {
        int dev = 0, cus = 0, per_cu = 0;
        if (n_in != 22 || ws_size < WS_END) { fprintf(stderr, "kernel_launch: unexpected inputs (n_in %d, ws %zu)\n", n_in, ws_size); grid = -1; return; }
        hipGetDevice(&dev);
        hipDeviceGetAttribute(&cus, hipDeviceAttributeMultiprocessorCount, dev);
        if (hipFuncSetAttribute((const void*)mega_fwd, hipFuncAttributeMaxDynamicSharedMemorySize, LDS_BYTES) != hipSuccess) { fprintf(stderr, "kernel_launch: hipFuncSetAttribute failed\n"); grid = -1; return; }
        if (hipOccupancyMaxActiveBlocksPerMultiprocessor(&per_cu, (const void*)mega_fwd, 512, LDS_BYTES) != hipSuccess || per_cu < 1) { fprintf(stderr, "kernel_launch: occupancy query says %d\n", per_cu); per_cu = 1; }
        (void)hipGetLastError();
        grid = cus;
    }
    if (grid < 0) return;
    Params p{};
    const float** pp = (const float**)&p;
    for (int i = 0; i < 22; ++i) pp[i] = (const float*)d_in[i];
    p.out = (float*)d_out; p.ws = (unsigned char*)d_ws; p.ph_lo = 0; p.ph_hi = 10; p.coop = 1; p.pad = 0;
    if (hipMemsetAsync(d_ws, 0, 16384, stream) != hipSuccess) { fprintf(stderr, "kernel_launch: memset failed\n"); return; }
    void* args[] = {&p};
    hipError_t e = hipLaunchCooperativeKernel((const void*)mega_fwd, dim3(grid), dim3(512), args, LDS_BYTES, stream);
    if (e != hipSuccess) fprintf(stderr, "cooperative launch failed: %s (grid %d)\n", hipGetErrorString(e), grid);
}
```

```cpp
#include <hip/hip_runtime.h>
#include <hip/hip_cooperative_groups.h>
#include <cstdio>
#include <cstdint>
namespace cg = cooperative_groups;

#define LAS __attribute__((address_space(3)))
typedef unsigned short bf16_t;
typedef short bf16x8 __attribute__((ext_vector_type(8)));
typedef short s16x4 __attribute__((ext_vector_type(4)));
typedef float f32x2 __attribute__((ext_vector_type(2)));
typedef float f32x4 __attribute__((ext_vector_type(4)));
typedef float f32x16 __attribute__((ext_vector_type(16)));
typedef unsigned u32x2 __attribute__((ext_vector_type(2)));
typedef unsigned u32x4 __attribute__((ext_vector_type(4)));

constexpr int DM = 2048, SEQ = 2048, NBP = 4, MP = 8192, MS = 128, MT = 8320, MPAD = 8448;
constexpr int N1 = 16640, DFF = 8192, DQKV = 6144;
constexpr float ALPHA = 1.189207115002721f, LN_EPS = 1e-5f, RMS_EPS = 1e-6f;
constexpr int LDS_BYTES = 160768;
constexpr size_t MiB = 1u << 20;
constexpr size_t WS_BG = 1 * MiB, WS_VSTAT = 3 * MiB, WS_GL = 6 * MiB;
constexpr size_t WS_WPT = 8 * MiB, WS_WOT = 24 * MiB, WS_U = 32 * MiB, WS_Z = 65 * MiB, WS_VA = 98 * MiB, WS_QKV = 131 * MiB;
constexpr size_t WS_GA = 230 * MiB, WS_GB = 263 * MiB, WS_W1T = 296 * MiB, WS_XB = 361 * MiB, WS_PS = 296 * MiB;
constexpr size_t WS_MTMP = 296 * MiB, WS_MB = 362 * MiB, WS_R1 = 395 * MiB, WS_H = 296 * MiB;
constexpr size_t WS_WUPT = 440 * MiB, WS_WDNT = 472 * MiB,
     WS_X1 = 131 * MiB, WS_X1B = 197 * MiB, WS_R2 = 230 * MiB;
constexpr size_t WS_PART = 98 * MiB;
constexpr size_t WS_END = 504 * MiB;
constexpr int PS_ITEM = 73728;
constexpr int PS_W = 0, PS_KCD = 16384, PS_QD = 32768, PS_KDT = 49152, PS_AT = 65536;
constexpr size_t O_YP = 0, O_YS = 16777216, O_CP = 17039360, O_SP = 17113088, O_GV = 18161664, O_CS = 18423808, O_SS = 20783104;

__device__ __forceinline__ unsigned pk2(float lo, float hi) { typedef __bf16 b2 __attribute__((ext_vector_type(2))); f32x2 v = {lo, hi}; b2 b = __builtin_convertvector(v, b2); return __builtin_bit_cast(unsigned, b); }
__device__ __forceinline__ float bf2f(unsigned short b) { return __uint_as_float((unsigned)b << 16); }
__device__ __forceinline__ float bflo(unsigned w) { return __uint_as_float(w << 16); }
__device__ __forceinline__ float bfhi(unsigned w) { return __uint_as_float(w & 0xffff0000u); }
__device__ __forceinline__ float sigmoidf_(float x) { return 1.0f / (1.0f + __expf(-x)); }
__device__ __forceinline__ float siluf_(float x) { return x / (1.0f + __expf(-x)); }
__device__ __forceinline__ float wave_sum(float v) {
#pragma unroll
    for (int o = 1; o < 64; o <<= 1) v += __shfl_xor(v, o);
    return v;
}
__device__ __forceinline__ void lds_barrier() { asm volatile("s_waitcnt lgkmcnt(0)\n\ts_barrier" ::: "memory"); }
__device__ __forceinline__ f32x2 gelu_pk(f32x2 v) {
    const f32x2 av = __builtin_elementwise_abs(v), d = av * 0.2316418882f + 1.0f;
    f32x2 t; t.x = __builtin_amdgcn_rcpf(d.x); t.y = __builtin_amdgcn_rcpf(d.y);
    f32x2 q = t * 0.5307027145f + (-0.7265760135f); q = q * t + 0.7107068705f; q = q * t + (-0.142248368f); q = q * t + 0.127414796f; q = q * t;
    const f32x2 s = (v * v) * (-0.72134752044f);
    f32x2 e; e.x = __builtin_amdgcn_exp2f(s.x); e.y = __builtin_amdgcn_exp2f(s.y);
    const f32x2 m = v * (q * e), r = v - m;
    f32x2 o; o.x = v.x < 0.f ? m.x : r.x; o.y = v.y < 0.f ? m.y : r.y; return o;
}
__device__ __forceinline__ f32x4 gelu4(f32x4 v) { f32x2 a = gelu_pk((f32x2){v[0], v[1]}), b = gelu_pk((f32x2){v[2], v[3]}); return (f32x4){a.x, a.y, b.x, b.y}; }

namespace pg8 {
constexpr int BM = 256, BK = 64, HALF = 128, HTB = HALF * BK * 2, STAGE_BYTES = 8 * HTB, NXCD = 8, WGM = 8;
__host__ __device__ __forceinline__ int lds_byte(int r, int c) { const int st = (r >> 4) * 2 + (c >> 5), rr = r & 15, cc = c & 31, ob = rr * 64 + cc * 2; return st * 1024 + (ob ^ (((ob >> 9) & 1) << 5)); }
__host__ __device__ __forceinline__ void stage_rc(int b, int& R, int& C) { const int st = b / 1024, sb = b % 1024, swz = sb ^ (((sb >> 9) & 1) << 5); R = (st >> 1) * 16 + swz / 64; C = (st & 1) * 32 + (swz % 64) / 2; }
__host__ __device__ __forceinline__ int perm32(int rho) { const int n = rho >> 4, i = rho & 15; return 8 * (i >> 2) + 4 * n + (i & 3); }
struct Unit { int pm, pn, k0, nt; };
struct Gemm { const bf16_t* A; const bf16_t* Bt; int M, N, K; };
struct Sched {
    int nM, nN, nwg, G, c, pairs, offM, offN, ntK;
    int split, sM, sNt, sSl, sNtK;
    __device__ void init(int nM_, int nN_, int G_, int c_, int pairs_, int offM_, int offN_, int ntK_) { nM = nM_; nN = nN_; nwg = nM * nN; G = G_; c = c_; pairs = pairs_; offM = offM_; offN = offN_; ntK = ntK_; split = 0; sM = 0; sNt = 0; sSl = 0; sNtK = 0; }
    __device__ void init_split(int sM_, int nN_, int slices, int ntk_slice, int G_, int c_, int pairs_, int offM_, int offN_) { init(1, nN_, G_, c_, pairs_, offM_, offN_, ntk_slice); split = 1; sM = sM_; sNt = nN_; sSl = slices; sNtK = ntk_slice; nwg = nN_ * slices * (pairs_ ? 2 : 1); }
    __device__ bool next(int i, Unit& u) const {
        if (split) {
            const int L = i * G + c; if (L >= nwg) return false;
            const int sl = L % sSl, r = L / sSl, pn = r % sNt, which = r / sNt;
            u.pm = sM + which * offM; u.pn = pn + which * offN; u.k0 = sl * sNtK; u.nt = sNtK; return true;
        }
        const int j = pairs ? (i >> 1) : i, which = pairs ? (i & 1) : 0;
        const long L = (long)j * G + c; if (L >= nwg) return false;
        int wgid = (int)L; { const int q = nwg / NXCD, r = nwg % NXCD, xcd = wgid % NXCD, off = wgid / NXCD; wgid = (xcd < r ? xcd * (q + 1) : r * (q + 1) + (xcd - r) * q) + off; }
        const int nig = WGM * nN, gid = wgid / nig, fm = gid * WGM, gsz = (nM - fm) < WGM ? (nM - fm) : WGM;
        u.pm = fm + ((wgid % nig) % gsz) + which * offM; u.pn = (wgid % nig) / gsz + which * offN; u.k0 = 0; u.nt = ntK; return true;
    }
};

template <class Epi>
__device__ __forceinline__ void gemm_phase(LAS unsigned char* lds, const Gemm g, const Sched& S, const Epi& E) {
    const int tid = threadIdx.x, wid = __builtin_amdgcn_readfirstlane(tid >> 6), lane = tid & 63, wr = wid >> 2, wc = wid & 3, fr = lane & 15, fq = lane >> 4;
    const int K = g.K;
    unsigned voffA[2], voffB[2];
#pragma unroll
    for (int i = 0; i < 2; ++i) { int R, C; stage_rc(tid * 16 + i * 8192, R, C); const int Rb = (R & ~31) + perm32(R & 31);
        voffA[i] = (unsigned)(R * K + C) * 2u; voffB[i] = (unsigned)(Rb * K + C) * 2u; }
    const size_t kstep = (size_t)(BK * 2);
    const size_t hstep = (size_t)HALF * K * 2;
    const size_t tstep = 2 * hstep;
    const unsigned ldsw = (unsigned)wid * 1024u;
    const int aoff = lds_byte(wr * 64 + fr, fq * 8), boff = lds_byte(wc * 32 + fr, fq * 8);
#define PG8_SA(b, h) (((b) * 2 + (h)) * HTB)
#define PG8_SB(b, h) ((4 + (b) * 2 + (h)) * HTB)
#define PG8_STAGE(bufoff, gbase, voff) do { _Pragma("unroll") for (int _i = 0; _i < 2; ++_i) \
        __builtin_amdgcn_global_load_lds((const unsigned*)((const char*)(gbase) + (voff)[_i]), (LAS unsigned*)(lds + (bufoff) + ldsw + _i * 8192), 16, 0, 0); } while (0)
#define PG8_LDA(dst, b, h) do { _Pragma("unroll") for (int m = 0; m < 4; ++m) _Pragma("unroll") for (int k = 0; k < 2; ++k) dst[m][k] = *(const LAS bf16x8*)(lds + PG8_SA(b, h) + aoff + m * 2048 + k * 1024); } while (0)
#define PG8_LDB(dst, b, h) do { _Pragma("unroll") for (int n = 0; n < 2; ++n) _Pragma("unroll") for (int k = 0; k < 2; ++k) dst[n][k] = *(const LAS bf16x8*)(lds + PG8_SB(b, h) + boff + n * 2048 + k * 1024); } while (0)
#define PG8_MMA(ai, bj, At, Bt) do { __builtin_amdgcn_s_setprio(1); _Pragma("unroll") for (int m = 0; m < 4; ++m) _Pragma("unroll") for (int n = 0; n < 2; ++n) _Pragma("unroll") for (int k = 0; k < 2; ++k) \
        acc[ai][bj][m][n] = __builtin_amdgcn_mfma_f32_16x16x32_bf16(Bt[n][k], At[m][k], acc[ai][bj][m][n], 0, 0, 0); __builtin_amdgcn_s_setprio(0); } while (0)
#define PG8_WAIT_V(n) asm volatile("s_waitcnt vmcnt(" #n ")" ::: "memory")
#define PG8_WAIT_L(n) asm volatile("s_waitcnt lgkmcnt(" #n ")" ::: "memory")
#define PG8_BAR __builtin_amdgcn_s_barrier()
#define PG8_SCHED __builtin_amdgcn_sched_barrier(0)
    Unit cur, nxt; int ui = 0;
    if (!S.next(0, cur)) return;
    f32x4 acc[2][2][4][2];
#pragma unroll
    for (int a = 0; a < 2; ++a)
#pragma unroll
        for (int b = 0; b < 2; ++b)
#pragma unroll
            for (int m = 0; m < 4; ++m)
#pragma unroll
                for (int n = 0; n < 2; ++n) acc[a][b][m][n] = (f32x4){0.f, 0.f, 0.f, 0.f};
    bf16x8 At[4][2], B0[2][2], B1[2][2];
    const char* cA = (const char*)g.A + (size_t)cur.pm * tstep + (size_t)cur.k0 * kstep; const char* cB = (const char*)g.Bt + (size_t)cur.pn * tstep + (size_t)cur.k0 * kstep;
    PG8_STAGE(PG8_SB(0, 0), cB, voffB); PG8_STAGE(PG8_SB(0, 1), cB + hstep, voffB); PG8_STAGE(PG8_SA(0, 0), cA, voffA); PG8_STAGE(PG8_SA(0, 1), cA + hstep, voffA);
    if (wr == 1) PG8_BAR;
    PG8_WAIT_V(2); PG8_BAR;
    PG8_STAGE(PG8_SB(1, 0), cB + kstep, voffB); PG8_STAGE(PG8_SA(1, 0), cA + kstep, voffA); PG8_STAGE(PG8_SB(1, 1), cB + hstep + kstep, voffB);
    PG8_WAIT_V(6); PG8_BAR;
    for (;;) {
        const bool has_next = S.next(ui + 1, nxt);
        const char* nA = has_next ? (const char*)g.A + (size_t)nxt.pm * tstep + (size_t)nxt.k0 * kstep : cA; const char* nB = has_next ? (const char*)g.Bt + (size_t)nxt.pn * tstep + (size_t)nxt.k0 * kstep : cB;
        const int nt = cur.nt;
        for (int t = 0; t < nt; t += 2) {
            const bool last = (t == nt - 2);
            const char* a1 = cA + (size_t)(t + 1) * kstep;
            const char* a2 = last ? nA : cA + (size_t)(t + 2) * kstep; const char* b2 = last ? nB : cB + (size_t)(t + 2) * kstep;
            const char* a3 = a2 + kstep; const char* b3 = b2 + kstep;
            PG8_LDB(B0, 0, 0); PG8_LDB(B1, 0, 1); PG8_SCHED; PG8_LDA(At, 0, 0); PG8_STAGE(PG8_SA(1, 1), a1 + hstep, voffA);
            PG8_WAIT_V(8); PG8_WAIT_L(0); PG8_BAR; PG8_MMA(0, 0, At, B0); PG8_MMA(0, 1, At, B1); PG8_BAR; PG8_SCHED;
            PG8_LDA(At, 0, 1); PG8_STAGE(PG8_SB(0, 0), b2, voffB); PG8_STAGE(PG8_SB(0, 1), b2 + hstep, voffB); PG8_STAGE(PG8_SA(0, 0), a2, voffA);
            PG8_WAIT_V(8); PG8_WAIT_L(0); PG8_BAR; PG8_MMA(1, 0, At, B0); PG8_MMA(1, 1, At, B1); PG8_BAR; PG8_SCHED;
            PG8_LDB(B0, 1, 0); PG8_LDB(B1, 1, 1); PG8_SCHED; PG8_LDA(At, 1, 0); PG8_STAGE(PG8_SA(0, 1), a2 + hstep, voffA);
            PG8_WAIT_V(8); PG8_WAIT_L(0); PG8_BAR; PG8_MMA(0, 0, At, B0); PG8_MMA(0, 1, At, B1); PG8_BAR; PG8_SCHED;
            PG8_LDA(At, 1, 1); PG8_STAGE(PG8_SB(1, 0), b3, voffB); PG8_STAGE(PG8_SB(1, 1), b3 + hstep, voffB); PG8_STAGE(PG8_SA(1, 0), a3, voffA);
            PG8_WAIT_V(8); PG8_WAIT_L(0); PG8_BAR; PG8_MMA(1, 0, At, B0); PG8_MMA(1, 1, At, B1); PG8_BAR; PG8_SCHED;
        }
        if (wr == 0) PG8_BAR;
        E(acc, cur, wr, wc, fr, fq);
        if (!has_next) break;
#pragma unroll
        for (int a = 0; a < 2; ++a)
#pragma unroll
            for (int b = 0; b < 2; ++b)
#pragma unroll
                for (int m = 0; m < 4; ++m)
#pragma unroll
                    for (int n = 0; n < 2; ++n) acc[a][b][m][n] = (f32x4){0.f, 0.f, 0.f, 0.f};
        cur = nxt; cA = nA; cB = nB; ++ui;
        if (wr == 1) PG8_BAR;
    }
    PG8_WAIT_V(0);
    PG8_BAR;
#undef PG8_SA
#undef PG8_SB
#undef PG8_STAGE
#undef PG8_LDA
#undef PG8_LDB
#undef PG8_MMA
#undef PG8_WAIT_V
#undef PG8_WAIT_L
#undef PG8_BAR
#undef PG8_SCHED
}
}
using pg8::Unit;
typedef f32x4 Acc[2][2][4][2];

struct Params {
    const float *x_prompt, *x_sample, *state_conv, *state_ssm, *w_in, *w_s, *b_s, *ln_v_g, *ln_v_b, *w_conv, *a_log, *dt_bias, *w_onorm,
                *w_proj_a, *w_proj_b, *w_o, *ln1_g, *ln1_b, *w_up, *w_down, *ln2_g, *ln2_b;
    float* out; unsigned char* ws; int ph_lo, ph_hi, coop, pad;
};

__device__ __forceinline__ void store8bf(bf16_t* p, f32x4 v0, f32x4 v1) { u32x4 w; w.x = pk2(v0[0], v0[1]); w.y = pk2(v0[2], v0[3]); w.z = pk2(v1[0], v1[1]); w.w = pk2(v1[2], v1[3]); *(u32x4*)p = w; }

struct Epi1 {
    unsigned char* ws; const float* a_log; const float* dt_bias;
    __device__ __forceinline__ void operator()(const Acc& acc, const Unit& u, int wr, int wc, int fr, int fq) const {
        const int pn = u.pn; const int row0 = u.pm * 256 + wr * 64 + fr; const int cl = wc * 32 + 8 * fq;
        if (pn < 64) {
            int act, ld, cb; size_t boff;
            if (pn < 8) { boff = WS_U; act = 1; ld = DM; cb = pn * 256; }
            else if (pn < 16) { boff = WS_VA; act = 1; ld = DM; cb = (pn - 8) * 256; }
            else if (pn < 40) { boff = WS_QKV; act = 0; ld = DQKV; cb = (pn - 16) * 256; }
            else if (pn < 48) { boff = WS_Z; act = 2; ld = DM; cb = (pn - 40) * 256; }
            else if (pn < 56) { boff = WS_GA; act = 3; ld = DM; cb = (pn - 48) * 256; }
            else { boff = WS_GB; act = 3; ld = DM; cb = (pn - 56) * 256; }
            const bool stats = (pn >= 8 && pn < 16);
            bf16_t* base = (bf16_t*)(ws + boff);
            float* vstat = (float*)(ws + WS_VSTAT) + ((pn - 8) * 4 + wc) * 2;
            const unsigned off0 = (unsigned)(row0 * ld + cb + cl);
#pragma unroll
            for (int ai = 0; ai < 2; ++ai)
#pragma unroll
                for (int m = 0; m < 4; ++m) {
                    const unsigned off = off0 + (unsigned)((ai * 128 + m * 16) * ld); float s = 0.f, s2 = 0.f;
#pragma unroll
                    for (int bj = 0; bj < 2; ++bj) { f32x4 v0 = acc[ai][bj][m][0], v1 = acc[ai][bj][m][1];
                        if (act == 1) { v0 = gelu4(v0); v1 = gelu4(v1); }
                        else if (act >= 2) {
#pragma unroll
                            for (int e = 0; e < 4; ++e) { const float t0 = sigmoidf_(v0[e]), t1 = sigmoidf_(v1[e]); v0[e] = act == 2 ? v0[e] * t0 : t0; v1[e] = act == 2 ? v1[e] * t1 : t1; } }
                        if (stats) {
#pragma unroll
                            for (int e = 0; e < 4; ++e) { s += v0[e] + v1[e]; s2 += v0[e] * v0[e] + v1[e] * v1[e]; } }
                        store8bf(base + off + bj * 128, v0, v1); }
                    if (stats) { s += __shfl_xor(s, 16); s += __shfl_xor(s, 32); s2 += __shfl_xor(s2, 16); s2 += __shfl_xor(s2, 32);
                        if (fq == 0) { float* sp = vstat + (unsigned)((row0 + ai * 128 + m * 16) * 64); sp[0] = s; sp[1] = s2; } }
                    __builtin_amdgcn_sched_barrier(0);
                }
        } else if (wc == 0) {
            float* bg = (float*)(ws + WS_BG);
            const unsigned boff0 = (unsigned)(row0 * 32 + 8 * fq);
            if (fq < 2) {
#pragma unroll
                for (int ai = 0; ai < 2; ++ai)
#pragma unroll
                    for (int m = 0; m < 4; ++m) {
#pragma unroll
                        for (int n = 0; n < 2; ++n) { const f32x4 v = acc[ai][0][m][n]; f32x4 o;
#pragma unroll
                            for (int e = 0; e < 4; ++e) o[e] = sigmoidf_(v[e]);
                            *(f32x4*)(bg + boff0 + (unsigned)((ai * 128 + m * 16) * 32 + 4 * n)) = o; }
                        __builtin_amdgcn_sched_barrier(0); }
            } else {
                const int h0 = 8 * (fq - 2);
#pragma unroll
                for (int n = 0; n < 2; ++n) {
                    f32x4 na = *(const f32x4*)(a_log + h0 + 4 * n); const f32x4 db = *(const f32x4*)(dt_bias + h0 + 4 * n);
#pragma unroll
                    for (int e = 0; e < 4; ++e) na[e] = -__expf(na[e]);
#pragma unroll
                    for (int ai = 0; ai < 2; ++ai)
#pragma unroll
                        for (int m = 0; m < 4; ++m) { const f32x4 v = acc[ai][0][m][n]; f32x4 o;
#pragma unroll
                            for (int e = 0; e < 4; ++e) { const float xx = v[e] + db[e]; const float sp = xx > 20.f ? xx : __logf(1.0f + __expf(xx)); o[e] = na[e] * sp; }
                            *(f32x4*)(bg + boff0 + (unsigned)((ai * 128 + m * 16) * 32 + 4 * n)) = o;
                            __builtin_amdgcn_sched_barrier(0); }
                }
            }
        }
    }
};
struct Epi4 {
    unsigned char* ws;
    __device__ __forceinline__ void operator()(const Acc& acc, const Unit& u, int wr, int wc, int fr, int fq) const {
        const int which = u.pm >= 33 ? 1 : 0; const int pm = u.pm - 33 * which, pn = u.pn - 8 * which;
        const bf16_t* gate = (const bf16_t*)(ws + (which ? WS_GB : WS_GA)); bf16_t* mt = (bf16_t*)(ws + WS_MTMP); bf16_t* mb = (bf16_t*)(ws + WS_MB);
        const int row0 = pm * 256 + wr * 64 + fr, col0 = pn * 256 + wc * 32 + 8 * fq;
#pragma unroll
        for (int ai = 0; ai < 2; ++ai)
#pragma unroll
            for (int m = 0; m < 4; ++m) { const size_t off = (size_t)(row0 + ai * 128 + m * 16) * DM + col0;
#pragma unroll
                for (int bj = 0; bj < 2; ++bj) { const u32x4 gw = *(const u32x4*)(gate + off + bj * 128);
                    f32x4 g0 = {bflo(gw.x), bfhi(gw.x), bflo(gw.y), bfhi(gw.y)}, g1 = {bflo(gw.z), bfhi(gw.z), bflo(gw.w), bfhi(gw.w)};
                    f32x4 v0 = acc[ai][bj][m][0] * g0, v1 = acc[ai][bj][m][1] * g1;
                    if (which == 0) store8bf(mt + off + bj * 128, v0, v1);
                    else { const u32x4 tw = *(const u32x4*)(mt + off + bj * 128); v0 += (f32x4){bflo(tw.x), bfhi(tw.x), bflo(tw.y), bfhi(tw.y)}; v1 += (f32x4){bflo(tw.z), bfhi(tw.z), bflo(tw.w), bfhi(tw.w)}; store8bf(mb + off + bj * 128, v0, v1); } } }
    }
};
struct EpiRes {
    __device__ __forceinline__ void done(const Unit&) const {}
    const float* resf; const bf16_t* resb; bf16_t* out;
    __device__ __forceinline__ void operator()(const Acc& acc, const Unit& u, int wr, int wc, int fr, int fq) const {
        const int row0 = u.pm * 256 + wr * 64 + fr, col0 = u.pn * 256 + wc * 32 + 8 * fq;
#pragma unroll
        for (int ai = 0; ai < 2; ++ai)
#pragma unroll
            for (int m = 0; m < 4; ++m) { const size_t off = (size_t)(row0 + ai * 128 + m * 16) * DM + col0;
#pragma unroll
                for (int bj = 0; bj < 2; ++bj) { f32x4 r0, r1;
                    if (resf) { r0 = *(const f32x4*)(resf + off + bj * 128); r1 = *(const f32x4*)(resf + off + bj * 128 + 4); }
                    else { const u32x4 w = *(const u32x4*)(resb + off + bj * 128); r0 = (f32x4){bflo(w.x), bfhi(w.x), bflo(w.y), bfhi(w.y)}; r1 = (f32x4){bflo(w.z), bfhi(w.z), bflo(w.w), bfhi(w.w)}; }
                    store8bf(out + off + bj * 128, r0 * ALPHA + acc[ai][bj][m][0], r1 * ALPHA + acc[ai][bj][m][1]); } }
    }
};
struct Epi7 {
    bf16_t* H;
    __device__ __forceinline__ void operator()(const Acc& acc, const Unit& u, int wr, int wc, int fr, int fq) const {
        const int row0 = u.pm * 256 + wr * 64 + fr, col0 = u.pn * 256 + wc * 32 + 8 * fq;
#pragma unroll
        for (int ai = 0; ai < 2; ++ai)
#pragma unroll
            for (int m = 0; m < 4; ++m) { const size_t off = (size_t)(row0 + ai * 128 + m * 16) * DFF + col0;
#pragma unroll
                for (int bj = 0; bj < 2; ++bj) { f32x4 v0 = acc[ai][bj][m][0], v1 = acc[ai][bj][m][1];
#pragma unroll
                    for (int e = 0; e < 4; ++e) { const float a = fmaxf(v0[e], 0.f), b = fmaxf(v1[e], 0.f); v0[e] = a * a; v1[e] = b * b; }
                    store8bf(H + off + bj * 128, v0, v1); } }
    }
};

struct EpiSPart {
    float* part; int ld;
    __device__ __forceinline__ void operator()(const Acc& acc, const Unit& u, int wr, int wc, int fr, int fq) const {
        const int r0 = wr * 64 + fr, col0 = u.pn * 256 + wc * 32 + 8 * fq; float* base = part + (size_t)(u.k0 / u.nt) * 128 * ld;
#pragma unroll
        for (int m = 0; m < 4; ++m) { float* op = base + (size_t)(r0 + m * 16) * ld + col0;
#pragma unroll
            for (int bj = 0; bj < 2; ++bj) { *(f32x4*)(op + bj * 128) = acc[0][bj][m][0]; *(f32x4*)(op + bj * 128 + 4) = acc[0][bj][m][1]; } }
    }
};
struct EpiS4 {
    unsigned char* ws;
    __device__ __forceinline__ void operator()(const Acc& acc, const Unit& u, int wr, int wc, int fr, int fq) const {
        const int which = u.pm >= 33 ? 1 : 0; const int pn = u.pn - 8 * which;
        const bf16_t* gate = (const bf16_t*)(ws + (which ? WS_GB : WS_GA)); float* base = (float*)(ws + WS_PART) + (size_t)(which * 16 + u.k0 / u.nt) * 128 * DM;
        const int r0 = wr * 64 + fr, col0 = pn * 256 + wc * 32 + 8 * fq;
#pragma unroll
        for (int m = 0; m < 4; ++m) { const int r = r0 + m * 16;
#pragma unroll
            for (int bj = 0; bj < 2; ++bj) { const u32x4 gw = *(const u32x4*)(gate + (size_t)(MP + r) * DM + col0 + bj * 128);
                const f32x4 g0 = {bflo(gw.x), bfhi(gw.x), bflo(gw.y), bfhi(gw.y)}, g1 = {bflo(gw.z), bfhi(gw.z), bflo(gw.w), bfhi(gw.w)};
                float* op = base + (size_t)r * DM + col0 + bj * 128; *(f32x4*)op = acc[0][bj][m][0] * g0; *(f32x4*)(op + 4) = acc[0][bj][m][1] * g1; } }
    }
};

__device__ __forceinline__ void transpose_item(const float* W, int K, int N, bf16_t* WT, int dst_row0, LAS float* scr, int kb, int nb, int lane) {
    const int k0 = 64 * kb, n0 = 32 * nb;
#pragma unroll 8
    for (int i = 0; i < 32; ++i) { const int kk = 2 * i + (lane >> 5); scr[kk * 33 + (lane & 31)] = W[(size_t)(k0 + kk) * N + n0 + (lane & 31)]; }
    asm volatile("s_waitcnt lgkmcnt(0)" ::: "memory");
    const int c = lane & 7;
#pragma unroll
    for (int j = 0; j < 4; ++j) { const int n = (lane >> 3) + 8 * j; const LAS float* s = scr + (8 * c) * 33 + n;
        u32x4 o; o.x = pk2(s[0 * 33], s[1 * 33]); o.y = pk2(s[2 * 33], s[3 * 33]); o.z = pk2(s[4 * 33], s[5 * 33]); o.w = pk2(s[6 * 33], s[7 * 33]);
        *(u32x4*)(WT + (size_t)(dst_row0 + n) * K + k0 + 8 * c) = o; }
    asm volatile("s_waitcnt lgkmcnt(0)" ::: "memory");
}
__device__ __forceinline__ void transpose_item_fast(const float* W, int K, int N, bf16_t* WT, int dst_row0, LAS float* scr, int kb, int nb, int lane) {
    const int k0 = 64 * kb, n0 = 32 * nb;
    float v[32];
    const float* src = W + (size_t)(k0 + (lane >> 5)) * N + n0 + (lane & 31);
#pragma unroll
    for (int i = 0; i < 32; ++i) v[i] = src[(size_t)(2 * i) * N];
#pragma unroll
    for (int i = 0; i < 32; ++i) scr[(2 * i + (lane >> 5)) * 33 + (lane & 31)] = v[i];
    asm volatile("s_waitcnt lgkmcnt(0)" ::: "memory");
    const int c = lane & 7;
#pragma unroll
    for (int j = 0; j < 4; ++j) { const int n = (lane >> 3) + 8 * j; const LAS float* s = scr + (8 * c) * 33 + n;
        u32x4 o; o.x = pk2(s[0 * 33], s[1 * 33]); o.y = pk2(s[2 * 33], s[3 * 33]); o.z = pk2(s[4 * 33], s[5 * 33]); o.w = pk2(s[6 * 33], s[7 * 33]);
        *(u32x4*)(WT + (size_t)(dst_row0 + n) * K + k0 + 8 * c) = o; }
    asm volatile("s_waitcnt lgkmcnt(0)" ::: "memory");
}
__device__ __forceinline__ void transpose64(const float* W, int N, bf16_t* WT, int K, int k0, int n0, int dst_row0, LAS float* scr, int lane) {
    f32x4 v[16];
    const float* src = W + (size_t)(k0 + (lane >> 4)) * N + n0 + (lane & 15) * 4;
#pragma unroll
    for (int t = 0; t < 16; ++t) v[t] = *(const f32x4*)(src + (size_t)(4 * t) * N);
#pragma unroll
    for (int t = 0; t < 16; ++t) { LAS float* d = scr + (4 * t + (lane >> 4)) * 65 + (lane & 15) * 4; d[0] = v[t][0]; d[1] = v[t][1]; d[2] = v[t][2]; d[3] = v[t][3]; }
    asm volatile("s_waitcnt lgkmcnt(0)" ::: "memory");
    const int c = lane & 7;
#pragma unroll
    for (int j = 0; j < 8; ++j) { const int n = (lane >> 3) + 8 * j; const LAS float* s = scr + (8 * c) * 65 + n;
        u32x4 o; o.x = pk2(s[0 * 65], s[1 * 65]); o.y = pk2(s[2 * 65], s[3 * 65]); o.z = pk2(s[4 * 65], s[5 * 65]); o.w = pk2(s[6 * 65], s[7 * 65]);
        *(u32x4*)(WT + (size_t)(dst_row0 + n) * K + k0 + 8 * c) = o; }
    asm volatile("s_waitcnt lgkmcnt(0)" ::: "memory");
}
__device__ __forceinline__ void ln_row(const float* src, const float* g, const float* b, float* dstf, bf16_t* dstb, int lane, int nparts = 0, size_t pstride = 0, const float* res = nullptr) {
    f32x4 v[8]; float s = 0.f;
    if (nparts == 0) {
#pragma unroll
        for (int j = 0; j < 8; ++j) v[j] = *(const f32x4*)(src + (lane + 64 * j) * 4);
    } else {
#pragma unroll
        for (int j = 0; j < 8; ++j) v[j] = *(const f32x4*)(res + (lane + 64 * j) * 4) * ALPHA;
        for (int sl = 0; sl < nparts; ++sl) {
#pragma unroll
            for (int j = 0; j < 8; ++j) v[j] += *(const f32x4*)(src + (size_t)sl * pstride + (lane + 64 * j) * 4);
        }
    }
#pragma unroll
    for (int j = 0; j < 8; ++j) s += (v[j][0] + v[j][1]) + (v[j][2] + v[j][3]);
    const float mean = wave_sum(s) * (1.f / DM); float s2 = 0.f;
#pragma unroll
    for (int j = 0; j < 8; ++j) { v[j] = v[j] - mean; s2 += (v[j][0] * v[j][0] + v[j][1] * v[j][1]) + (v[j][2] * v[j][2] + v[j][3] * v[j][3]); }
    const float rstd = 1.0f / sqrtf(wave_sum(s2) * (1.f / DM) + LN_EPS);
#pragma unroll
    for (int j = 0; j < 8; ++j) { const int c = (lane + 64 * j) * 4; const f32x4 gg = *(const f32x4*)(g + c), bb = *(const f32x4*)(b + c); const f32x4 y = v[j] * rstd * gg + bb;
        if (dstf) *(f32x4*)(dstf + c) = y;
        if (dstb) { u32x2 w; w.x = pk2(y[0], y[1]); w.y = pk2(y[2], y[3]); *(u32x2*)(dstb + c) = w; } }
}

__device__ __forceinline__ void ln_row_b(const bf16_t* src, const float* g, const float* b, float* dstf, bf16_t* dstb, int lane) {
    float v[4][8]; float s = 0.f;
#pragma unroll
    for (int j = 0; j < 4; ++j) { const u32x4 w = *(const u32x4*)(src + (lane + 64 * j) * 8);
        v[j][0] = bflo(w.x); v[j][1] = bfhi(w.x); v[j][2] = bflo(w.y); v[j][3] = bfhi(w.y); v[j][4] = bflo(w.z); v[j][5] = bfhi(w.z); v[j][6] = bflo(w.w); v[j][7] = bfhi(w.w);
#pragma unroll
        for (int e = 0; e < 8; ++e) s += v[j][e]; }
    const float mean = wave_sum(s) * (1.f / DM); float s2 = 0.f;
#pragma unroll
    for (int j = 0; j < 4; ++j)
#pragma unroll
        for (int e = 0; e < 8; ++e) { v[j][e] -= mean; s2 += v[j][e] * v[j][e]; }
    const float rstd = 1.0f / sqrtf(wave_sum(s2) * (1.f / DM) + LN_EPS);
#pragma unroll
    for (int j = 0; j < 4; ++j) { const int c = (lane + 64 * j) * 8; const f32x4 g0 = *(const f32x4*)(g + c), g1 = *(const f32x4*)(g + c + 4), b0 = *(const f32x4*)(b + c), b1 = *(const f32x4*)(b + c + 4);
        const f32x4 y0 = (f32x4){v[j][0], v[j][1], v[j][2], v[j][3]} * rstd * g0 + b0, y1 = (f32x4){v[j][4], v[j][5], v[j][6], v[j][7]} * rstd * g1 + b1;
        if (dstf) { *(f32x4*)(dstf + c) = y0; *(f32x4*)(dstf + c + 4) = y1; }
        if (dstb) store8bf(dstb + c, y0, y1); }
}

__device__ __forceinline__ void prescan_item(const Params& p, LAS unsigned char* lds, int it, int cvt_base) {
    const int tid = threadIdx.x, wid = tid >> 6, lane = tid & 63;
    const int bh = it >> 5, n = it & 31, b = bh >> 4, h = bh & 15, t0 = n * 64, mrow0 = b * SEQ + t0;
    LAS bf16_t* Kb = (LAS bf16_t*)(lds);
    LAS bf16_t* Qb = (LAS bf16_t*)(lds + 17408);
    LAS float* NfT = (LAS float*)(lds + 34816);
    LAS bf16_t* KdT = (LAS bf16_t*)(lds + 52224);
    LAS bf16_t* VbT = (LAS bf16_t*)(lds + 70656);
    LAS bf16_t* KbgT = (LAS bf16_t*)(lds + 89088);
    LAS bf16_t* Tb = (LAS bf16_t*)(lds + 107520);
    LAS float* sm_beta = (LAS float*)(lds + 116736);
    LAS float* sm_gc = sm_beta + 64;
    LAS float* Wc = (LAS float*)(lds + 117248);
    LAS float* OH = (LAS float*)(lds + 123392);
    unsigned char* ps = p.ws + WS_PS + (size_t)it * PS_ITEM;
    const float* bg = (const float*)(p.ws + WS_BG);
    const bf16_t* qkv = (const bf16_t*)(p.ws + WS_QKV);
    const int ri = tid >> 3, c0 = (tid & 7) * 16;
    u32x4 raw[3][4][2];
    {
        const unsigned char* qb = (const unsigned char*)qkv;
#pragma unroll
        for (int j = 0; j < 4; ++j) {
            const int tt = t0 + ri - 3 + j, ttc = tt < 0 ? 0 : tt;
            const unsigned off = (unsigned)(((b * SEQ + ttc) * DQKV + h * 128 + c0) * 2);
#pragma unroll
            for (int sec = 0; sec < 2; ++sec) {
                u32x4 a0 = *(const u32x4*)(qb + (size_t)(off + sec * 4096u)), a1 = *(const u32x4*)(qb + (size_t)(off + sec * 4096u + 16u));
                if (tt < 0) { a0 = (u32x4){0u, 0u, 0u, 0u}; a1 = (u32x4){0u, 0u, 0u, 0u}; }
                raw[sec][j][0] = a0; raw[sec][j][1] = a1;
            }
        }
    }
#pragma unroll
    for (int k = 0; k < 3; ++k) { const int idx = tid + 512 * k, j = idx / 384, rem = idx % 384; Wc[idx] = p.w_conv[(size_t)j * DQKV + (rem >> 7) * DM + h * 128 + (rem & 127)]; }
    if (tid >= 384) OH[tid - 384] = (tid == 384 + 64) ? 1.f : 0.f;
    if (wid == 0) {
        const float be = bg[(size_t)(mrow0 + lane) * 32 + h]; float g = bg[(size_t)(mrow0 + lane) * 32 + 16 + h];
#pragma unroll
        for (int o = 1; o < 64; o <<= 1) { const float t = __shfl_up(g, o); if (lane >= o) g += t; }
        sm_beta[lane] = be; sm_gc[lane] = g;
        if (lane == 63) ((float*)(p.ws + WS_GL))[it] = __expf(g);
    }
    lds_barrier();
    {
        const int i = ri;
        const int isw = i ^ ((tid & 7) << 3);
        const float gci = sm_gc[i], bei = sm_beta[i], gcl = sm_gc[63];
        const float eg = __expf(gci), ekd = __expf(gcl - gci);
#pragma unroll
        for (int sec = 0; sec < 3; ++sec) {
            float vals[16];
            asm volatile("" ::: "memory"); __builtin_amdgcn_sched_barrier(0);
            if (sec == 1) {
                const unsigned char* qb = (const unsigned char*)qkv;
#pragma unroll
                for (int j = 0; j < 4; ++j) { const int tt = t0 + ri - 3 + j, ttc = tt < 0 ? 0 : tt; const unsigned off = (unsigned)(((b * SEQ + ttc) * DQKV + h * 128 + c0) * 2) + 8192u;
                    u32x4 a0 = *(const u32x4*)(qb + (size_t)off), a1 = *(const u32x4*)(qb + (size_t)(off + 16u));
                    if (tt < 0) { a0 = (u32x4){0u, 0u, 0u, 0u}; a1 = (u32x4){0u, 0u, 0u, 0u}; }
                    raw[2][j][0] = a0; raw[2][j][1] = a1; }
                asm volatile("" ::: "memory"); __builtin_amdgcn_sched_barrier(0);
            }
#pragma unroll
            for (int e = 0; e < 16; ++e) vals[e] = 0.f;
#pragma unroll
            for (int j = 0; j < 4; ++j) {
                const LAS float* wp = Wc + (j * 3 + sec) * 128 + c0;
                const f32x4 w0 = *(const LAS f32x4*)wp, w1 = *(const LAS f32x4*)(wp + 4), w2 = *(const LAS f32x4*)(wp + 8), w3 = *(const LAS f32x4*)(wp + 12);
                const u32x4 r0 = raw[sec][j][0], r1 = raw[sec][j][1];
                vals[0] += bflo(r0.x) * w0[0]; vals[1] += bfhi(r0.x) * w0[1]; vals[2] += bflo(r0.y) * w0[2]; vals[3] += bfhi(r0.y) * w0[3];
                vals[4] += bflo(r0.z) * w1[0]; vals[5] += bfhi(r0.z) * w1[1]; vals[6] += bflo(r0.w) * w1[2]; vals[7] += bfhi(r0.w) * w1[3];
                vals[8] += bflo(r1.x) * w2[0]; vals[9] += bfhi(r1.x) * w2[1]; vals[10] += bflo(r1.y) * w2[2]; vals[11] += bfhi(r1.y) * w2[3];
                vals[12] += bflo(r1.z) * w3[0]; vals[13] += bfhi(r1.z) * w3[1]; vals[14] += bflo(r1.w) * w3[2]; vals[15] += bfhi(r1.w) * w3[3];
            }
#pragma unroll
            for (int e = 0; e < 16; ++e) vals[e] = siluf_(vals[e]);
            if (sec < 2) {
                float sq = 0.f;
#pragma unroll
                for (int e = 0; e < 16; ++e) sq += vals[e] * vals[e];
                sq += __shfl_xor(sq, 1); sq += __shfl_xor(sq, 2); sq += __shfl_xor(sq, 4);
                const float rn = (1.0f / sqrtf(sq + RMS_EPS)) * (sec == 0 ? 0.08838834764831845f : 1.0f);
#pragma unroll
                for (int e = 0; e < 16; ++e) vals[e] *= rn;
                unsigned w8[8];
#pragma unroll
                for (int e = 0; e < 8; ++e) w8[e] = pk2(vals[2 * e], vals[2 * e + 1]);
                LAS bf16_t* dst = (sec == 0 ? Qb : Kb) + i * 136 + c0;
                *(LAS u32x4*)dst = (u32x4){w8[0], w8[1], w8[2], w8[3]}; *(LAS u32x4*)(dst + 8) = (u32x4){w8[4], w8[5], w8[6], w8[7]};
                asm volatile("" ::: "memory"); __builtin_amdgcn_sched_barrier(0);
                if (sec == 0) {
#pragma unroll
                    for (int e = 0; e < 8; ++e) w8[e] = pk2(vals[2 * e] * eg, vals[2 * e + 1] * eg);
                    bf16_t* qdp = (bf16_t*)(ps + PS_QD) + i * 128 + c0;
                    *(u32x4*)qdp = (u32x4){w8[0], w8[1], w8[2], w8[3]}; *(u32x4*)(qdp + 8) = (u32x4){w8[4], w8[5], w8[6], w8[7]};
                } else {
#pragma unroll
                    for (int e = 0; e < 16; ++e) KdT[(c0 + e) * 72 + isw] = (bf16_t)(pk2(vals[e] * ekd, 0.f) & 0xffffu);
                    asm volatile("" ::: "memory"); __builtin_amdgcn_sched_barrier(0);
                    const float bk = bei * eg;
#pragma unroll
                    for (int e = 0; e < 16; ++e) KbgT[(c0 + e) * 72 + isw] = (bf16_t)(pk2(bk * vals[e], 0.f) & 0xffffu);
                }
            } else {
#pragma unroll
                for (int e = 0; e < 16; ++e) VbT[(c0 + e) * 72 + isw] = (bf16_t)(pk2(bei * vals[e], 0.f) & 0xffffu);
            }
        }
    }
    lds_barrier();
    {
        const int mat = wid >> 2, mi = wid & 3, fr = lane & 15, fq = lane >> 4;
        LAS bf16_t* Asrc = mat ? Qb : Kb;
        bf16x8 af[4];
#pragma unroll
        for (int s = 0; s < 4; ++s) af[s] = *(const LAS bf16x8*)(Asrc + (16 * mi + fr) * 136 + 32 * s + 8 * fq);
#pragma unroll
        for (int nj = 0; nj < 4; ++nj) {
            f32x4 acc = {0.f, 0.f, 0.f, 0.f};
            if (nj <= mi) {
#pragma unroll
                for (int s = 0; s < 4; ++s) { const bf16x8 bfr = *(const LAS bf16x8*)(Kb + (16 * nj + fr) * 136 + 32 * s + 8 * fq); acc = __builtin_amdgcn_mfma_f32_16x16x32_bf16(af[s], bfr, acc, 0, 0, 0); }
            }
            const int jj = 16 * nj + fr; const float gcj = sm_gc[jj];
            if (mat == 0) { f32x4 o;
#pragma unroll
                for (int j = 0; j < 4; ++j) { const int i = 16 * mi + 4 * fq + j; const float dec = __expf(fminf(sm_gc[i] - gcj, 0.f)); o[j] = (i > jj) ? sm_beta[i] * acc[j] * dec : 0.f; }
                *(LAS f32x4*)(NfT + jj * 68 + 16 * mi + 4 * fq) = o;
            } else {
#pragma unroll
                for (int j = 0; j < 4; ++j) { const int i = 16 * mi + 4 * fq + j; const float dec = __expf(fminf(sm_gc[i] - gcj, 0.f));
                    ((bf16_t*)(ps + PS_AT))[i * 64 + jj] = (bf16_t)(pk2((i >= jj) ? acc[j] * dec : 0.f, 0.f) & 0xffffu); }
            }
        }
    }
    lds_barrier();
    if (tid < 128) {
        const int c = tid >> 1, half = tid & 1; f32x2 r2[16];
        const LAS float* ohp = OH + 64 - c + 4 * half;
#pragma unroll
        for (int li = 0; li < 8; ++li) { r2[2 * li] = (f32x2){ohp[8 * li], ohp[8 * li + 1]}; r2[2 * li + 1] = (f32x2){ohp[8 * li + 2], ohp[8 * li + 3]}; }
        const LAS float* nb = NfT + half * 4;
#pragma unroll
        for (int j = 0; j < 63; ++j) {
            const int jc = j >> 2, lj = jc >> 1, ej = j & 3;
            const float xm = (ej & 2) ? ((ej & 1) ? r2[2 * lj + 1].y : r2[2 * lj + 1].x) : ((ej & 1) ? r2[2 * lj].y : r2[2 * lj].x);
            const float xo = __shfl_xor(xm, 1);
            const float xj = ((jc & 1) == half) ? xm : xo;
            const f32x2 xj2 = {xj, xj};
#pragma unroll
            for (int li = lj; li < 8; ++li) {
                f32x4 nv = *(const LAS f32x4*)(nb + j * 68 + 8 * li);
                if (li == lj) {
                    const int rowb = 4 * (2 * li + half);
#pragma unroll
                    for (int e = 0; e < 4; ++e) nv[e] = (rowb + e > j) ? nv[e] : 0.f;
                }
                r2[2 * li] = r2[2 * li] - (f32x2){nv[0], nv[1]} * xj2; r2[2 * li + 1] = r2[2 * li + 1] - (f32x2){nv[2], nv[3]} * xj2;
            }
            asm volatile("" ::: "memory"); __builtin_amdgcn_sched_barrier(0);
        }
#pragma unroll
        for (int li = 0; li < 8; ++li) { const int rb = 4 * (2 * li + half);
            Tb[(rb) * 72 + c] = (bf16_t)(pk2(r2[2 * li].x, 0.f) & 0xffffu); Tb[(rb + 1) * 72 + c] = (bf16_t)(pk2(r2[2 * li].y, 0.f) & 0xffffu);
            Tb[(rb + 2) * 72 + c] = (bf16_t)(pk2(r2[2 * li + 1].x, 0.f) & 0xffffu); Tb[(rb + 3) * 72 + c] = (bf16_t)(pk2(r2[2 * li + 1].y, 0.f) & 0xffffu); }
    } else if (tid >= 256) {
        const int t2 = tid - 256; bf16_t* kd = (bf16_t*)(ps + PS_KDT);
#pragma unroll
        for (int k = 0; k < 4; ++k) { const int q = t2 + 256 * k, row = q >> 3, cc = q & 7; *(u32x4*)(kd + row * 64 + cc * 8) = *(const LAS u32x4*)(KdT + row * 72 + (cc ^ ((row >> 4) & 7)) * 8); }
        if (cvt_base >= 0) {
            LAS float* scr = (LAS float*)(lds + 124928 + (wid - 4) * 8448);
#pragma unroll 1
            for (int r = 0; r < 2; ++r) { const int t = cvt_base + (wid - 4) * 2 + r;
                if (t < 8192) transpose_item_fast(p.w_up, DM, DFF, (bf16_t*)(p.ws + WS_WUPT), 32 * (t & 255), scr, t >> 8, t & 255, lane);
                else { const int u = t - 8192; transpose_item_fast(p.w_down, DFF, DM, (bf16_t*)(p.ws + WS_WDNT), 32 * (u & 63), scr, u >> 6, u & 63, lane); } }
        }
    }
    lds_barrier();
    {
        const int fr = lane & 15, fq = lane >> 4;
        float* wout = (float*)(ps + PS_W); bf16_t* kout = (bf16_t*)(ps + PS_KCD);
        bf16x8 tf[4][2];
#pragma unroll
        for (int mi = 0; mi < 4; ++mi)
#pragma unroll
            for (int s = 0; s < 2; ++s) tf[mi][s] = *(const LAS bf16x8*)(Tb + (16 * mi + fr) * 72 + 32 * s + 8 * fq);
#pragma unroll
        for (int t = 0; t < 2; ++t) {
            const int ni = wid * 2 + t;
            const bf16x8 b0 = *(const LAS bf16x8*)(VbT + (16 * ni + fr) * 72 + 8 * (fq ^ (ni & 7))), b1 = *(const LAS bf16x8*)(VbT + (16 * ni + fr) * 72 + 8 * ((4 + fq) ^ (ni & 7)));
#pragma unroll
            for (int mi = 0; mi < 4; ++mi) {
                f32x4 acc = {0.f, 0.f, 0.f, 0.f};
                acc = __builtin_amdgcn_mfma_f32_16x16x32_bf16(tf[mi][0], b0, acc, 0, 0, 0);
                acc = __builtin_amdgcn_mfma_f32_16x16x32_bf16(tf[mi][1], b1, acc, 0, 0, 0);
                if (ni < 8) {
                    const int e = 16 * ni + fr; const unsigned wb = (unsigned)((e >> 5) * 1024 + (fq >> 1) * 128 + (fq & 1) * 32 + (e & 31));
                    unsigned* w32 = (unsigned*)wout + wb + (unsigned)((mi >> 1) * 512 + (mi & 1) * 256);
                    w32[0] = pk2(acc[0], acc[1]); w32[64] = pk2(acc[2], acc[3]);
                } else {
                    const unsigned kb_ = (unsigned)(4 * fq * 128 + 16 * (ni - 8) + fr);
#pragma unroll
                    for (int j = 0; j < 4; ++j) kout[kb_ + (unsigned)((16 * mi + j) * 128)] = (bf16_t)(pk2(-acc[j], 0.f) & 0xffffu);
                }
                asm volatile("" ::: "memory"); __builtin_amdgcn_sched_barrier(0);
            }
        }
    }
    lds_barrier();
}

__device__ __forceinline__ bf16x8 packs(const f32x16& x, int s) {
    u32x4 w; w.x = pk2(x[8 * s], x[8 * s + 1]); w.y = pk2(x[8 * s + 2], x[8 * s + 3]); w.z = pk2(x[8 * s + 4], x[8 * s + 5]); w.w = pk2(x[8 * s + 6], x[8 * s + 7]); return __builtin_bit_cast(bf16x8, w);
}
__device__ __forceinline__ bf16x8 ldA2(const LAS bf16_t* p) { const u32x2 a = *(const LAS u32x2*)p, b = *(const LAS u32x2*)(p + 8); u32x4 w = {a.x, a.y, b.x, b.y}; return __builtin_bit_cast(bf16x8, w); }
#define MFMA32(a, b, c) __builtin_amdgcn_mfma_f32_32x32x16_bf16((a), (b), (c), 0, 0, 0)
__device__ __forceinline__ int crow(int reg, int hh) { return (reg & 3) + 8 * (reg >> 2) + 4 * hh; }

__device__ __forceinline__ void scan_stage(const unsigned char* src, LAS unsigned char* bb, int t2) {
    constexpr int O_KCD = 0, O_QD = 16896, O_KDT = 33792, O_AT = 51200;
#pragma unroll
    for (int half = 0; half < 2; ++half) {
        u32x4 stg[7];
#pragma unroll
        for (int k = 0; k < 7; ++k) stg[k] = *(const u32x4*)(src + (size_t)(t2 + 256 * (7 * half + k)) * 16);
#pragma unroll
        for (int k = 0; k < 7; ++k) { const int kk = 7 * half + k, q = t2 + 256 * kk; LAS unsigned char* d_;
            if (kk < 4) d_ = bb + O_KCD + (q >> 4) * 264 + (q & 15) * 16; else if (kk < 8) d_ = bb + O_QD + ((q - 1024) >> 4) * 264 + (q & 15) * 16;
            else if (kk < 12) d_ = bb + O_KDT + ((q - 2048) >> 3) * 136 + (q & 7) * 16; else d_ = bb + O_AT + ((q - 3072) >> 3) * 136 + (q & 7) * 16;
            *(LAS u32x2*)d_ = (u32x2){stg[k].x, stg[k].y}; *(LAS u32x2*)(d_ + 8) = (u32x2){stg[k].z, stg[k].w}; }
    }
}
__device__ __forceinline__ void scan_onorm(const Params& p, const LAS bf16_t* Ob, bf16_t* zrow0, int h, int t2) {
    const int oi = t2 >> 2, oq = t2 & 3; u32x4 ov[4];
#pragma unroll
    for (int k = 0; k < 4; ++k) ov[k] = *(const LAS u32x4*)(Ob + oi * 136 + oq * 32 + 8 * k);
    float ov_f[32];
#pragma unroll
    for (int k = 0; k < 4; ++k) { ov_f[8 * k] = bflo(ov[k].x); ov_f[8 * k + 1] = bfhi(ov[k].x); ov_f[8 * k + 2] = bflo(ov[k].y); ov_f[8 * k + 3] = bfhi(ov[k].y);
        ov_f[8 * k + 4] = bflo(ov[k].z); ov_f[8 * k + 5] = bfhi(ov[k].z); ov_f[8 * k + 6] = bflo(ov[k].w); ov_f[8 * k + 7] = bfhi(ov[k].w); }
    float ss = 0.f;
#pragma unroll
    for (int e = 0; e < 32; ++e) ss += ov_f[e] * ov_f[e];
    ss += __shfl_xor(ss, 1); ss += __shfl_xor(ss, 2);
    const float rstd = 1.0f / sqrtf(ss * (1.f / 128.f) + RMS_EPS);
    bf16_t* zp = zrow0 + (size_t)oi * DM + h * 128 + oq * 32; const float* wn = p.w_onorm + oq * 32;
#pragma unroll
    for (int k = 0; k < 4; ++k) { const u32x4 zw = *(const u32x4*)(zp + 8 * k); const f32x4 w0 = *(const f32x4*)(wn + 8 * k), w1 = *(const f32x4*)(wn + 8 * k + 4);
        u32x4 o; o.x = pk2(ov_f[8 * k] * rstd * w0[0] * bflo(zw.x), ov_f[8 * k + 1] * rstd * w0[1] * bfhi(zw.x));
        o.y = pk2(ov_f[8 * k + 2] * rstd * w0[2] * bflo(zw.y), ov_f[8 * k + 3] * rstd * w0[3] * bfhi(zw.y));
        o.z = pk2(ov_f[8 * k + 4] * rstd * w1[0] * bflo(zw.z), ov_f[8 * k + 5] * rstd * w1[1] * bfhi(zw.z));
        o.w = pk2(ov_f[8 * k + 6] * rstd * w1[2] * bflo(zw.w), ov_f[8 * k + 7] * rstd * w1[3] * bfhi(zw.w));
        *(u32x4*)(zp + 8 * k) = o; }
}
__device__ __forceinline__ void scan_bh(const Params& p, LAS unsigned char* lds, int bh) {
    const int tid = threadIdx.x, wid = __builtin_amdgcn_readfirstlane(tid >> 6), lane = tid & 63, r = lane & 31, hh = lane >> 5;
    const int b = bh >> 4, h = bh & 15;
    constexpr int BUFB = 59904, O_KCD = 0, O_QD = 16896, O_KDT = 33792, O_AT = 51200, OBUFB = 17408;
    LAS unsigned char* Obase = lds + 2 * BUFB;
    const unsigned char* psb = p.ws + WS_PS + (size_t)(bh * 32) * PS_ITEM;
    const float* gl = (const float*)(p.ws + WS_GL) + bh * 32;
    bf16_t* Zb = (bf16_t*)(p.ws + WS_Z) + (size_t)(b * SEQ) * DM;
    if (wid >= 4) scan_stage(psb + PS_KCD, lds, tid - 256);
    lds_barrier();
    if (wid < 4) {
        f32x16 S[4], Vn[2], O[2];
#pragma unroll
        for (int d = 0; d < 4; ++d)
#pragma unroll
            for (int i = 0; i < 16; ++i) S[d][i] = 0.f;
        const int e0 = 32 * wid + r;
        { const unsigned* wsrc = (const unsigned*)(psb + PS_W) + wid * 1024 + lane;
#pragma unroll
            for (int mi = 0; mi < 2; ++mi)
#pragma unroll
                for (int k = 0; k < 8; ++k) { const unsigned u = wsrc[(mi * 8 + k) * 64]; Vn[mi][2 * k] = bflo(u); Vn[mi][2 * k + 1] = bfhi(u); } }
        const float glv = gl[lane & 31];
        for (int n = 0; n < 32; ++n) {
            LAS unsigned char* bb = lds + (n & 1) * BUFB;
            unsigned Wp[16];
            if (n + 1 < 32) { const unsigned* wsrc = (const unsigned*)(psb + (size_t)(n + 1) * PS_ITEM + PS_W) + wid * 1024 + lane;
#pragma unroll
                for (int k = 0; k < 16; ++k) Wp[k] = wsrc[k * 64]; }
            const LAS bf16_t* kcd = (const LAS bf16_t*)(bb + O_KCD); const LAS bf16_t* qdl = (const LAS bf16_t*)(bb + O_QD);
            const LAS bf16_t* kdt = (const LAS bf16_t*)(bb + O_KDT); const LAS bf16_t* att = (const LAS bf16_t*)(bb + O_AT);
            LAS bf16_t* Obuf = (LAS bf16_t*)(Obase + (n & 1) * OBUFB);
#pragma unroll
            for (int mi = 0; mi < 2; ++mi)
#pragma unroll
                for (int i = 0; i < 16; ++i) O[mi][i] = 0.f;
#pragma unroll
            for (int s = 0; s < 8; ++s) {
                bf16x8 ac[4];
#pragma unroll
                for (int mi = 0; mi < 2; ++mi) { ac[mi] = ldA2(kcd + (32 * mi + r) * 132 + 16 * s + 4 * hh); ac[2 + mi] = ldA2(qdl + (32 * mi + r) * 132 + 16 * s + 4 * hh); }
                const bf16x8 sf = packs(S[s >> 1], s & 1);
#pragma unroll
                for (int mi = 0; mi < 2; ++mi) { Vn[mi] = MFMA32(ac[mi], sf, Vn[mi]); O[mi] = MFMA32(ac[2 + mi], sf, O[mi]); }
                __builtin_amdgcn_sched_barrier(0);
            }
            bf16x8 vf[4];
#pragma unroll
            for (int s = 0; s < 4; ++s) vf[s] = packs(Vn[s >> 1], s & 1);
            if (n + 1 < 32) {
#pragma unroll
                for (int mi = 0; mi < 2; ++mi)
#pragma unroll
                    for (int k = 0; k < 8; ++k) { Vn[mi][2 * k] = bflo(Wp[mi * 8 + k]); Vn[mi][2 * k + 1] = bfhi(Wp[mi * 8 + k]); } }
#pragma unroll
            for (int s = 0; s < 2; ++s) O[0] = MFMA32(ldA2(att + (r) * 68 + 16 * s + 4 * hh), vf[s], O[0]);
#pragma unroll
            for (int s = 0; s < 4; ++s) O[1] = MFMA32(ldA2(att + (32 + r) * 68 + 16 * s + 4 * hh), vf[s], O[1]);
            const float g_l = __builtin_bit_cast(float, __builtin_amdgcn_readlane(__builtin_bit_cast(int, glv), n));
#pragma unroll
            for (int d = 0; d < 4; ++d) { S[d] = S[d] * g_l;
#pragma unroll
                for (int s = 0; s < 4; ++s) S[d] = MFMA32(ldA2(kdt + (32 * d + r) * 68 + 16 * s + 4 * hh), vf[s], S[d]); }
#pragma unroll
            for (int mi = 0; mi < 2; ++mi)
#pragma unroll
                for (int i = 0; i < 16; ++i) Obuf[(32 * mi + crow(i, hh)) * 136 + e0] = (bf16_t)(pk2(O[mi][i], 0.f) & 0xffffu);
            lds_barrier();
        }
        float* so = p.out + O_SP + (size_t)bh * 16384;
#pragma unroll
        for (int d = 0; d < 4; ++d)
#pragma unroll
            for (int i = 0; i < 16; ++i) so[(32 * d + crow(i, hh)) * 128 + e0] = S[d][i];
    } else {
        const int t2 = tid - 256, oi = t2 >> 2, oq = t2 & 3;
        u32x4 stg[8], stgb[6], zr[4];
#define SCAN_LD_A(item) do { const unsigned char* s_ = psb + (size_t)(item) * PS_ITEM + PS_KCD; _Pragma("unroll") for (int k = 0; k < 8; ++k) stg[k] = *(const u32x4*)(s_ + (size_t)(t2 + 256 * k) * 16); } while (0)
#define SCAN_LD_B(item) do { const unsigned char* s_ = psb + (size_t)(item) * PS_ITEM + PS_KCD; _Pragma("unroll") for (int k = 0; k < 6; ++k) stgb[k] = *(const u32x4*)(s_ + (size_t)(t2 + 256 * (8 + k)) * 16); } while (0)
#define SCAN_ST_A(bufi) do { LAS unsigned char* bb_ = lds + (bufi) * BUFB; _Pragma("unroll") for (int k = 0; k < 8; ++k) { const int q = t2 + 256 * k; LAS unsigned char* d_; \
            if (k < 4) d_ = bb_ + O_KCD + (q >> 4) * 264 + (q & 15) * 16; else d_ = bb_ + O_QD + ((q - 1024) >> 4) * 264 + (q & 15) * 16; \
            *(LAS u32x2*)d_ = (u32x2){stg[k].x, stg[k].y}; *(LAS u32x2*)(d_ + 8) = (u32x2){stg[k].z, stg[k].w}; } } while (0)
#define SCAN_ST_B(bufi) do { LAS unsigned char* bb_ = lds + (bufi) * BUFB; _Pragma("unroll") for (int k = 0; k < 6; ++k) { const int q = t2 + 256 * (8 + k); LAS unsigned char* d_; \
            if (k < 4) d_ = bb_ + O_KDT + ((q - 2048) >> 3) * 136 + (q & 7) * 16; else d_ = bb_ + O_AT + ((q - 3072) >> 3) * 136 + (q & 7) * 16; \
            *(LAS u32x2*)d_ = (u32x2){stgb[k].x, stgb[k].y}; *(LAS u32x2*)(d_ + 8) = (u32x2){stgb[k].z, stgb[k].w}; } } while (0)
#define SCAN_ZLD(chunk) do { const bf16_t* zp_ = Zb + (size_t)((chunk) * 64 + oi) * DM + h * 128 + oq * 32; _Pragma("unroll") for (int k = 0; k < 4; ++k) zr[k] = *(const u32x4*)(zp_ + 8 * k); } while (0)
#define SCAN_NORM(obuf, chunk) do { const LAS bf16_t* Ob_ = (const LAS bf16_t*)(obuf); u32x4 ov[4]; SCAN_ZLD(chunk); \
            _Pragma("unroll") for (int k = 0; k < 4; ++k) ov[k] = *(const LAS u32x4*)(Ob_ + oi * 136 + oq * 32 + 8 * k); \
            float ss = 0.f; \
            _Pragma("unroll") for (int k = 0; k < 4; ++k) { const float a0 = bflo(ov[k].x), a1 = bfhi(ov[k].x), a2 = bflo(ov[k].y), a3 = bfhi(ov[k].y), a4 = bflo(ov[k].z), a5 = bfhi(ov[k].z), a6 = bflo(ov[k].w), a7 = bfhi(ov[k].w); \
                ss += (a0 * a0 + a1 * a1) + (a2 * a2 + a3 * a3) + (a4 * a4 + a5 * a5) + (a6 * a6 + a7 * a7); } \
            ss += __shfl_xor(ss, 1); ss += __shfl_xor(ss, 2); \
            const float rstd = 1.0f / sqrtf(ss * (1.f / 128.f) + RMS_EPS); \
            bf16_t* zp_ = Zb + (size_t)((chunk) * 64 + oi) * DM + h * 128 + oq * 32; const float* wn = p.w_onorm + oq * 32; \
            _Pragma("unroll") for (int k = 0; k < 4; ++k) { const u32x4 zw = zr[k]; const f32x4 w0 = *(const f32x4*)(wn + 8 * k) * rstd, w1 = *(const f32x4*)(wn + 8 * k + 4) * rstd; \
                u32x4 o; o.x = pk2(bflo(ov[k].x) * w0[0] * bflo(zw.x), bfhi(ov[k].x) * w0[1] * bfhi(zw.x)); \
                o.y = pk2(bflo(ov[k].y) * w0[2] * bflo(zw.y), bfhi(ov[k].y) * w0[3] * bfhi(zw.y)); \
                o.z = pk2(bflo(ov[k].z) * w1[0] * bflo(zw.z), bfhi(ov[k].z) * w1[1] * bfhi(zw.z)); \
                o.w = pk2(bflo(ov[k].w) * w1[2] * bflo(zw.w), bfhi(ov[k].w) * w1[3] * bfhi(zw.w)); \
                *(u32x4*)(zp_ + 8 * k) = o; asm volatile("" ::: "memory"); } } while (0)
        SCAN_LD_A(1); SCAN_LD_B(1);
        for (int n = 0; n < 32; ++n) {
            if (n + 1 < 32) { SCAN_ST_A((n + 1) & 1); SCAN_ST_B((n + 1) & 1); }
            if (n + 2 < 32) { SCAN_LD_A(n + 2); SCAN_LD_B(n + 2); }
            if (n >= 1) SCAN_NORM(Obase + ((n - 1) & 1) * OBUFB, n - 1);
            lds_barrier();
        }
        SCAN_NORM(Obase + OBUFB, 31);
#undef SCAN_LD_A
#undef SCAN_LD_B
#undef SCAN_ST_A
#undef SCAN_ST_B
#undef SCAN_ZLD
#undef SCAN_NORM
    }
    lds_barrier();
}

__device__ __forceinline__ void sample_prefetch(const Params& p, int it, f32x4 (&Sn)[8]) {
    const int tid = threadIdx.x; const float* S0 = p.state_ssm + (size_t)it * 16384 + (tid >> 5) * 1024 + (tid & 31) * 4;
#pragma unroll
    for (int i = 0; i < 8; ++i) Sn[i] = *(const f32x4*)(S0 + i * 128);
}
__device__ __forceinline__ void sample_item(const Params& p, LAS unsigned char* lds, int it, const f32x4 (&Sr)[8]) {
    const int tid = threadIdx.x, wid = tid >> 6, lane = tid & 63;
    const int b = it >> 4, h = it & 15, m = MP + b;
    const int e4 = (tid & 31) * 4, dg = tid >> 5;
    LAS float* vq = (LAS float*)lds;
    LAS float* red = vq + 384;
    LAS float* vnew = vq + 400;
    LAS float* part = vq + 1024;
    const bf16_t* qkv = (const bf16_t*)(p.ws + WS_QKV); const float* bg = (const float*)(p.ws + WS_BG); bf16_t* Zb = (bf16_t*)(p.ws + WS_Z);
    if (tid < 384) { const int sec = tid >> 7, c = tid & 127, col = sec * DM + h * 128 + c;
        float a = bf2f(qkv[(size_t)m * DQKV + col]) * p.w_conv[3 * DQKV + col];
#pragma unroll
        for (int j = 0; j < 3; ++j) a += p.state_conv[(size_t)(b * 3 + j) * DQKV + col] * p.w_conv[j * DQKV + col];
        vq[sec * 128 + c] = siluf_(a); }
    lds_barrier();
    if (wid < 2) { const float a = vq[wid * 128 + lane], c2 = vq[wid * 128 + 64 + lane]; const float s = wave_sum(a * a + c2 * c2); if (lane == 0) red[wid] = s; }
    lds_barrier();
    if (tid < 256) { const int sec = tid >> 7; const float rs = 1.0f / sqrtf(red[sec] + RMS_EPS) * (sec == 0 ? 0.08838834764831845f : 1.0f); vq[tid] *= rs; }
    lds_barrier();
    if (wid == 0) { const float s = wave_sum(vq[lane] * vq[128 + lane] + vq[64 + lane] * vq[192 + lane]); if (lane == 0) red[2] = s; }
    {
        f32x4 ks = {0.f, 0.f, 0.f, 0.f}, qs = {0.f, 0.f, 0.f, 0.f};
#pragma unroll
        for (int i = 0; i < 8; ++i) { const float kk = vq[128 + dg * 8 + i], qq = vq[dg * 8 + i]; ks += Sr[i] * kk; qs += Sr[i] * qq; }
        *(LAS f32x4*)(part + dg * 128 + e4) = ks; *(LAS f32x4*)(part + 2048 + dg * 128 + e4) = qs;
    }
    lds_barrier();
    const float beta = bg[(size_t)m * 32 + h], eg = __expf(bg[(size_t)m * 32 + 16 + h]);
    float o = 0.f;
    if (tid < 128) { float kS = 0.f, qS = 0.f;
#pragma unroll
        for (int d = 0; d < 16; ++d) { kS += part[d * 128 + tid]; qS += part[2048 + d * 128 + tid]; }
        const float vn = beta * (vq[256 + tid] - eg * kS); o = eg * qS + red[2] * vn; vnew[tid] = vn;
        const float s = wave_sum(o * o); if (lane == 0) red[4 + wid] = s; }
    lds_barrier();
    if (tid < 128) { const float rstd = 1.0f / sqrtf((red[4] + red[5]) * (1.f / 128.f) + RMS_EPS); bf16_t* zp = Zb + (size_t)m * DM + h * 128 + tid;
        *zp = (bf16_t)(pk2(o * rstd * p.w_onorm[tid] * bf2f(*zp), 0.f) & 0xffffu); }
    {
        float* So = p.out + O_SS + (size_t)it * 16384; const f32x4 vn4 = *(const LAS f32x4*)(vnew + e4);
#pragma unroll
        for (int i = 0; i < 8; ++i) { const float kk = vq[128 + dg * 8 + i]; *(f32x4*)(So + (dg * 8 + i) * 128 + e4) = Sr[i] * eg + vn4 * kk; }
    }
    lds_barrier();
}

__device__ __forceinline__ void mixerA_item(const Params& p, LAS unsigned char* lds, int it) {
    const int tid = threadIdx.x, wid = tid >> 6, lane = tid & 63, fr = lane & 15, fq = lane >> 4;
    const int b = it >> 8, c = (it >> 4) & 15, g = it & 15, m0 = b * SEQ + c * 128;
    LAS bf16_t* Wt = (LAS bf16_t*)lds;
    LAS bf16_t* VnT = (LAS bf16_t*)(lds + 34816);
    LAS float* st = (LAS float*)(lds + 68608);
    const float* vstat = (const float*)(p.ws + WS_VSTAT); const bf16_t* VA = (const bf16_t*)(p.ws + WS_VA); bf16_t* U = (bf16_t*)(p.ws + WS_U);
    if (tid < 128) { const float* sp = vstat + (size_t)(m0 + tid) * 64; float s = 0.f, s2 = 0.f;
#pragma unroll
        for (int k = 0; k < 16; ++k) { const f32x4 v = *(const f32x4*)(sp + 4 * k); s += v[0] + v[2]; s2 += v[1] + v[3]; }
        const float mu = s * (1.f / DM), var = fmaxf(s2 * (1.f / DM) - mu * mu, 0.f); st[2 * tid] = mu; st[2 * tid + 1] = 1.0f / sqrtf(var + LN_EPS); }
    {
        const float* ws_ = p.w_s + (size_t)g * 16384;
#pragma unroll
        for (int k = 0; k < 8; ++k) { const int idx = tid + 512 * k, t = idx >> 5, s4 = (idx & 31) * 4; f32x4 w = *(const f32x4*)(ws_ + t * 128 + s4);
#pragma unroll
            for (int e = 0; e < 4; ++e) if (s4 + e > t) w[e] = 0.f;
            *(LAS u32x2*)(Wt + t * 136 + s4) = (u32x2){pk2(w[0], w[1]), pk2(w[2], w[3])}; }
    }
    lds_barrier();
#pragma unroll
    for (int k = 0; k < 4; ++k) {
        const int q = tid + 512 * k, l = q & 63, grp = q >> 6, s = (grp >> 2) * 16 + (l >> 2), dc = (grp & 3) * 4 + (l & 3);
        const u32x4 raw = *(const u32x4*)(VA + (size_t)(m0 + s) * DM + g * 128 + dc * 8);
        const float mu = st[2 * s], rs = st[2 * s + 1];
        const float* gp = p.ln_v_g + g * 128 + dc * 8; const float* bp = p.ln_v_b + g * 128 + dc * 8;
        const f32x4 g0 = *(const f32x4*)gp, g1 = *(const f32x4*)(gp + 4), b0 = *(const f32x4*)bp, b1 = *(const f32x4*)(bp + 4);
        float v[8] = {bflo(raw.x), bfhi(raw.x), bflo(raw.y), bfhi(raw.y), bflo(raw.z), bfhi(raw.z), bflo(raw.w), bfhi(raw.w)};
#pragma unroll
        for (int e = 0; e < 8; ++e) { const float gg = e < 4 ? g0[e & 3] : g1[e & 3], bb = e < 4 ? b0[e & 3] : b1[e & 3]; const float y = (v[e] - mu) * rs * gg + bb;
            VnT[(dc * 8 + e) * 132 + s] = (bf16_t)(pk2(y, 0.f) & 0xffffu); }
    }
    lds_barrier();
    {
        bf16x8 wf[4];
        const int nks = ((16 * wid + 15) >> 5) + 1;
#pragma unroll
        for (int s = 0; s < 4; ++s) wf[s] = *(const LAS bf16x8*)(Wt + (16 * wid + fr) * 136 + 32 * s + 8 * fq);
        const int t = 16 * wid + fr; const float bs = p.b_s[g * 128 + t];
#pragma unroll
        for (int mb = 0; mb < 8; ++mb) {
            f32x4 acc = {0.f, 0.f, 0.f, 0.f};
#pragma unroll
            for (int s = 0; s < 4; ++s) if (s < nks) {
                const LAS bf16_t* vp = VnT + (16 * mb + fr) * 132 + 32 * s + 8 * fq; const u32x2 a0 = *(const LAS u32x2*)vp, a1 = *(const LAS u32x2*)(vp + 4);
                u32x4 aw = {a0.x, a0.y, a1.x, a1.y};
                acc = __builtin_amdgcn_mfma_f32_16x16x32_bf16(__builtin_bit_cast(bf16x8, aw), wf[s], acc, 0, 0, 0); }
            bf16_t* up = U + (size_t)(m0 + t) * DM + g * 128 + 16 * mb + 4 * fq; const u32x2 uw = *(const u32x2*)up;
            u32x2 o; o.x = pk2(bflo(uw.x) * (acc[0] + bs), bfhi(uw.x) * (acc[1] + bs)); o.y = pk2(bflo(uw.y) * (acc[2] + bs), bfhi(uw.y) * (acc[3] + bs));
            *(u32x2*)up = o;
        }
    }
    lds_barrier();
}

#define XB_TMO      128
#define XB_XCNT(j)  (256  + 64 * (j))
#define XB_XSUB(j)  (1280 + 64 * (j))
#define XB_XGEN(j)  (2304 + 64 * (j))
#define XB_TOP      3328
#define XB_TOPGEN   3392
#define XCD_BAR_WORDS 3456
#define XB_SPIN_CAP (1u << 18)
__device__ __forceinline__ unsigned xb_ld(unsigned* p)              { return __hip_atomic_load(p, __ATOMIC_RELAXED, __HIP_MEMORY_SCOPE_AGENT); }
__device__ __forceinline__ unsigned xb_add(unsigned* p, unsigned v) { return __hip_atomic_fetch_add(p, v, __ATOMIC_RELAXED, __HIP_MEMORY_SCOPE_AGENT); }
__device__ __forceinline__ unsigned xb_xcc_id() { return (unsigned)__builtin_amdgcn_s_getreg((3 << 11) | 20) & 0xFu; }
#define XB_SPIN(cond, bar) do { unsigned _sp = 0; while (cond) { __builtin_amdgcn_s_sleep(1); \
    if ((++_sp & 255u) == 0u) { if (xb_ld(&(bar)[XB_TMO])) break; if (_sp > XB_SPIN_CAP) { atomicAdd(&(bar)[XB_TMO], 1u); break; } } } } while (0)
struct XcdBarrier { unsigned* bar; unsigned x; volatile LAS unsigned* st; };
__device__ __forceinline__ XcdBarrier xcd_barrier_post(unsigned* bar, volatile LAS unsigned* st) {
    XcdBarrier b; b.bar = bar; b.x = xb_xcc_id(); b.st = st;
    if (threadIdx.x == 0) (void)xb_add(&bar[XB_XCNT(b.x)], 1u);
    return b;
}
__device__ __forceinline__ void xcd_barrier_complete(unsigned* bar, unsigned x, unsigned& nloc, unsigned& nx) {
    const unsigned G = gridDim.x * gridDim.y * gridDim.z;
    unsigned sum, cnt, mine, sp = 0u;
    for (;;) {
        sum = 0u; cnt = 0u; mine = 0u;
#pragma unroll
        for (unsigned j = 0; j < 16; ++j) { const unsigned c = xb_ld(&bar[XB_XCNT(j)]); sum += c; cnt += (c > 0u) ? 1u : 0u; mine = (j == x) ? c : mine; }
        if (sum == G) break;
        __builtin_amdgcn_s_sleep(1);
        if ((++sp & 255u) == 0u) { if (xb_ld(&bar[XB_TMO])) break; if (sp > XB_SPIN_CAP) { atomicAdd(&bar[XB_TMO], 1u); break; } }
    }
    nloc = mine > 0u ? mine : 1u; nx = cnt > 0u ? cnt : 1u;
}
__device__ __forceinline__ void xcd_barrier(const XcdBarrier& b) {
    asm volatile("s_waitcnt vmcnt(0)" ::: "memory");
    __syncthreads();
    if (threadIdx.x == 0) {
        unsigned* bar = b.bar;
        __builtin_amdgcn_s_waitcnt(0);
        unsigned nloc = b.st[0], nx = b.st[1];
        if (nloc == 0u) { xcd_barrier_complete(bar, b.x, nloc, nx); b.st[0] = nloc; b.st[1] = nx; }
        const unsigned old = xb_add(&bar[XB_XSUB(b.x)], 1u);
        const unsigned gen = old / nloc;
        if (old + 1u == (gen + 1u) * nloc) {
            __builtin_amdgcn_fence(__ATOMIC_RELEASE, "agent");
            asm volatile("s_waitcnt vmcnt(0)" ::: "memory");
            const unsigned og = xb_add(&bar[XB_TOP], 1u);
            const unsigned tg = og / nx;
            if (og + 1u == (tg + 1u) * nx) xb_add(&bar[XB_TOPGEN], 1u);
            else XB_SPIN(xb_ld(&bar[XB_TOPGEN]) == tg, bar);
            __builtin_amdgcn_fence(__ATOMIC_ACQUIRE, "agent");
            xb_add(&bar[XB_XGEN(b.x)], 1u);
            asm volatile("s_waitcnt vmcnt(0)" ::: "memory");
        } else {
            XB_SPIN(xb_ld(&bar[XB_XGEN(b.x)]) == gen, bar);
            __builtin_amdgcn_fence(__ATOMIC_ACQUIRE, "agent");
            asm volatile("s_waitcnt vmcnt(0)" ::: "memory");
        }
    }
    __syncthreads();
}

__device__ __forceinline__ unsigned char* opq(unsigned char* q) { asm volatile("" : "+s"(q)); return q; }
__global__ void __launch_bounds__(512, 2) mega_fwd(Params p) {
    extern __shared__ __attribute__((aligned(16))) unsigned char smem[];
    LAS unsigned char* lds = (LAS unsigned char*)smem;
    cg::grid_group grid = cg::this_grid();
    const int tid = threadIdx.x, wid = tid >> 6, lane = tid & 63, G = gridDim.x, blk = blockIdx.x;
    unsigned char* ws = p.ws;
#ifndef PHMASK
#define PHMASK 0x3ff
#endif
#define IN(k) (((PHMASK >> (k)) & 1) && p.ph_lo <= (k) && (k) < p.ph_hi)
#define SEAM(k) do { if (IN(k) && IN((k) + 1)) { if (p.coop == 2) grid.sync(); else xcd_barrier(xbar); } } while (0)
    volatile LAS unsigned* xst = (volatile LAS unsigned*)(lds + 160000);
    if (tid < 2) xst[tid] = 0u;
    __syncthreads();
    const XcdBarrier xbar = xcd_barrier_post((unsigned*)ws, xst);

    if (IN(0)) { unsigned char* ws = opq(p.ws);
        LAS float* scr = (LAS float*)(lds + wid * 16640);
        const int gw = blk * 8 + wid, NGW = G * 8;
        constexpr int I_IN = 32 * 256, I_BG = 32, I_P = 32 * 32;
        const int NIT = I_IN + I_BG + (G == 256 ? 0 : 3 * I_P);
        for (int it = gw; it < NIT; it += NGW) {
            int r = it;
            if (r < I_IN) { const int kb = r >> 8, nb = r & 255; const int n0 = nb < 192 ? 64 * nb : 12320 + 64 * (nb - 192); const int drow = nb < 192 ? n0 : n0 - 32;
                transpose64(p.w_in, 16416, (bf16_t*)(ws + WS_W1T), DM, 64 * kb, n0, drow, scr, lane); continue; }
            r -= I_IN;
            if (r < I_BG) { transpose_item(p.w_in, DM, 16416, (bf16_t*)(ws + WS_W1T), 16384, scr, r, 384, lane); continue; }
            r -= I_BG;
            if (r < I_P) { transpose64(p.w_proj_a, DM, (bf16_t*)(ws + WS_WPT), DM, 64 * (r >> 5), 64 * (r & 31), 64 * (r & 31), scr, lane); continue; } r -= I_P;
            if (r < I_P) { transpose64(p.w_proj_b, DM, (bf16_t*)(ws + WS_WPT), DM, 64 * (r >> 5), 64 * (r & 31), DM + 64 * (r & 31), scr, lane); continue; } r -= I_P;
            transpose64(p.w_o, DM, (bf16_t*)(ws + WS_WOT), DM, 64 * (r >> 5), 64 * (r & 31), 64 * (r & 31), scr, lane);
        }
        bf16_t* xb = (bf16_t*)(ws + WS_XB);
#pragma unroll 4
        for (size_t q = (size_t)blk * 512 + tid; q < (size_t)MPAD * DM / 8; q += (size_t)G * 512) {
            const size_t e = q * 8; const int row = (int)(e / DM);
            u32x4 o = {0u, 0u, 0u, 0u};
            if (row < MT) { const float* src = row < MP ? p.x_prompt + e : p.x_sample + (e - (size_t)MP * DM); const f32x4 a = *(const f32x4*)src, c2 = *(const f32x4*)(src + 4);
                o.x = pk2(a[0], a[1]); o.y = pk2(a[2], a[3]); o.z = pk2(c2[0], c2[1]); o.w = pk2(c2[2], c2[3]); }
            *(u32x4*)(xb + e) = o;
        }
        bf16_t* w1 = (bf16_t*)(ws + WS_W1T);
        for (size_t q = (size_t)blk * 512 + tid; q < (size_t)224 * DM / 8; q += (size_t)G * 512) *(u32x4*)(w1 + (size_t)16416 * DM + q * 8) = (u32x4){0u, 0u, 0u, 0u};
    }
    SEAM(0);
    if (IN(1)) { unsigned char* ws = opq(p.ws);
        pg8::Gemm g{(const bf16_t*)(ws + WS_XB), (const bf16_t*)(ws + WS_W1T), MPAD, N1, DM};
        pg8::Sched S; S.init(33, 65, G, blk, 0, 0, 0, 32);
        Epi1 E{ws, p.a_log, p.dt_bias};
        pg8::gemm_phase<Epi1>(lds, g, S, E);
        if (G == 256) { const int rem = (33 * 65) % 256;
            if (blk >= rem) { LAS float* scr = (LAS float*)(lds + wid * 16640); const int nw = (256 - rem) * 8;
                for (int t = (blk - rem) * 8 + wid; t < 3 * 1024; t += nw) { const int m = t >> 10, r = t & 1023;
                    if (m == 0) transpose64(p.w_proj_a, DM, (bf16_t*)(ws + WS_WPT), DM, 64 * (r >> 5), 64 * (r & 31), 64 * (r & 31), scr, lane);
                    else if (m == 1) transpose64(p.w_proj_b, DM, (bf16_t*)(ws + WS_WPT), DM, 64 * (r >> 5), 64 * (r & 31), DM + 64 * (r & 31), scr, lane);
                    else transpose64(p.w_o, DM, (bf16_t*)(ws + WS_WOT), DM, 64 * (r >> 5), 64 * (r & 31), 64 * (r & 31), scr, lane); } } }
    }
    SEAM(1);
    if (IN(2)) { unsigned char* ws = opq(p.ws);
        { int k = 0; for (int it = blk; it < 2048; it += G, ++k) prescan_item(p, lds, it, (G == 256 && k < 8) ? blk * 64 + k * 8 : -1); }
    }
    SEAM(2);
    if (IN(3)) { unsigned char* ws = opq(p.ws);
        const bool split = G > 64;
        if (blk < 64) { for (int bh = blk; bh < 64; bh += (split ? 64 : G)) scan_bh(p, lds, bh); }
        if (!split || blk >= 64) {
            const int oi = split ? blk - 64 : blk, on = split ? G - 64 : G;
            const bf16_t* qkv = (const bf16_t*)(ws + WS_QKV);
            for (int q = oi * 512 + tid; q < NBP * 3 * DQKV / 4; q += on * 512) { const int e = q * 4, col = e % DQKV, j = (e / DQKV) % 3, bb = e / (3 * DQKV);
                const u32x2 r = *(const u32x2*)(qkv + (size_t)(bb * SEQ + SEQ - 3 + j) * DQKV + col); *(f32x4*)(p.out + O_CP + e) = (f32x4){bflo(r.x), bfhi(r.x), bflo(r.y), bfhi(r.y)}; }
#pragma unroll 2
            for (int q = oi * 512 + tid; q < MS * 3 * DQKV / 4; q += on * 512) { const int e = q * 4, col = e % DQKV, j = (e / DQKV) % 3, bb = e / (3 * DQKV); f32x4 v;
                if (j < 2) v = *(const f32x4*)(p.state_conv + (size_t)(bb * 3 + j + 1) * DQKV + col);
                else { const u32x2 r = *(const u32x2*)(qkv + (size_t)(MP + bb) * DQKV + col); v = (f32x4){bflo(r.x), bfhi(r.x), bflo(r.y), bfhi(r.y)}; }
                *(f32x4*)(p.out + O_CS + e) = v; }
            const float* vstat = (const float*)(ws + WS_VSTAT); const bf16_t* VA = (const bf16_t*)(ws + WS_VA); bf16_t* U = (bf16_t*)(ws + WS_U);
            for (int row = oi * 8 + wid; row < MS; row += on * 8) { const int m = MP + row;
                const f32x2 st = lane < 32 ? *(const f32x2*)(vstat + (size_t)m * 64 + 2 * lane) : (f32x2){0.f, 0.f};
                const float s = wave_sum(st.x), s2 = wave_sum(st.y);
                const float mu = s * (1.f / DM), var = fmaxf(s2 * (1.f / DM) - mu * mu, 0.f), rs = 1.0f / sqrtf(var + LN_EPS);
#pragma unroll
                for (int k = 0; k < 8; ++k) { const int cc = (lane + 64 * k) * 4, gg = cc >> 7;
                    const u32x2 va = *(const u32x2*)(VA + (size_t)m * DM + cc); const f32x4 lg = *(const f32x4*)(p.ln_v_g + cc), lb = *(const f32x4*)(p.ln_v_b + cc);
                    f32x4 vn = {bflo(va.x), bfhi(va.x), bflo(va.y), bfhi(va.y)}; vn = (vn - mu) * rs * lg + lb;
                    *(f32x4*)(p.out + O_GV + (size_t)row * DM + cc) = vn;
                    const float w00 = p.w_s[(size_t)gg * 16384], bs0 = p.b_s[gg * 128];
                    bf16_t* up = U + (size_t)m * DM + cc; const u32x2 uw = *(const u32x2*)up;
                    *(u32x2*)up = (u32x2){pk2(bflo(uw.x) * (w00 * vn[0] + bs0), bfhi(uw.x) * (w00 * vn[1] + bs0)), pk2(bflo(uw.y) * (w00 * vn[2] + bs0), bfhi(uw.y) * (w00 * vn[3] + bs0))}; }
            }
        }
        {
            unsigned* qctr = (unsigned*)ws + 3584;
            volatile LAS int* slot = (volatile LAS int*)(lds + 160016);
            if (tid == 0) { slot[0] = (int)__hip_atomic_fetch_add(qctr, 1u, __ATOMIC_RELAXED, __HIP_MEMORY_SCOPE_AGENT); slot[1] = (int)__hip_atomic_fetch_add(qctr, 1u, __ATOMIC_RELAXED, __HIP_MEMORY_SCOPE_AGENT); }
            lds_barrier();
            int cur = slot[0], nxt = slot[1], par = 0;
            f32x4 Sr[8], Sn[8];
            if (cur < 2048) sample_prefetch(p, cur, Sr);
            lds_barrier();
            while (cur < 3072) {
                unsigned tick = 0u;
                if (tid == 0) tick = __hip_atomic_fetch_add(qctr, 1u, __ATOMIC_RELAXED, __HIP_MEMORY_SCOPE_AGENT);
                if (nxt < 2048) sample_prefetch(p, nxt, Sn);
                if (cur < 2048) sample_item(p, lds, cur, Sr); else mixerA_item(p, lds, cur - 2048);
                if (tid == 0) slot[par] = (int)tick;
                lds_barrier();
                const int nn = slot[par]; par ^= 1;
#pragma unroll
                for (int i = 0; i < 8; ++i) Sr[i] = Sn[i];
                cur = nxt; nxt = nn;
            }
        }
    }
    SEAM(3);
    if (IN(4)) { unsigned char* ws = opq(p.ws);
        pg8::Gemm g{(const bf16_t*)(ws + WS_U), (const bf16_t*)(ws + WS_WPT), 2 * MPAD, 2 * DM, DM};
        { pg8::Sched S; S.init(32, 8, G, blk, 1, 33, 8, 32); Epi4 E{ws}; pg8::gemm_phase<Epi4>(lds, g, S, E); }
        { pg8::Sched S; S.init_split(32, 8, 16, 2, G, blk, 1, 33, 8); EpiS4 E{ws}; pg8::gemm_phase<EpiS4>(lds, g, S, E); }
    }
    SEAM(4);
    if (IN(5)) { unsigned char* ws = opq(p.ws);
        {
            const float* part = (const float*)(ws + WS_PART); bf16_t* MB = (bf16_t*)(ws + WS_MB);
            for (int q = blk * 512 + tid; q < MS * DM / 4; q += G * 512) { f32x4 v = *(const f32x4*)(part + 4 * q);
#pragma unroll 8
                for (int sl = 1; sl < 32; ++sl) v += *(const f32x4*)(part + (size_t)sl * MS * DM + 4 * q);
                *(u32x2*)(MB + (size_t)MP * DM + 4 * q) = (u32x2){pk2(v[0], v[1]), pk2(v[2], v[3])}; }
        }
        pg8::Gemm g{(const bf16_t*)(ws + WS_MB), (const bf16_t*)(ws + WS_WOT), MPAD, DM, DM};
        { pg8::Sched S; S.init(32, 8, G, blk, 0, 0, 0, 32); EpiRes E{p.x_prompt, nullptr, (bf16_t*)(ws + WS_R1)}; pg8::gemm_phase<EpiRes>(lds, g, S, E); }
        xcd_barrier(xbar);
        { pg8::Sched S; S.init_split(32, 8, 16, 2, G, blk, 0, 0, 0); EpiSPart E{(float*)(ws + WS_PART), DM}; pg8::gemm_phase<EpiSPart>(lds, g, S, E); }
        if (G == 256) {
            const int gw2 = (blk & 127) * 8 + wid, nrow = blk >= 128 ? 5 : 3, base = blk >= 128 ? 0 : 5120;
            for (int j = 0; j < nrow; ++j) { const int m = base + gw2 + 1024 * j;
                ln_row_b((const bf16_t*)(ws + WS_R1) + (size_t)m * DM, p.ln1_g, p.ln1_b, nullptr, (bf16_t*)(ws + WS_X1B) + (size_t)m * DM, lane); }
        }
    }
    SEAM(5);
    if (IN(6) && G != 256) { unsigned char* ws = opq(p.ws);
        const int gw = blk * 8 + wid, NGW = G * 8;
        for (int m = (G == 256 ? MP + gw : gw); m < MT; m += NGW) {
            if (m < MP) { if (G != 256) ln_row_b((const bf16_t*)(ws + WS_R1) + (size_t)m * DM, p.ln1_g, p.ln1_b, nullptr, (bf16_t*)(ws + WS_X1B) + (size_t)m * DM, lane); }
            else ln_row((const float*)(ws + WS_PART) + (size_t)(m - MP) * DM, p.ln1_g, p.ln1_b, (float*)(ws + WS_X1) + (size_t)m * DM, (bf16_t*)(ws + WS_X1B) + (size_t)m * DM, lane, 16, (size_t)MS * DM, p.x_sample + (size_t)(m - MP) * DM);
        }
        LAS float* scr = (LAS float*)(lds + wid * 16640);
        if (G != 256) for (int it = gw; it < 8192; it += NGW) {
            if (it < 4096) transpose64(p.w_up, DFF, (bf16_t*)(ws + WS_WUPT), DM, 64 * (it >> 7), 64 * (it & 127), 64 * (it & 127), scr, lane);
            else { const int r = it - 4096; transpose64(p.w_down, DM, (bf16_t*)(ws + WS_WDNT), DFF, 64 * (r >> 5), 64 * (r & 31), 64 * (r & 31), scr, lane); }
        }
    }
    if (G != 256) SEAM(6);
    if (IN(7)) { unsigned char* ws = opq(p.ws);
        pg8::Gemm g{(const bf16_t*)(ws + WS_X1B), (const bf16_t*)(ws + WS_WUPT), MPAD, DFF, DM};
        if (G == 256 && blk < 16) {
            const int row = blk * 8 + wid, m = MP + row;
            ln_row((const float*)(ws + WS_PART) + (size_t)row * DM, p.ln1_g, p.ln1_b, (float*)(ws + WS_X1) + (size_t)m * DM, (bf16_t*)(ws + WS_X1B) + (size_t)m * DM, lane, 16, (size_t)MS * DM, p.x_sample + (size_t)row * DM);
            asm volatile("s_waitcnt vmcnt(0)" ::: "memory");
            if (lane == 0) { __builtin_amdgcn_fence(__ATOMIC_RELEASE, "agent"); asm volatile("s_waitcnt vmcnt(0)" ::: "memory");
                __hip_atomic_fetch_add((unsigned*)ws + 3840, 1u, __ATOMIC_RELAXED, __HIP_MEMORY_SCOPE_AGENT); }
        }
        { pg8::Sched S; S.init(32, 32, G, blk, 0, 0, 0, 32); Epi7 E{(bf16_t*)(ws + WS_H)}; pg8::gemm_phase<Epi7>(lds, g, S, E); }
        if (G == 256) {
            if (tid == 0) { unsigned* cnt = (unsigned*)ws + 3840; unsigned sp = 0;
                while (__hip_atomic_load(cnt, __ATOMIC_RELAXED, __HIP_MEMORY_SCOPE_AGENT) < 128u) { __builtin_amdgcn_s_sleep(8); if (++sp > (1u << 22)) break; }
                __builtin_amdgcn_fence(__ATOMIC_ACQUIRE, "agent"); asm volatile("s_waitcnt vmcnt(0)" ::: "memory"); }
            __syncthreads();
        }
        { pg8::Sched S; S.init_split(32, 32, 8, 4, G, blk, 0, 0, 0); EpiSPart E{(float*)(ws + WS_PART), DFF}; pg8::gemm_phase<EpiSPart>(lds, g, S, E); }
    }
    SEAM(7);
    if (IN(8)) { unsigned char* ws = opq(p.ws);
        {
            const float* part = (const float*)(ws + WS_PART); bf16_t* H = (bf16_t*)(ws + WS_H);
            for (int q = blk * 512 + tid; q < MS * DFF / 4; q += G * 512) { f32x4 v = *(const f32x4*)(part + 4 * q);
#pragma unroll
                for (int sl = 1; sl < 8; ++sl) v += *(const f32x4*)(part + (size_t)sl * MS * DFF + 4 * q);
#pragma unroll
                for (int e = 0; e < 4; ++e) { const float a = fmaxf(v[e], 0.f); v[e] = a * a; }
                *(u32x2*)(H + (size_t)MP * DFF + 4 * q) = (u32x2){pk2(v[0], v[1]), pk2(v[2], v[3])}; }
        }
        pg8::Gemm g{(const bf16_t*)(ws + WS_H), (const bf16_t*)(ws + WS_WDNT), MPAD, DM, DFF};
        { pg8::Sched S; S.init(32, 8, G, blk, 0, 0, 0, 128); EpiRes E{nullptr, (const bf16_t*)(ws + WS_X1B), (bf16_t*)(ws + WS_R2)}; pg8::gemm_phase<EpiRes>(lds, g, S, E); }
        xcd_barrier(xbar);
        if (G == 256) {
            { pg8::Sched S; S.init_split(32, 8, 16, 8, G, blk, 0, 0, 0); EpiSPart E{(float*)(ws + WS_PART), DM}; pg8::gemm_phase<EpiSPart>(lds, g, S, E); }
            const int gw2 = (blk & 127) * 8 + wid, nrow = blk >= 128 ? 5 : 3, base = blk >= 128 ? 0 : 5120;
            for (int j = 0; j < nrow; ++j) { const int m = base + gw2 + 1024 * j;
                ln_row_b((const bf16_t*)(ws + WS_R2) + (size_t)m * DM, p.ln2_g, p.ln2_b, p.out + (size_t)m * DM, nullptr, lane); }
        } else { pg8::Sched S; S.init_split(32, 8, 32, 4, G, blk, 0, 0, 0); EpiSPart E{(float*)(ws + WS_PART), DM}; pg8::gemm_phase<EpiSPart>(lds, g, S, E); }
    }
    SEAM(8);
    if (IN(9)) { unsigned char* ws = opq(p.ws);
        const int gw = blk * 8 + wid, NGW = G * 8;
        for (int m = (G == 256 ? MP + gw : gw); m < MT; m += NGW) {
            if (m < MP) ln_row_b((const bf16_t*)(ws + WS_R2) + (size_t)m * DM, p.ln2_g, p.ln2_b, p.out + (size_t)m * DM, nullptr, lane);
            else ln_row((const float*)(ws + WS_PART) + (size_t)(m - MP) * DM, p.ln2_g, p.ln2_b, p.out + (size_t)m * DM, nullptr, lane, G == 256 ? 16 : 32, (size_t)MS * DM, (const float*)(ws + WS_X1) + (size_t)m * DM);
        }
    }
#undef IN
#undef SEAM
}

extern "C" void kernel_launch(void* const* d_in, const int* in_sizes, int n_in, void* d_out, int out_size, void* d_ws, size_t ws_size, hipStream_t stream) {
    static int grid = 0;
    if (grid == 0) {
        int dev = 0, cus = 0, per_cu = 0;
        if (n_in != 22 || ws_size < WS_END) { fprintf(stderr, "kernel_launch: unexpected inputs (n_in %d, ws %zu)\n", n_in, ws_size); grid = -1; return; }
        hipGetDevice(&dev);
        hipDeviceGetAttribute(&cus, hipDeviceAttributeMultiprocessorCount, dev);
        if (hipFuncSetAttribute((const void*)mega_fwd, hipFuncAttributeMaxDynamicSharedMemorySize, LDS_BYTES) != hipSuccess) { fprintf(stderr, "kernel_launch: hipFuncSetAttribute failed\n"); grid = -1; return; }
        if (hipOccupancyMaxActiveBlocksPerMultiprocessor(&per_cu, (const void*)mega_fwd, 512, LDS_BYTES) != hipSuccess || per_cu < 1) { fprintf(stderr, "kernel_launch: occupancy query says %d\n", per_cu); per_cu = 1; }
        (void)hipGetLastError();
        grid = cus;
    }
    if (grid < 0) return;
    Params p{};
    const float** pp = (const float**)&p;
    for (int i = 0; i < 22; ++i) pp[i] = (const float*)d_in[i];
    p.out = (float*)d_out; p.ws = (unsigned char*)d_ws; p.ph_lo = 0; p.ph_hi = 10; p.coop = 1; p.pad = 0;
    if (hipMemsetAsync(d_ws, 0, 16384, stream) != hipSuccess) { fprintf(stderr, "kernel_launch: memset failed\n"); return; }
    void* args[] = {&p};
    hipError_t e = hipLaunchCooperativeKernel((const void*)mega_fwd, dim3(grid), dim3(512), args, LDS_BYTES, stream);
    if (e != hipSuccess) fprintf(stderr, "cooperative launch failed: %s (grid %d)\n", hipGetErrorString(e), grid);
}
```
